# Optimizing an MI355X kernel written in HIP

```python
import math
import jax, jax.numpy as jnp
from jax import lax
import numpy as np

D_MODEL = 2048
BATCH = 4
SEQ = 4096
DEPTH = 1

GRID_W = 64
CTX_LEN = 256
Q_BLOCK = 128
ROPE_THETA = 10000.0
EPS = 1e-6
A_HEADS = 8
A_KV_HEADS = 2
A_HEAD_DIM = 128
B_HEADS = 8
B_NOPE = 128
B_ROPE = 64
B_V = 128
B_KV_RANK = 512
N_GROUPS = 4
EXPERTS_PER_GROUP = 4
N_EXPERTS = N_GROUPS * EXPERTS_PER_GROUP
TOP_K_IN_GROUP = 2
D_EXPERT = 1024
IN_SIZES = (A_HEADS * A_HEAD_DIM, A_KV_HEADS * A_HEAD_DIM, A_KV_HEADS * A_HEAD_DIM,
            B_HEADS * (B_NOPE + B_ROPE), B_KV_RANK, B_ROPE, 2 * D_MODEL)
D_IN = sum(IN_SIZES)
N_MOD = 6

kernel_name = 'hybrid_gqa_mla_hmoe_diffusion_block'


def _split_points():
    return [int(v) for v in np.cumsum(IN_SIZES)[:-1]]


def rmsnorm(x, g):
    xf = x.astype(jnp.float32)
    y = xf * lax.rsqrt(jnp.mean(xf * xf, axis=-1, keepdims=True) + EPS)
    return (y * g.astype(jnp.float32)).astype(x.dtype)


def modulate(h, shift, scale):
    return h * (1 + scale) + shift


def axial_rope_tables(n_tokens, rot_dim):
    rows = n_tokens // GRID_W
    row = jnp.repeat(jnp.arange(rows), GRID_W).astype(jnp.float32)
    col = jnp.tile(jnp.arange(GRID_W), rows).astype(jnp.float32)
    n_freq = rot_dim // 4
    freqs = ROPE_THETA ** (-jnp.arange(n_freq, dtype=jnp.float32) / n_freq)
    ang = jnp.concatenate([row[:, None] * freqs, col[:, None] * freqs], axis=-1)
    return jnp.cos(ang), jnp.sin(ang)


def apply_rope(x, cos, sin):
    shape = (1, cos.shape[0]) + (1,) * (x.ndim - 3) + (cos.shape[-1],)
    cos = cos.reshape(shape).astype(x.dtype)
    sin = sin.reshape(shape).astype(x.dtype)
    x1, x2 = jnp.split(x, 2, axis=-1)
    return jnp.concatenate([x1 * cos - x2 * sin, x1 * sin + x2 * cos], axis=-1)


def mixer_inputs(h, p, rope):
    B, S, _ = h.shape
    qa, ka, va, qb, ckv, kr, gl = jnp.split(h @ p['w_in'], _split_points(), axis=-1)
    qa = rmsnorm(qa.reshape(B, S, A_HEADS, A_HEAD_DIM), p['a_q_norm'])
    ka = rmsnorm(ka.reshape(B, S, A_KV_HEADS, A_HEAD_DIM), p['a_k_norm'])
    va = va.reshape(B, S, A_KV_HEADS, A_HEAD_DIM)
    qb = qb.reshape(B, S, B_HEADS, B_NOPE + B_ROPE)
    qbn, qbr = qb[..., :B_NOPE], qb[..., B_NOPE:]
    kv = (rmsnorm(ckv, p['b_kv_norm']) @ p['w_ukv']).reshape(B, S, B_HEADS, B_NOPE + B_V)
    kbn, vb = kv[..., :B_NOPE], kv[..., B_NOPE:]
    if rope is not None:
        cos_a, sin_a, cos_b, sin_b = rope
        qa = apply_rope(qa, cos_a, sin_a)
        ka = apply_rope(ka, cos_a, sin_a)
        qbr = apply_rope(qbr, cos_b, sin_b)
        kr = apply_rope(kr, cos_b, sin_b)
    qa = qa.reshape(B, S, A_KV_HEADS, A_HEADS // A_KV_HEADS, A_HEAD_DIM)
    return {'qa': qa, 'ka': ka, 'va': va, 'qbn': qbn, 'qbr': qbr,
            'kbn': kbn, 'kr': kr, 'vb': vb, 'gl': gl}


def gqa_attend(q, k, v):
    s = jnp.einsum('bqkgd,bskd->bkgqs', q.astype(jnp.float32), k.astype(jnp.float32))
    pr = jax.nn.softmax(s / math.sqrt(A_HEAD_DIM), axis=-1)
    return jnp.einsum('bkgqs,bskd->bqkgd', pr, v.astype(jnp.float32)).astype(v.dtype)


def mla_attend(qn, qr, kn, kr, v):
    f32 = jnp.float32
    s = (jnp.einsum('bqhd,bshd->bhqs', qn.astype(f32), kn.astype(f32))
         + jnp.einsum('bqhd,bsd->bhqs', qr.astype(f32), kr.astype(f32)))
    pr = jax.nn.softmax(s / math.sqrt(B_NOPE + B_ROPE), axis=-1)
    return jnp.einsum('bhqs,bshd->bqhd', pr, v.astype(f32)).astype(v.dtype)


def blocked(fn, qs, *kv):
    def to_blocks(t):
        B, S = t.shape[:2]
        return jnp.moveaxis(t.reshape((B, S // Q_BLOCK, Q_BLOCK) + t.shape[2:]), 1, 0)
    out = lax.map(lambda qb: fn(*qb, *kv), tuple(to_blocks(q) for q in qs))
    nb, B = out.shape[:2]
    return jnp.moveaxis(out, 0, 1).reshape((B, nb * Q_BLOCK) + out.shape[3:])


def merge_branches(oa, ob, gl, p):
    B, S = oa.shape[:2]
    ya = oa.reshape(B, S, -1) @ p['w_br_a']
    yb = ob.reshape(B, S, -1) @ p['w_br_b']
    ga, gb = jnp.split(jax.nn.sigmoid(gl), 2, axis=-1)
    return (ga * ya + gb * yb) @ p['w_out']


def hier_moe(h, p):
    B, S, D = h.shape
    t = h.reshape(-1, D)
    g_prob = jax.nn.softmax((t @ p['w_group'] + p['b_group']).astype(jnp.float32), axis=-1)
    g_val, g_idx = lax.top_k(g_prob, 1)
    e_all = jnp.einsum('nd,gde->nge', t, p['w_router']) + p['b_router']
    e_logits = jnp.take_along_axis(e_all, g_idx[:, :, None], axis=1)[:, 0].astype(jnp.float32)
    e_val, e_idx = lax.top_k(jax.nn.softmax(e_logits, axis=-1), TOP_K_IN_GROUP)
    w = g_val * e_val / jnp.sum(e_val, axis=-1, keepdims=True)
    eid = g_idx * EXPERTS_PER_GROUP + e_idx
    gate = jnp.sum(jax.nn.one_hot(eid, N_EXPERTS, dtype=jnp.float32) * w[..., None], axis=1)
    gate = gate.astype(t.dtype)
    y = jnp.zeros_like(t)
    for e in range(N_EXPERTS):
        hid = jax.nn.silu(t @ p['w_e_gate'][e]) * (t @ p['w_e_up'][e])
        y = y + gate[:, e:e + 1] * (hid @ p['w_e_down'][e])
    return y.reshape(B, S, D)


def setup_inputs(seed: int = 0) -> dict:
    key = jax.random.key(seed)
    ks = jax.random.split(key, 24)
    nrm = jax.random.normal
    f32 = jnp.float32
    D = D_MODEL
    return {
        'x': nrm(ks[0], (BATCH, SEQ, D), f32),
        'c': nrm(ks[1], (BATCH, D), f32),
        'ctx': nrm(ks[2], (BATCH, CTX_LEN, D), f32),
        'c_ctx': nrm(ks[3], (D,), f32),
        'w_mod': nrm(ks[4], (DEPTH, D, N_MOD * D), f32) * (0.5 * D ** -0.5),
        'b_mod': nrm(ks[5], (DEPTH, N_MOD * D), f32) * 0.02,
        'norm_mix': 1.0 + 0.05 * nrm(ks[6], (DEPTH, D), f32),
        'norm_ffn': 1.0 + 0.05 * nrm(ks[7], (DEPTH, D), f32),
        'w_in': nrm(ks[8], (DEPTH, D, D_IN), f32) * D ** -0.5,
        'a_q_norm': 1.0 + 0.05 * nrm(ks[9], (DEPTH, A_HEAD_DIM), f32),
        'a_k_norm': 1.0 + 0.05 * nrm(ks[10], (DEPTH, A_HEAD_DIM), f32),
        'b_kv_norm': 1.0 + 0.05 * nrm(ks[11], (DEPTH, B_KV_RANK), f32),
        'w_ukv': nrm(ks[12], (DEPTH, B_KV_RANK, B_HEADS * (B_NOPE + B_V)), f32) * B_KV_RANK ** -0.5,
        'w_br_a': nrm(ks[13], (DEPTH, A_HEADS * A_HEAD_DIM, D), f32) * (A_HEADS * A_HEAD_DIM) ** -0.5,
        'w_br_b': nrm(ks[14], (DEPTH, B_HEADS * B_V, D), f32) * (B_HEADS * B_V) ** -0.5,
        'w_out': nrm(ks[15], (DEPTH, D, D), f32) * D ** -0.5,
        'w_group': nrm(ks[16], (DEPTH, D, N_GROUPS), f32) * D ** -0.5,
        'b_group': nrm(ks[17], (DEPTH, N_GROUPS), f32) * 0.01,
        'w_router': nrm(ks[18], (DEPTH, N_GROUPS, D, EXPERTS_PER_GROUP), f32) * D ** -0.5,
        'b_router': nrm(ks[19], (DEPTH, N_GROUPS, EXPERTS_PER_GROUP), f32) * 0.01,
        'w_e_gate': nrm(ks[20], (DEPTH, N_EXPERTS, D, D_EXPERT), f32) * D ** -0.5,
        'w_e_up': nrm(ks[21], (DEPTH, N_EXPERTS, D, D_EXPERT), f32) * D ** -0.5,
        'w_e_down': nrm(ks[22], (DEPTH, N_EXPERTS, D_EXPERT, D), f32) * D_EXPERT ** -0.5,
        'norm_final': 1.0 + 0.05 * nrm(ks[23], (D,), f32),
    }


def reference(x, c, ctx, c_ctx, w_mod, b_mod, norm_mix, norm_ffn, w_in, a_q_norm, a_k_norm,
              b_kv_norm, w_ukv, w_br_a, w_br_b, w_out, w_group, b_group, w_router, b_router,
              w_e_gate, w_e_up, w_e_down, norm_final):
    B, S, D = x.shape
    rope = (*axial_rope_tables(S, A_HEAD_DIM), *axial_rope_tables(S, B_ROPE))
    silu_c = jax.nn.silu(c)
    silu_cc = jax.nn.silu(c_ctx)
    for l in range(DEPTH):
        p = {'w_in': w_in[l], 'a_q_norm': a_q_norm[l], 'a_k_norm': a_k_norm[l],
             'b_kv_norm': b_kv_norm[l], 'w_ukv': w_ukv[l], 'w_br_a': w_br_a[l],
             'w_br_b': w_br_b[l], 'w_out': w_out[l], 'w_group': w_group[l],
             'b_group': b_group[l], 'w_router': w_router[l], 'b_router': b_router[l],
             'w_e_gate': w_e_gate[l], 'w_e_up': w_e_up[l], 'w_e_down': w_e_down[l]}
        mod_x = (silu_c @ w_mod[l] + b_mod[l])[:, None, :]
        mod_c = (silu_cc @ w_mod[l] + b_mod[l])[None, None, :]
        sh1, sc1, g1, sh2, sc2, g2 = jnp.split(mod_x, N_MOD, axis=-1)
        csh1, csc1, cg1, csh2, csc2, cg2 = jnp.split(mod_c, N_MOD, axis=-1)

        hx = modulate(rmsnorm(x, norm_mix[l]), sh1, sc1)
        hc = modulate(rmsnorm(ctx, norm_mix[l]), csh1, csc1)
        mx = mixer_inputs(hx, p, rope)
        mc = mixer_inputs(hc, p, None)

        ka = jnp.concatenate([mc['ka'], mx['ka']], axis=1)
        va = jnp.concatenate([mc['va'], mx['va']], axis=1)
        kbn = jnp.concatenate([mc['kbn'], mx['kbn']], axis=1)
        kr = jnp.concatenate([mc['kr'], mx['kr']], axis=1)
        vb = jnp.concatenate([mc['vb'], mx['vb']], axis=1)
        oa = blocked(gqa_attend, (mx['qa'],), ka, va)
        ob = blocked(mla_attend, (mx['qbn'], mx['qbr']), kbn, kr, vb)
        x_new = x + g1 * merge_branches(oa, ob, mx['gl'], p)
        x_new = x_new + g2 * hier_moe(modulate(rmsnorm(x_new, norm_ffn[l]), sh2, sc2), p)

        if l + 1 < DEPTH:
            oac = gqa_attend(mc['qa'], mc['ka'], mc['va'])
            obc = mla_attend(mc['qbn'], mc['qbr'], mc['kbn'], mc['kr'], mc['vb'])
            ctx = ctx + cg1 * merge_branches(oac, obc, mc['gl'], p)
            ctx = ctx + cg2 * hier_moe(modulate(rmsnorm(ctx, norm_ffn[l]), csh2, csc2), p)
        x = x_new
    return rmsnorm(x, norm_final)
```

```cpp
#include <hip/hip_runtime.h>
#include <cstdio>
#include <cstdint>
#include <type_traits>

#define LAS __attribute__((address_space(3)))
#define GAS __attribute__((address_space(1)))
typedef unsigned short bf16_t;
typedef short bf16x8 __attribute__((ext_vector_type(8)));
typedef short s16x4 __attribute__((ext_vector_type(4)));
typedef float f32x2 __attribute__((ext_vector_type(2)));
typedef float f32x4 __attribute__((ext_vector_type(4)));
typedef float f32x16 __attribute__((ext_vector_type(16)));
typedef unsigned u32x2 __attribute__((ext_vector_type(2)));
typedef unsigned u32x4 __attribute__((ext_vector_type(4)));
typedef int i32x4 __attribute__((ext_vector_type(4)));
typedef int i32x8 __attribute__((ext_vector_type(8)));
typedef GAS unsigned gu32;

constexpr int DM = 2048, NB = 4, SEQ = 4096, CTXL = 256, KEYS = SEQ + CTXL, NTOK = NB * SEQ, NKEY = NB * KEYS;
constexpr int NMOD = 6 * DM;
constexpr int DIN = 7744, NINP = 7936;
constexpr int C_QA = 0, C_KA = 1024, C_VA = 1280, C_QB = 1536, C_CKV = 3072, C_KR = 3584, C_GL = 3840;
constexpr int NEXP = 16, DEXP = 1024;
constexpr float EPS = 1e-6f;
constexpr int NWAVES = 8;

constexpr size_t MiB = 1u << 20;
constexpr size_t WS_CTL = 0, CTL_ZERO_BYTES = 1 * MiB;
constexpr size_t WS_MOD = 1 * MiB;
constexpr size_t WS_ROPEA = WS_MOD + 256 * 1024;
constexpr size_t WS_ROPEB = WS_ROPEA + 16 * 1024;
constexpr size_t WS_RSTD = WS_ROPEB + 16 * 1024;
constexpr size_t WS_SAHX = WS_RSTD + 96 * 1024;
constexpr size_t WS_BIASR = WS_RSTD + 192 * 1024;
constexpr size_t WS_SAH2 = WS_RSTD + 256 * 1024;
constexpr size_t WS_SAO = WS_RSTD + 384 * 1024;
constexpr size_t WS_SAM = WS_RSTD + 512 * 1024;
constexpr size_t WS_LIST = 2 * MiB;
constexpr size_t WS_WLIST = 3 * MiB;
constexpr size_t WS_MODP = 4 * MiB;
constexpr size_t WS_WIN = 12 * MiB;
constexpr size_t WS_WUKV = 43 * MiB;
constexpr size_t WS_WBRA = 45 * MiB;
constexpr size_t WS_WBRB = 49 * MiB;
constexpr size_t WS_WOUT = 53 * MiB;
constexpr size_t WS_R1 = 61 * MiB;
constexpr size_t WS_R2 = 133 * MiB;
constexpr size_t WS_R3 = 261 * MiB;
constexpr size_t WS_R4 = 389 * MiB;
constexpr size_t WS_WG = 453 * MiB;
constexpr size_t WS_WD = 581 * MiB;
constexpr size_t WS_END = 645 * MiB;
constexpr size_t WS_INVD = WS_MODP + 3 * MiB;
constexpr size_t WS_SSC = WS_MODP + 2 * MiB;
constexpr size_t R2_QA = 0, R2_KA = 32 * MiB, R2_VA = R2_KA + (size_t)NKEY * 256 * 2, R2_QB = 49 * MiB, R2_CKV = 97 * MiB, R2_KR = 114 * MiB;
static_assert(R2_VA + (size_t)NKEY * 256 * 2 <= R2_QB && R2_CKV + (size_t)NKEY * 512 * 2 <= R2_KR && R2_KR + (size_t)NKEY * 64 * 2 <= 128 * MiB, "R2 map");
constexpr int CW_BAR = 4096;
constexpr int CW_ECNT = 16384;
constexpr int CW_CMAX_IN = 32768;
constexpr int CW_CMAX_BR = 98304, CW_CMAX_OUT = 98304 + 4096;
constexpr int CW_QHEAD = 131072, CW_QCNT = 131072 + 64;
constexpr int CW_CMAX_WG = 65536;
constexpr int RING_BYTES = 131072;
constexpr int CTL_OFF = 159744;
constexpr int MISC_OFF = CTL_OFF + 320;
constexpr int MOETAB_OFF = CTL_OFF + 1024;
constexpr int QSLOT_OFF = CTL_OFF + 1536;
constexpr int LDS_BYTES = 161792;
static_assert(83968 + 8 * 9216 <= CTL_OFF && LDS_BYTES <= 163840, "attention scratch below the control region");

#define RLX_AGENT __ATOMIC_RELAXED, __HIP_MEMORY_SCOPE_AGENT
#define LDS_WAIT() asm volatile("s_waitcnt lgkmcnt(0)" ::: "memory")
#define VM_WAIT() asm volatile("s_waitcnt vmcnt(0)" ::: "memory")
__device__ __forceinline__ unsigned cvt_pk_bf16(float lo, float hi) { unsigned r; asm volatile("v_cvt_pk_bf16_f32 %0, %1, %2" : "=v"(r) : "v"(lo), "v"(hi)); return r; }
__device__ __forceinline__ float bflo(unsigned w) { return __uint_as_float(w << 16); }
__device__ __forceinline__ float bfhi(unsigned w) { return __uint_as_float(w & 0xffff0000u); }
__device__ __forceinline__ float sigmoidf_(float v) { return __builtin_amdgcn_rcpf(1.0f + __builtin_amdgcn_exp2f(-1.4426950408889634f * v)); }
__device__ __forceinline__ float wave_sum(float v) {
#pragma unroll
    for (int o = 1; o < 64; o <<= 1) v += __shfl_xor(v, o);
    return v;
}

constexpr int WTAB_OFF_ = 159744 + 1792;
__device__ __forceinline__ int my_lane() { return (int)__builtin_amdgcn_mbcnt_hi(~0u, __builtin_amdgcn_mbcnt_lo(~0u, 0u)); }
__device__ __forceinline__ int my_wave() { const unsigned key = (unsigned)__builtin_amdgcn_s_getreg((5 << 11) | 4) & 63u;
    return __builtin_amdgcn_readfirstlane(((const LAS int*)(unsigned long)WTAB_OFF_)[key]); }
__device__ __forceinline__ int my_tid() { return my_wave() * 64 + my_lane(); }
__device__ __forceinline__ int opaque_v(int v) { asm volatile("" : "+v"(v)); return v; }

namespace pg8 {
constexpr int BM = 256, BK = 64, HALF = 128, HTB = HALF * BK * 2, STAGE_BYTES = 8 * HTB, NXCD = 8, WGM = 8;
__host__ __device__ __forceinline__ int lds_byte(int r, int c) { const int st = (r >> 4) * 2 + (c >> 5), rr = r & 15, cc = c & 31, ob = rr * 64 + cc * 2; return st * 1024 + (ob ^ (((ob >> 9) & 1) << 5)); }
__host__ __device__ __forceinline__ void stage_rc(int b, int& R, int& C) { const int st = b / 1024, sb = b % 1024, swz = sb ^ (((sb >> 9) & 1) << 5); R = (st >> 1) * 16 + swz / 64; C = (st & 1) * 32 + (swz % 64) / 2; }
__host__ __device__ __forceinline__ int perm32(int rho) { const int n = rho >> 4, i = rho & 15; return 8 * (i >> 2) + 4 * n + (i & 3); }

struct Unit { int pm, pn, x, y; };
struct Gemm { const bf16_t* A; const bf16_t* Bt; int K; int lda = 0; long asplit = 0; };

__device__ __forceinline__ void tile_map(int L, int nM, int nN, int& pm, int& pn) {
    const int nwg = nM * nN; int wgid = L;
    { const int q = nwg / NXCD, r = nwg % NXCD, xcd = wgid % NXCD, off = wgid / NXCD; wgid = (xcd < r ? xcd * (q + 1) : r * (q + 1) + (xcd - r) * q) + off; }
    const int nig = WGM * nN, gid = wgid / nig, fm = gid * WGM, gsz = (nM - fm) < WGM ? (nM - fm) : WGM;
    pm = fm + ((wgid % nig) % gsz); pn = (wgid % nig) / gsz;
}
struct TileOrder {
    int nM, nN, G, c;
    __device__ __forceinline__ bool next(int i, Unit& u) const {
        const long L = (long)i * G + c; if (L >= (long)nM * nN) return false;
        tile_map((int)L, nM, nN, u.pm, u.pn); u.x = 0; u.y = 0; return true;
    }
    __device__ __forceinline__ int src_row(const Unit&, int) const { return 0; }
    __device__ __forceinline__ void done(const Unit&) const {}
};

template <class Epi, class Sched, bool GATHER, int PR = 0, bool ALIGN_EPI = true, bool SP2 = true>
__device__ __forceinline__ void gemm_phase(LAS unsigned char* lds, const Gemm g, const Sched& S, const Epi& E) {
    constexpr bool I8 = (PR == 1), BYTES = (PR != 0);
    typedef typename std::conditional<I8, i32x4, f32x4>::type acc_t;
    const int tid = opaque_v(my_tid()), wid = __builtin_amdgcn_readfirstlane(tid >> 6), lane = tid & 63, wr = wid >> 2, wc = wid & 3, fr = lane & 15, fq = lane >> 4;
    const int K = BYTES ? g.K / 2 : g.K, nt = K / BK;
    const int LA = g.lda ? (BYTES ? g.lda / 2 : g.lda) : K;
    unsigned voffA[2], voffB[2];
#pragma unroll
    for (int i = 0; i < 2; ++i) { int R, C; stage_rc(tid * 16 + i * 8192, R, C); const int Rb = Epi::PERM ? ((R & ~31) + perm32(R & 31)) : R;
        voffA[i] = (unsigned)(R * LA + C) * 2u; voffB[i] = (unsigned)(Rb * K + C) * 2u; }
    const size_t kstep = (size_t)(BK * 2);
    const size_t hstep = (size_t)HALF * K * 2;
    const size_t tstep = 2 * hstep;
    const size_t hstepA = (size_t)HALF * LA * 2, tstepA = 2 * hstepA; const long asplit = g.asplit;
    const __amdgpu_buffer_rsrc_t rsA = __builtin_amdgcn_make_buffer_rsrc((void*)g.A, 0, 0x7ffffff0, 0x00020000), rsB = __builtin_amdgcn_make_buffer_rsrc((void*)g.Bt, 0, 0x7ffffff0, 0x00020000);
#define PG8_KOFFA(t_) ((size_t)(t_) * kstep + ((t_) >= nt / 2 ? asplit : 0L))
    const unsigned ldsw = (unsigned)wid * 1024u;
    const int aoff = lds_byte(wr * 64 + fr, fq * 8), boff = lds_byte(wc * 32 + fr, fq * 8);
#define PG8_SA(b, h) (((b) * 2 + (h)) * HTB)
#define PG8_SB(b, h) ((4 + (b) * 2 + (h)) * HTB)
#define PG8_STAGE_R(bufoff, gbase, voff, RS, BP) do { const unsigned so_ = (unsigned)((const char*)(gbase) - (const char*)(BP)); _Pragma("unroll") for (int _i = 0; _i < 2; ++_i) \
        __builtin_amdgcn_raw_ptr_buffer_load_lds(RS, (LAS unsigned*)(lds + (bufoff) + ldsw + _i * 8192), 16, (int)(voff)[_i], (int)so_, 0, 0); } while (0)
#define PG8_STAGE(bufoff, gbase, voff) PG8_STAGE_R(bufoff, gbase, voff, rsB, g.Bt)
#define PG8_STAGE_A(bufoff, h, dptr, koff, vg) do { if constexpr (GATHER) PG8_STAGE_R(bufoff, (const char*)g.A + (koff), (vg)[h], rsA, g.A); else PG8_STAGE_R(bufoff, (dptr) + (h) * hstepA, voffA, rsA, g.A); } while (0)
#define PG8_LDA(dst, b, h) do { _Pragma("unroll") for (int m = 0; m < 4; ++m) { dst[m].lo = __builtin_bit_cast(i32x4, *(const LAS bf16x8*)(lds + PG8_SA(b, h) + aoff + m * 2048)); dst[m].hi = __builtin_bit_cast(i32x4, *(const LAS bf16x8*)(lds + PG8_SA(b, h) + aoff + m * 2048 + 1024)); } } while (0)
#define PG8_LDB(dst, b, h) do { _Pragma("unroll") for (int n = 0; n < 2; ++n) { dst[n].lo = __builtin_bit_cast(i32x4, *(const LAS bf16x8*)(lds + PG8_SB(b, h) + boff + n * 2048)); dst[n].hi = __builtin_bit_cast(i32x4, *(const LAS bf16x8*)(lds + PG8_SB(b, h) + boff + n * 2048 + 1024)); } } while (0)
#define PG8_FR(v, k) ((k) ? (v).hi : (v).lo)
#define PG8_MMA(ai, bj, At, Bt) do { __builtin_amdgcn_s_setprio(1); _Pragma("unroll") for (int m = 0; m < 4; ++m) _Pragma("unroll") for (int n = 0; n < 2; ++n) { \
        if constexpr (PR == 2) { acc[ai][bj][m][n] = __builtin_amdgcn_mfma_scale_f32_16x16x128_f8f6f4(Bt[n], At[m], acc[ai][bj][m][n], 0, 0, 0, 0x7F7F7F7F, 0, 0x7F7F7F7F); } \
        else { _Pragma("unroll") for (int k = 0; k < 2; ++k) { \
        if constexpr (I8) acc[ai][bj][m][n] = __builtin_amdgcn_mfma_i32_16x16x64_i8(PG8_FR(Bt[n], k), PG8_FR(At[m], k), acc[ai][bj][m][n], 0, 0, 0); \
        else acc[ai][bj][m][n] = __builtin_amdgcn_mfma_f32_16x16x32_bf16(__builtin_bit_cast(bf16x8, PG8_FR(Bt[n], k)), __builtin_bit_cast(bf16x8, PG8_FR(At[m], k)), acc[ai][bj][m][n], 0, 0, 0); } } } __builtin_amdgcn_s_setprio(0); } while (0)
#define PG8_WAIT_V(n) asm volatile("s_waitcnt vmcnt(" #n ")" ::: "memory")
#define PG8_WAIT_L(n) asm volatile("s_waitcnt lgkmcnt(" #n ")" ::: "memory")
#define PG8_BAR __builtin_amdgcn_s_barrier()
#define PG8_SCHED __builtin_amdgcn_sched_barrier(0)
#define PG8_GOFF(dst, u) do { const int t_ = opaque_v(tid); _Pragma("unroll") for (int _i = 0; _i < 2; ++_i) { int R_, C_; stage_rc(t_ * 16 + _i * 8192, R_, C_); \
        _Pragma("unroll") for (int _h = 0; _h < 2; ++_h) dst[_h][_i] = (unsigned)(S.src_row(u, _h * HALF + R_) * K + C_) * 2u; } } while (0)
    Unit cur, nxt, prv; int ui = 0;
    if (!S.next(0, cur)) return;
    prv = cur;
    unsigned vgC[2][2] = {{0u, 0u}, {0u, 0u}}, vgN[2][2] = {{0u, 0u}, {0u, 0u}};
    if constexpr (GATHER) PG8_GOFF(vgC, cur);
    acc_t acc[2][2][4][2];
#pragma unroll
    for (int a = 0; a < 2; ++a)
#pragma unroll
        for (int b = 0; b < 2; ++b)
#pragma unroll
            for (int m = 0; m < 4; ++m)
#pragma unroll
                for (int n = 0; n < 2; ++n) { int z0_, z1_, z2_, z3_; asm volatile("v_mov_b32 %0, 0\n\tv_mov_b32 %1, 0\n\tv_mov_b32 %2, 0\n\tv_mov_b32 %3, 0" : "=v"(z0_), "=v"(z1_), "=v"(z2_), "=v"(z3_)); acc[a][b][m][n] = __builtin_bit_cast(acc_t, (i32x4){z0_, z1_, z2_, z3_}); }
    i32x8 At[4], B0[2], B1[2];
    const char* cA = (const char*)g.A + (GATHER ? (size_t)0 : (size_t)cur.pm * tstepA); const char* cB = (const char*)g.Bt + (size_t)cur.pn * tstep;
    static_assert(SP2, "only the two-super-phase loop is kept");
    PG8_STAGE(PG8_SB(0, 0), cB, voffB); PG8_STAGE(PG8_SB(0, 1), cB + hstep, voffB); PG8_STAGE_A(PG8_SA(0, 0), 0, cA, 0, vgC); PG8_STAGE_A(PG8_SA(0, 1), 1, cA, 0, vgC);
    if (wr == 1) PG8_BAR;
    PG8_WAIT_V(2); PG8_BAR;
    PG8_STAGE(PG8_SB(1, 0), cB + kstep, voffB); PG8_STAGE_A(PG8_SA(1, 0), 0, cA + kstep, kstep, vgC); PG8_STAGE(PG8_SB(1, 1), cB + hstep + kstep, voffB);
    PG8_WAIT_V(6); PG8_BAR;
    for (;;) {
        const bool has_next = S.next(ui + 1, nxt);
        if constexpr (GATHER) { if (has_next) PG8_GOFF(vgN, nxt); else {
#pragma unroll
            for (int h_ = 0; h_ < 2; ++h_)
#pragma unroll
                for (int i_ = 0; i_ < 2; ++i_) vgN[h_][i_] = vgC[h_][i_]; } }
        const char* nA = (has_next && !GATHER) ? (const char*)g.A + (size_t)nxt.pm * tstepA : cA; const char* nB = has_next ? (const char*)g.Bt + (size_t)nxt.pn * tstep : cB;
#pragma unroll 1
        for (int t = 0; t < nt; t += 2) {
            const bool last = (t == nt - 2);
            if constexpr (Epi::MIDHOOK) { if (t == nt / 2) E.mid(acc, cur, wr, wc, opaque_v(fr), fq); }
            const char* a1 = cA + PG8_KOFFA(t + 1); const size_t k1 = (size_t)(t + 1) * kstep;
            const char* a2 = last ? nA : cA + PG8_KOFFA(t + 2); const char* b2 = last ? nB : cB + (size_t)(t + 2) * kstep;
            const size_t k2 = last ? (size_t)0 : (size_t)(t + 2) * kstep, k3 = k2 + kstep;
            const char* a3 = a2 + kstep; const char* b3 = b2 + kstep;
            PG8_LDB(B0, 0, 0); PG8_LDB(B1, 0, 1); PG8_SCHED; PG8_LDA(At, 0, 0); PG8_STAGE_A(PG8_SA(1, 1), 1, a1, k1, vgC);
            if constexpr (GATHER) { if (last) {
#pragma unroll
                for (int h_ = 0; h_ < 2; ++h_)
#pragma unroll
                    for (int i_ = 0; i_ < 2; ++i_) vgC[h_][i_] = vgN[h_][i_]; } }
            PG8_WAIT_V(8); PG8_WAIT_L(0); PG8_BAR; PG8_MMA(0, 0, At, B0); PG8_MMA(0, 1, At, B1); PG8_BAR; PG8_SCHED;
            PG8_LDA(At, 0, 1); PG8_STAGE(PG8_SB(0, 0), b2, voffB); PG8_STAGE(PG8_SB(0, 1), b2 + hstep, voffB); PG8_STAGE_A(PG8_SA(0, 0), 0, a2, k2, vgC);
            PG8_WAIT_V(8); PG8_WAIT_L(0); PG8_BAR; PG8_MMA(1, 0, At, B0); PG8_MMA(1, 1, At, B1); PG8_BAR; PG8_SCHED;
            PG8_LDB(B0, 1, 0); PG8_LDB(B1, 1, 1); PG8_SCHED; PG8_LDA(At, 1, 0); PG8_STAGE_A(PG8_SA(0, 1), 1, a2, k2, vgC);
            PG8_WAIT_V(8); PG8_WAIT_L(0); PG8_BAR; PG8_MMA(0, 0, At, B0); PG8_MMA(0, 1, At, B1); PG8_BAR; PG8_SCHED;
            PG8_LDA(At, 1, 1); PG8_STAGE(PG8_SB(1, 0), b3, voffB); PG8_STAGE(PG8_SB(1, 1), b3 + hstep, voffB); PG8_STAGE_A(PG8_SA(1, 0), 0, a3, k3, vgC);
            PG8_WAIT_V(8); PG8_WAIT_L(0); PG8_BAR; PG8_MMA(1, 0, At, B0); PG8_MMA(1, 1, At, B1); PG8_BAR; PG8_SCHED;
        }
        if constexpr (ALIGN_EPI) { if (wr == 0) PG8_BAR; }
        if (ui > 0) S.done(prv);
        E(acc, cur, wr, wc, opaque_v(fr), fq);
        prv = cur;
        if (!has_next) break;
#pragma unroll
        for (int a = 0; a < 2; ++a)
#pragma unroll
            for (int b = 0; b < 2; ++b)
#pragma unroll
                for (int m = 0; m < 4; ++m)
#pragma unroll
                    for (int n = 0; n < 2; ++n) { int z0_, z1_, z2_, z3_; asm volatile("v_mov_b32 %0, 0\n\tv_mov_b32 %1, 0\n\tv_mov_b32 %2, 0\n\tv_mov_b32 %3, 0" : "=v"(z0_), "=v"(z1_), "=v"(z2_), "=v"(z3_)); acc[a][b][m][n] = __builtin_bit_cast(acc_t, (i32x4){z0_, z1_, z2_, z3_}); }
        cur = nxt; cA = nA; cB = nB; ++ui;
        if constexpr (ALIGN_EPI) { if (wr == 1) PG8_BAR; }
    }
    PG8_WAIT_V(0);
    S.done(prv);
    if constexpr (!ALIGN_EPI) { if (wr == 0) PG8_BAR; }
    PG8_BAR;
#undef PG8_SA
#undef PG8_SB
#undef PG8_STAGE
#undef PG8_STAGE_R
#undef PG8_STAGE_A
#undef PG8_LDA
#undef PG8_LDB
#undef PG8_MMA
#undef PG8_WAIT_V
#undef PG8_WAIT_L
#undef PG8_BAR
#undef PG8_SCHED
#undef PG8_GOFF
#undef PG8_FR
#undef PG8_KOFFA
}
}

#define XB_TMO      128
#define XB_XCNT(j)  (256  + 64 * (j))
#define XB_XSUB(j)  (1280 + 64 * (j))
#define XB_XGEN(j)  (2304 + 64 * (j))
#define XB_TOP      3328
#define XB_TOPGEN   3392
#define XCD_BAR_WORDS 3456
#define XB_SPIN_CAP (1u << 18)

__device__ __forceinline__ unsigned xb_ld(unsigned* p)              { return __hip_atomic_load(p, __ATOMIC_RELAXED, __HIP_MEMORY_SCOPE_AGENT); }
__device__ __forceinline__ unsigned xb_add(unsigned* p, unsigned v) { return __hip_atomic_fetch_add(p, v, __ATOMIC_RELAXED, __HIP_MEMORY_SCOPE_AGENT); }
__device__ __forceinline__ unsigned xb_xcc_id() { return (unsigned)__builtin_amdgcn_s_getreg((3 << 11) | 20) & 0xFu; }
#define XB_SPIN(cond, bar) do { unsigned _sp = 0; while (cond) { __builtin_amdgcn_s_sleep(1); \
    if ((++_sp & 255u) == 0u) { if (xb_ld(&(bar)[XB_TMO])) break; if (_sp > XB_SPIN_CAP) { atomicAdd(&(bar)[XB_TMO], 1u); break; } } } } while (0)

struct XcdBarrier {
    unsigned* bar; unsigned x;
    volatile LAS unsigned* st;
};

__device__ __forceinline__ XcdBarrier xcd_barrier_post(unsigned* bar, volatile LAS unsigned* st) {
    XcdBarrier b; b.bar = bar; b.x = xb_xcc_id(); b.st = st;
    if (threadIdx.x == 0) (void)xb_add(&bar[XB_XCNT(b.x)], 1u);
    return b;
}
__device__ __forceinline__ void xcd_barrier_complete(unsigned* bar, unsigned x, unsigned& nloc, unsigned& nx) {
    const unsigned G = gridDim.x * gridDim.y * gridDim.z;
    unsigned sum, cnt, mine, sp = 0u;
    for (;;) {
        sum = 0u; cnt = 0u; mine = 0u;
#pragma unroll
        for (unsigned j = 0; j < 16; ++j) { const unsigned c = xb_ld(&bar[XB_XCNT(j)]); sum += c; cnt += (c > 0u) ? 1u : 0u; mine = (j == x) ? c : mine; }
        if (sum == G) break;
        __builtin_amdgcn_s_sleep(1);
        if ((++sp & 255u) == 0u) { if (xb_ld(&bar[XB_TMO])) break; if (sp > XB_SPIN_CAP) { atomicAdd(&bar[XB_TMO], 1u); break; } }
    }
    nloc = mine > 0u ? mine : 1u; nx = cnt > 0u ? cnt : 1u;
}

__device__ __forceinline__ void xcd_barrier(const XcdBarrier& b) {
    asm volatile("s_waitcnt vmcnt(0)" ::: "memory");
    __syncthreads();
    if (my_tid() == 0) {
        unsigned* bar = b.bar;
        __builtin_amdgcn_s_waitcnt(0);
        unsigned nloc = b.st[0], nx = b.st[1];
        if (nloc == 0u) { xcd_barrier_complete(bar, b.x, nloc, nx); b.st[0] = nloc; b.st[1] = nx; }
        const unsigned old = xb_add(&bar[XB_XSUB(b.x)], 1u);
        const unsigned gen = old / nloc;
        if (old + 1u == (gen + 1u) * nloc) {
            __builtin_amdgcn_fence(__ATOMIC_RELEASE, "agent");
            asm volatile("s_waitcnt vmcnt(0)" ::: "memory");
            const unsigned og = xb_add(&bar[XB_TOP], 1u);
            const unsigned tg = og / nx;
            if (og + 1u == (tg + 1u) * nx) xb_add(&bar[XB_TOPGEN], 1u);
            else XB_SPIN(xb_ld(&bar[XB_TOPGEN]) == tg, bar);
            __builtin_amdgcn_fence(__ATOMIC_ACQUIRE, "agent");
            xb_add(&bar[XB_XGEN(b.x)], 1u);
            asm volatile("s_waitcnt vmcnt(0)" ::: "memory");
        } else {
            XB_SPIN(xb_ld(&bar[XB_XGEN(b.x)]) == gen, bar);
            __builtin_amdgcn_fence(__ATOMIC_ACQUIRE, "agent");
            asm volatile("s_waitcnt vmcnt(0)" ::: "memory");
        }
    }
    __syncthreads();
}

#ifndef ATT_B_SDEPTH
#define ATT_B_SDEPTH 2
#endif
#ifndef ATT_B_QPARK
#define ATT_B_QPARK 5
#endif

namespace att {
constexpr int D = 128, NW = 8, QBLK = 32, KVBLK = 64;
constexpr float THR = 8.f;
constexpr size_t SHM_V = KVBLK * D * 2, SHM_K = KVBLK * D * 2, SHM_KR = KVBLK * 64 * 2;
constexpr size_t OFF_V = 0, OFF_K = 2 * SHM_V, OFF_KR = OFF_K + 2 * SHM_K, OFF_WS = OFF_KR + 2 * SHM_KR, OFF_QR = OFF_WS + NW * 64 * 4, SHM_ATTN = OFF_QR + NW * 9216;
#define KSWZ(row, colB) ((row) * 256 + ((colB) ^ ((((row) & 7) | (((row) >> 1) & 8)) << 4)))
#define KRSWZ(row, colB) ((row) * 128 + ((colB) ^ ((((row) >> 1) & 7) << 4)))
#define SBAR() __builtin_amdgcn_sched_barrier(0)
__device__ __forceinline__ int crow(int r, int hi) { return (r & 3) + 8 * (r >> 2) + 4 * hi; }
typedef __bf16 bf16x2_t __attribute__((ext_vector_type(2)));
__device__ __forceinline__ unsigned cvtpk(float lo, float hi) { const f32x2 v = {lo, hi}; return __builtin_bit_cast(unsigned, __builtin_convertvector(v, bf16x2_t)); }
template <int DR> __device__ __forceinline__ void seg1_sched() {
  __builtin_amdgcn_sched_group_barrier(0x100, DR ? 4 : 3, 0);
#pragma unroll
  for (int i = 0; i < 8; ++i) {
    __builtin_amdgcn_sched_group_barrier(0x008, 1, 0); __builtin_amdgcn_sched_group_barrier(0x100, 1, 0); __builtin_amdgcn_sched_group_barrier(0x400, 1, 0); __builtin_amdgcn_sched_group_barrier(0x002, DR ? 3 : 4, 0);
    __builtin_amdgcn_sched_group_barrier(0x008, 1, 0); __builtin_amdgcn_sched_group_barrier(0x100, DR ? 2 : 1, 0); __builtin_amdgcn_sched_group_barrier(0x400, 1, 0); __builtin_amdgcn_sched_group_barrier(0x002, DR ? 3 : 4, 0); }
  if constexpr (DR > 0) {
#pragma unroll
    for (int i = 0; i < 4; ++i) {
      __builtin_amdgcn_sched_group_barrier(0x008, 1, 0); __builtin_amdgcn_sched_group_barrier(0x100, 1, 0); __builtin_amdgcn_sched_group_barrier(0x002, 2, 0);
      __builtin_amdgcn_sched_group_barrier(0x008, 1, 0); __builtin_amdgcn_sched_group_barrier(0x100, 2, 0); __builtin_amdgcn_sched_group_barrier(0x002, 2, 0); }
  }
}
__device__ __forceinline__ bf16x8 ld8(const bf16_t* p) { return *reinterpret_cast<const bf16x8*>(p); }

template <int DR> struct Cfg { static constexpr float SCALE = 0.6931471805599453f; };

template <int DR>
__device__ __forceinline__ void partialSM(f32x16& p0, f32x16& p1, float& m_reg, float& mn, float& alpha) {
  constexpr float SCALE = Cfg<DR>::SCALE; constexpr float C = SCALE * 1.4426950408889634f;
  float pmax = p0[0];
#pragma unroll
  for (int r = 1; r < 16; ++r) pmax = fmaxf(pmax, p0[r]);
#pragma unroll
  for (int r = 0; r < 16; ++r) pmax = fmaxf(pmax, p1[r]);
  { auto rr = __builtin_amdgcn_permlane32_swap(__float_as_uint(pmax), __float_as_uint(pmax), false, false);
    pmax = fmaxf(__uint_as_float(rr[0]), __uint_as_float(rr[1])); }
  if (__builtin_expect(__all(pmax - m_reg <= THR / SCALE), 1)) { mn = m_reg; alpha = 1.f; }
  else { mn = fmaxf(m_reg, pmax); alpha = __builtin_amdgcn_exp2f((m_reg - mn) * C); m_reg = mn; }
  float mnC = -mn * C;
#pragma unroll
  for (int r = 0; r < 16; ++r) p0[r] = fmaf(p0[r], C, mnC);
#pragma unroll
  for (int r = 0; r < 16; ++r) p1[r] = fmaf(p1[r], C, mnC);
#pragma unroll
  for (int r = 0; r < 16; ++r) p0[r] = __builtin_amdgcn_exp2f(p0[r]);
}
__device__ __forceinline__ void finishSM(f32x16& p0, f32x16& p1, float alpha, float& l_reg, bf16x8& pa0, bf16x8& pa1, bf16x8& pa2, bf16x8& pa3) {
#pragma unroll
  for (int r = 0; r < 16; ++r) p1[r] = __builtin_amdgcn_exp2f(p1[r]);
  float ps = 0;
#pragma unroll
  for (int r = 0; r < 16; ++r) ps += p0[r];
#pragma unroll
  for (int r = 0; r < 16; ++r) ps += p1[r];
  { auto rr = __builtin_amdgcn_permlane32_swap(__float_as_uint(ps), __float_as_uint(ps), false, false);
    ps = __uint_as_float(rr[0]) + __uint_as_float(rr[1]); }
  l_reg = l_reg * alpha + ps;
#define PK4(P, BASE, OUT) do { u32x4 w = {cvtpk(P[BASE + 0], P[BASE + 1]), cvtpk(P[BASE + 2], P[BASE + 3]), cvtpk(P[BASE + 4], P[BASE + 5]), cvtpk(P[BASE + 6], P[BASE + 7])}; \
    OUT = __builtin_bit_cast(bf16x8, w); } while (0)
  PK4(p0, 0, pa0); PK4(p0, 8, pa1); PK4(p1, 0, pa2); PK4(p1, 8, pa3);
#undef PK4
}
__device__ __forceinline__ void finishSM_fast(f32x16& p0, f32x16& p1, float& l_reg, bf16x8& pa0, bf16x8& pa1, bf16x8& pa2, bf16x8& pa3) {
#pragma unroll
  for (int r = 0; r < 16; ++r) p1[r] = __builtin_amdgcn_exp2f(p1[r]);
  float ps = 0;
#pragma unroll
  for (int r = 0; r < 16; ++r) ps += p0[r];
#pragma unroll
  for (int r = 0; r < 16; ++r) ps += p1[r];
  { auto rr = __builtin_amdgcn_permlane32_swap(__float_as_uint(ps), __float_as_uint(ps), false, false);
    ps = __uint_as_float(rr[0]) + __uint_as_float(rr[1]); }
  l_reg += ps;
#define PK4(P, BASE, OUT) do { u32x4 w = {cvtpk(P[BASE + 0], P[BASE + 1]), cvtpk(P[BASE + 2], P[BASE + 3]), cvtpk(P[BASE + 4], P[BASE + 5]), cvtpk(P[BASE + 6], P[BASE + 7])}; \
    OUT = __builtin_bit_cast(bf16x8, w); } while (0)
  PK4(p0, 0, pa0); PK4(p0, 8, pa1); PK4(p1, 0, pa2); PK4(p1, 8, pa3);
#undef PK4
}
__device__ __forceinline__ void exp16(f32x16& p) {
#pragma unroll
  for (int r = 0; r < 16; ++r) p[r] = __builtin_amdgcn_exp2f(p[r]);
}
template <int DR, int QPARK>
__device__ __forceinline__ void qkt(f32x16& p0, f32x16& p1, const char* Ks, const char* KRs, const bf16x8* qr, const char* QRs, int r32, int hi) {
  p0 = f32x16{}; p1 = f32x16{};
#pragma unroll
  for (int d0 = 0; d0 < 8; ++d0) { int cb = (d0 * 16 + hi * 8) * 2;
    bf16x8 b0 = *reinterpret_cast<const bf16x8*>(Ks + KSWZ(r32, cb));
    bf16x8 b1 = *reinterpret_cast<const bf16x8*>(Ks + KSWZ(32 + r32, cb));
    bf16x8 q; if (d0 >= 8 - QPARK) q = *reinterpret_cast<const bf16x8*>(QRs + (4 + d0 - (8 - QPARK)) * 1024); else q = qr[d0];
    p0 = __builtin_amdgcn_mfma_f32_32x32x16_bf16(b0, q, p0, 0, 0, 0);
    p1 = __builtin_amdgcn_mfma_f32_32x32x16_bf16(b1, q, p1, 0, 0, 0); }
  if constexpr (DR > 0) {
#pragma unroll
    for (int d0 = 0; d0 < DR / 16; ++d0) { int cb = (d0 * 16 + hi * 8) * 2;
      bf16x8 b0 = *reinterpret_cast<const bf16x8*>(KRs + KRSWZ(r32, cb));
      bf16x8 b1 = *reinterpret_cast<const bf16x8*>(KRs + KRSWZ(32 + r32, cb));
      bf16x8 q; if constexpr (QPARK >= 0) q = *reinterpret_cast<const bf16x8*>(QRs + d0 * 1024); else q = qr[8 + d0];
      p0 = __builtin_amdgcn_mfma_f32_32x32x16_bf16(b0, q, p0, 0, 0, 0);
      p1 = __builtin_amdgcn_mfma_f32_32x32x16_bf16(b1, q, p1, 0, 0, 0); }
  }
}
__device__ __forceinline__ int v_st(int k, int c) { const int kk = k; return ((kk >> 3) * 4 + (c >> 5)) * 512 + ((kk & 7) * 32 + (c & 31)) * 2; }
__device__ __forceinline__ int v_rd_base(int lane) { return ((lane & 3) << 3) | (((lane >> 2) & 3) << 6) | (((lane >> 4) & 1) << 5) | (((lane >> 5) & 1) << 8); }
constexpr int v_rd_off(int d0, int ks, int half) { return d0 * 512 + ks * 4096 + half * 2048; }
template <int OFF> __device__ __forceinline__ s16x4 tr_read(int vb) {
  s16x4 r; asm volatile("ds_read_b64_tr_b16 %0, %1 offset:%2" : "=&v"(r) : "v"(vb), "i"(OFF) : "memory"); return r;
}
template <int D0> __device__ __forceinline__ void pv_one(f32x16& od, int vb, bf16x8 pa0, bf16x8 pa1, bf16x8 pa2, bf16x8 pa3) {
  const s16x4 l0 = tr_read<v_rd_off(D0, 0, 0)>(vb), h0 = tr_read<v_rd_off(D0, 0, 1)>(vb), l1 = tr_read<v_rd_off(D0, 1, 0)>(vb), h1 = tr_read<v_rd_off(D0, 1, 1)>(vb);
  const s16x4 l2 = tr_read<v_rd_off(D0, 2, 0)>(vb), h2 = tr_read<v_rd_off(D0, 2, 1)>(vb), l3 = tr_read<v_rd_off(D0, 3, 0)>(vb), h3 = tr_read<v_rd_off(D0, 3, 1)>(vb);
  asm volatile("s_waitcnt lgkmcnt(0)" ::: "memory"); SBAR();
#define PK(L, H) (bf16x8){L[0], L[1], L[2], L[3], H[0], H[1], H[2], H[3]}
  od = __builtin_amdgcn_mfma_f32_32x32x16_bf16(pa0, PK(l0, h0), od, 0, 0, 0);
  od = __builtin_amdgcn_mfma_f32_32x32x16_bf16(pa1, PK(l1, h1), od, 0, 0, 0);
  od = __builtin_amdgcn_mfma_f32_32x32x16_bf16(pa2, PK(l2, h2), od, 0, 0, 0);
  od = __builtin_amdgcn_mfma_f32_32x32x16_bf16(pa3, PK(l3, h3), od, 0, 0, 0);
#undef PK
}
template <int DR>
__device__ __forceinline__ void pv_partialSM(f32x16* o, int vb, bf16x8 pa0, bf16x8 pa1, bf16x8 pa2, bf16x8 pa3, f32x16& p0, f32x16& p1, float& m_reg, float& mnC, float& alpha) {
  constexpr float SCALE = Cfg<DR>::SCALE; constexpr float C = SCALE * 1.4426950408889634f;
  pv_one<0>(o[0], vb, pa0, pa1, pa2, pa3);
  float pmax = p0[0];
#pragma unroll
  for (int r = 1; r < 16; ++r) pmax = fmaxf(pmax, p0[r]);
#pragma unroll
  for (int r = 0; r < 16; ++r) pmax = fmaxf(pmax, p1[r]);
  { auto rr = __builtin_amdgcn_permlane32_swap(__float_as_uint(pmax), __float_as_uint(pmax), false, false);
    pmax = fmaxf(__uint_as_float(rr[0]), __uint_as_float(rr[1])); }
  alpha = 1.f;
  if (__builtin_expect(!__all(pmax - m_reg <= THR / SCALE), 0)) {
    asm volatile("" ::: "memory");
    const float mn = fmaxf(m_reg, pmax); alpha = __builtin_amdgcn_exp2f((m_reg - mn) * C); m_reg = mn; mnC = -mn * C; }
  pv_one<1>(o[1], vb, pa0, pa1, pa2, pa3);
#pragma unroll
  for (int r = 0; r < 16; ++r) p0[r] = fmaf(p0[r], C, mnC);
#pragma unroll
  for (int r = 0; r < 8; ++r) p0[r] = __builtin_amdgcn_exp2f(p0[r]);
  pv_one<2>(o[2], vb, pa0, pa1, pa2, pa3);
#pragma unroll
  for (int r = 8; r < 16; ++r) p0[r] = __builtin_amdgcn_exp2f(p0[r]);
#pragma unroll
  for (int r = 0; r < 8; ++r) p1[r] = fmaf(p1[r], C, mnC);
  pv_one<3>(o[3], vb, pa0, pa1, pa2, pa3);
#pragma unroll
  for (int r = 8; r < 16; ++r) p1[r] = fmaf(p1[r], C, mnC);
  asm volatile("" : "+v"(p0), "+v"(p1));
}
__device__ __forceinline__ void pv_fast(f32x16* o, int vb, bf16x8 pa0, bf16x8 pa1, bf16x8 pa2, bf16x8 pa3, f32x16& p0) {
  pv_one<0>(o[0], vb, pa0, pa1, pa2, pa3);
#pragma unroll
  for (int r = 0; r < 4; ++r) p0[r] = __builtin_amdgcn_exp2f(p0[r]);
  pv_one<1>(o[1], vb, pa0, pa1, pa2, pa3);
#pragma unroll
  for (int r = 4; r < 8; ++r) p0[r] = __builtin_amdgcn_exp2f(p0[r]);
  pv_one<2>(o[2], vb, pa0, pa1, pa2, pa3);
#pragma unroll
  for (int r = 8; r < 12; ++r) p0[r] = __builtin_amdgcn_exp2f(p0[r]);
  pv_one<3>(o[3], vb, pa0, pa1, pa2, pa3);
#pragma unroll
  for (int r = 12; r < 16; ++r) p0[r] = __builtin_amdgcn_exp2f(p0[r]);
  asm volatile("" : "+v"(p0));
}
__device__ __forceinline__ void pv_d0(f32x16* o, int vb, bf16x8 pa0, bf16x8 pa1, bf16x8 pa2, bf16x8 pa3) {
  pv_one<0>(o[0], vb, pa0, pa1, pa2, pa3); pv_one<1>(o[1], vb, pa0, pa1, pa2, pa3); pv_one<2>(o[2], vb, pa0, pa1, pa2, pa3); pv_one<3>(o[3], vb, pa0, pa1, pa2, pa3);
}

constexpr int ATT_FLAG_OFF = 159744 + 768;
#ifndef ATT_FORCE_SLOW
#define ATT_FORCE_SLOW 0
#endif
template <int DR, int QPARK, int SDEPTH, int LDQ, int LDK, int LDV, int LDO, bool O8 = false, bool FAST = false>
__device__ __forceinline__ bool attn_body(const bf16_t* __restrict__ Qb, const bf16_t* __restrict__ Kh, const bf16_t* __restrict__ Vh, const bf16_t* __restrict__ KRh,
                                          bf16_t* __restrict__ Ob, int seq, char* lds) {
  constexpr int NQ = (QPARK < 0) ? 8 + DR / 16 : (QPARK == 8 ? 1 : 8 - QPARK);
  constexpr int QPB = (QPARK < 0) ? 0 : (DR / 16 + QPARK) * 1024;
  static_assert(LDK == LDV, "K and V share the staging offsets");
  const int tid = opaque_v(my_tid()), wid = tid >> 6, lane = tid & 63, r32 = lane & 31, hi = lane >> 5;
  char* V_lds = lds + OFF_V; char* K_lds = lds + OFF_K; char* KR_lds = lds + OFF_KR;
  float* ws = (float*)(lds + OFF_WS) + wid * 64; float* li_l = ws; float* al_l = ws + 32;
  float m_reg = -1e30f, l_reg = 0; f32x16 o[4] = {}; bf16x8 qr[NQ];
  if constexpr (FAST) { if (tid == 0) *(volatile LAS unsigned*)(unsigned long)ATT_FLAG_OFF = 0u; }
  const bf16_t* Qw = Qb + (long)(wid * QBLK + r32) * LDQ + hi * 8;
#pragma unroll
  for (int d0 = 0; d0 < NQ; ++d0) { if constexpr (QPARK == 8) qr[d0] = bf16x8{}; else qr[d0] = ld8(Qw + d0 * 16); }
  char* QRs = lds + OFF_QR + wid * QPB + lane * 16;
  if constexpr (QPARK >= 0) {
#pragma unroll
    for (int d0 = 0; d0 < DR / 16; ++d0) *(bf16x8*)(QRs + d0 * 1024) = ld8(Qw + 128 + d0 * 16);
#pragma unroll
    for (int d0 = 8 - QPARK; d0 < 8; ++d0) *(bf16x8*)(QRs + (4 + d0 - (8 - QPARK)) * 1024) = ld8(Qw + d0 * 16);
  }
  const int sr = tid >> 4, sc = (tid & 15) * 8, vst0 = v_st(sr, sc), vst1 = v_st(32 + sr, sc);
  const int krr = tid >> 3, krc = (tid & 7) * 8;
  const int vb0 = (int)(uintptr_t)V_lds + v_rd_base(lane);
  struct { bf16x8 vs0, vs1, ks0, ks1, kr; } sr_[SDEPTH];
  const unsigned soff0 = (unsigned)(sr * LDK + sc) * 2u, soff1 = soff0 + (unsigned)(32 * LDK * 2), sofr = (unsigned)(krr * 64 + krc) * 2u;
  const __amdgpu_buffer_rsrc_t rsV = __builtin_amdgcn_make_buffer_rsrc((void*)Vh, 0, 0x7ffffff0, 0x00020000), rsK = __builtin_amdgcn_make_buffer_rsrc((void*)Kh, 0, 0x7ffffff0, 0x00020000);
  const __amdgpu_buffer_rsrc_t rsR = __builtin_amdgcn_make_buffer_rsrc((void*)(DR > 0 ? KRh : Kh), 0, 0x7ffffff0, 0x00020000);
#define BL128(rs, vo, so) __builtin_bit_cast(bf16x8, __builtin_amdgcn_raw_buffer_load_b128(rs, (int)(vo), (int)(so), 0))
#define SLOAD(i, k0) do { const unsigned so_ = (unsigned)(k0) * (unsigned)(LDV * 2); \
    sr_[i].vs0 = BL128(rsV, soff0, so_); sr_[i].vs1 = BL128(rsV, soff1, so_); \
    sr_[i].ks0 = BL128(rsK, soff0, so_); sr_[i].ks1 = BL128(rsK, soff1, so_); \
    if constexpr (DR > 0) sr_[i].kr = BL128(rsR, sofr, (unsigned)(k0) * 128u); } while (0)
#define SWRITE(b, i) do { *(bf16x8*)(V_lds + (b) * SHM_V + vst0) = sr_[i].vs0;          \
    *(bf16x8*)(V_lds + (b) * SHM_V + vst1) = sr_[i].vs1; int kc = sc * 2;               \
    *(bf16x8*)(K_lds + (b) * SHM_K + KSWZ(sr, kc)) = sr_[i].ks0;                       \
    *(bf16x8*)(K_lds + (b) * SHM_K + KSWZ(32 + sr, kc)) = sr_[i].ks1;                  \
    if constexpr (DR > 0) *(bf16x8*)(KR_lds + (b) * SHM_KR + KRSWZ(krr, krc * 2)) = sr_[i].kr; } while (0)
#define SWAIT() do { if constexpr (SDEPTH == 2) { if constexpr (DR > 0) asm volatile("s_waitcnt vmcnt(5)" ::: "memory"); else asm volatile("s_waitcnt vmcnt(4)" ::: "memory"); } \
    else asm volatile("s_waitcnt vmcnt(0)" ::: "memory"); } while (0)
#define RESC(a) do { if (__any((a) < 1.f)) { if (hi == 0) al_l[r32] = (a); asm volatile("s_waitcnt lgkmcnt(0)" ::: "memory"); \
    _Pragma("unroll") for (int d = 0; d < 4; ++d) _Pragma("unroll") for (int r = 0; r < 16; ++r) o[d][r] *= al_l[crow(r, hi)]; } } while (0)
  f32x16 pA0, pA1, pB0, pB1; float mnA, mnB, alA, alB; bf16x8 pa0, pa1, pa2, pa3; const int NT = seq / KVBLK;
  constexpr int SE = 0, SO = SDEPTH - 1;
  SLOAD(SE, 0); asm volatile("s_waitcnt vmcnt(0)" ::: "memory"); SWRITE(0, SE); __syncthreads();
  qkt<DR, QPARK>(pA0, pA1, K_lds, KR_lds, qr, QRs, r32, hi);
  if constexpr (FAST) exp16(pA0); else partialSM<DR>(pA0, pA1, m_reg, mnA, alA);
  float mnC_ = -m_reg * (Cfg<DR>::SCALE * 1.4426950408889634f);
  SLOAD(SO, KVBLK); if constexpr (SDEPTH == 2) { if (2 < NT) SLOAD(SE, 2 * KVBLK); }
  SWAIT(); SWRITE(1, SO); __syncthreads();
  for (int j = 1; j + 1 < NT; j += 2) {
    SBAR(); qkt<DR, QPARK>(pB0, pB1, K_lds + SHM_K, KR_lds + SHM_KR, qr, QRs, r32, hi);
    if constexpr (FAST) finishSM_fast(pA0, pA1, l_reg, pa0, pa1, pa2, pa3); else finishSM(pA0, pA1, alA, l_reg, pa0, pa1, pa2, pa3);
    seg1_sched<DR>(); SBAR();
    SLOAD(SO, (j + SDEPTH) * KVBLK); SBAR();
    if constexpr (FAST) pv_fast(o, vb0, pa0, pa1, pa2, pa3, pB0); else pv_partialSM<DR>(o, vb0, pa0, pa1, pa2, pa3, pB0, pB1, m_reg, mnC_, alB);
    __syncthreads(); SWAIT(); SWRITE(0, SE);
    if constexpr (!FAST) RESC(alB);
    __syncthreads();
    SBAR(); qkt<DR, QPARK>(pA0, pA1, K_lds, KR_lds, qr, QRs, r32, hi);
    if constexpr (FAST) finishSM_fast(pB0, pB1, l_reg, pa0, pa1, pa2, pa3); else finishSM(pB0, pB1, alB, l_reg, pa0, pa1, pa2, pa3);
    seg1_sched<DR>(); SBAR();
    if (SDEPTH == 1 || j + 3 < NT) SLOAD(SE, (j + 1 + SDEPTH) * KVBLK); SBAR();
    if constexpr (FAST) pv_fast(o, vb0 + (int)SHM_V, pa0, pa1, pa2, pa3, pA0); else pv_partialSM<DR>(o, vb0 + (int)SHM_V, pa0, pa1, pa2, pa3, pA0, pA1, m_reg, mnC_, alA);
    __syncthreads(); SWAIT(); SWRITE(1, SO);
    if constexpr (!FAST) RESC(alA);
    __syncthreads();
  }
  SBAR(); qkt<DR, QPARK>(pB0, pB1, K_lds + SHM_K, KR_lds + SHM_KR, qr, QRs, r32, hi);
  if constexpr (FAST) { finishSM_fast(pA0, pA1, l_reg, pa0, pa1, pa2, pa3); SBAR(); pv_fast(o, vb0, pa0, pa1, pa2, pa3, pB0); __syncthreads();
    finishSM_fast(pB0, pB1, l_reg, pa0, pa1, pa2, pa3); SBAR(); }
  else {
  finishSM(pA0, pA1, alA, l_reg, pa0, pa1, pa2, pa3); SBAR();
  pv_d0(o, vb0, pa0, pa1, pa2, pa3); partialSM<DR>(pB0, pB1, m_reg, mnB, alB);
  __syncthreads(); RESC(alB);
  finishSM(pB0, pB1, alB, l_reg, pa0, pa1, pa2, pa3); SBAR(); }
  pv_d0(o, vb0 + (int)SHM_V, pa0, pa1, pa2, pa3);
  if constexpr (FAST) {
    const bool bad = ATT_FORCE_SLOW || !(l_reg > 1e-30f && l_reg < 1e30f);
    if (__any(bad) && lane == 0) *(volatile LAS unsigned*)(unsigned long)ATT_FLAG_OFF = 1u;
    __syncthreads();
    const unsigned wgbad = *(volatile LAS unsigned*)(unsigned long)ATT_FLAG_OFF;
    if (wgbad) { __syncthreads(); return true; }
  }
  if (hi == 0) li_l[r32] = l_reg; asm volatile("s_waitcnt lgkmcnt(0)" ::: "memory");
  float rli[16];
#pragma unroll
  for (int r = 0; r < 16; ++r) rli[r] = __builtin_amdgcn_rcpf(li_l[crow(r, hi)]);
  bf16_t* Ow = Ob + (long)(wid * QBLK) * LDO;
#pragma unroll
  for (int r = 0; r < 16; ++r) { int orow = crow(r, hi);
#pragma unroll
    for (int d0 = 0; d0 < 4; ++d0) {
      if constexpr (O8) { const float v = fminf(fmaxf(o[d0][r] * rli[r] * 64.0f, -448.f), 448.f);
        ((unsigned char*)Ob)[(long)(wid * QBLK + orow) * LDO + d0 * 32 + r32] = (unsigned char)(__builtin_amdgcn_cvt_pk_fp8_f32(v, 0.f, 0u, false) & 0xffu); }
      else { const unsigned w = cvtpk(o[d0][r] * rli[r], 0.f); Ow[(long)orow * LDO + d0 * 32 + r32] = (bf16_t)(w & 0xffffu); } } }
  __syncthreads();
  return false;
#undef SLOAD
#undef SWRITE
#undef SWAIT
#undef RESC
}
}

__device__ __forceinline__ int rope_perm128(int j) { return j < 64 ? 2 * j : 2 * (j - 64) + 1; }
__device__ __forceinline__ int rope_perm64(int r) { return r < 32 ? 2 * r : 2 * (r - 32) + 1; }
template <int MODE> __device__ __forceinline__ int rowmap(int n) {
    if constexpr (MODE == 0) return n;
    else if constexpr (MODE == 1) {
        if (n < 1280) return (n & ~127) + rope_perm128(n & 127);
        if (n < 1536) return n;
        if (n < 3072) { const int q = n - 1536, h = q / 192, j = q % 192; return 1536 + h * 192 + (j < 128 ? j : 128 + rope_perm64(j - 128)); }
        if (n < 3584) return n;
        if (n < 3648) return C_KR + rope_perm64(n - 3584);
        return n + 192;
    } else if constexpr (MODE == 2) return (n >> 7) * 256 + (n & 127);
    else return (n >> 7) * 256 + 128 + (n & 127);
}
template <int MODE>
__device__ __forceinline__ void tr_item(const float* __restrict__ W, int N, int K, bf16_t* __restrict__ WT, int row_off, const float* __restrict__ kscale, LAS float* scr, int item, int lane) {
    const int nblk = N / 32, kb = item / nblk, nb = item % nblk, k0 = 64 * kb, n0 = 32 * nb;
    f32x4 v[8];
#pragma unroll
    for (int i = 0; i < 8; ++i) { const int kk = 8 * i + (lane >> 3); v[i] = *(const f32x4*)(W + (size_t)(k0 + kk) * N + n0 + (lane & 7) * 4); }
    if (kscale) {
#pragma unroll
        for (int i = 0; i < 8; ++i) { const int kk = 8 * i + (lane >> 3); v[i] = v[i] * kscale[k0 + kk]; }
    }
#pragma unroll
    for (int i = 0; i < 8; ++i) { const int kk = 8 * i + (lane >> 3); LAS float* d = scr + kk * 33 + (lane & 7) * 4; d[0] = v[i].x; d[1] = v[i].y; d[2] = v[i].z; d[3] = v[i].w; }
    LDS_WAIT(); asm volatile("" ::: "memory");
    const int c = lane & 7;
#pragma unroll
    for (int j = 0; j < 4; ++j) { const int n = (lane >> 3) + 8 * j; const LAS float* s = scr + (8 * c) * 33 + n;
        u32x4 o; o.x = cvt_pk_bf16(s[0 * 33], s[1 * 33]); o.y = cvt_pk_bf16(s[2 * 33], s[3 * 33]); o.z = cvt_pk_bf16(s[4 * 33], s[5 * 33]); o.w = cvt_pk_bf16(s[6 * 33], s[7 * 33]);
        *(u32x4*)(WT + (size_t)(row_off + rowmap<MODE>(n0 + n)) * K + k0 + 8 * c) = o; }
    LDS_WAIT(); asm volatile("" ::: "memory");
}
template <int MODE>
__device__ __forceinline__ void absmax_item(const float* __restrict__ W, int N, unsigned* cmax, int item, int lane) {
    const int nblk = N / 32, kb = item / nblk, nb = item % nblk, k0 = 256 * kb, n0 = 32 * nb;
    f32x4 m = {0.f, 0.f, 0.f, 0.f};
#pragma unroll 16
    for (int i = 0; i < 32; ++i) { const int kk = 8 * i + (lane >> 3); const f32x4 v = *(const f32x4*)(W + (size_t)(k0 + kk) * N + n0 + (lane & 7) * 4);
        m.x = fmaxf(m.x, fabsf(v.x)); m.y = fmaxf(m.y, fabsf(v.y)); m.z = fmaxf(m.z, fabsf(v.z)); m.w = fmaxf(m.w, fabsf(v.w)); }
#pragma unroll
    for (int o = 8; o < 64; o <<= 1) { m.x = fmaxf(m.x, __shfl_xor(m.x, o)); m.y = fmaxf(m.y, __shfl_xor(m.y, o)); m.z = fmaxf(m.z, __shfl_xor(m.z, o)); m.w = fmaxf(m.w, __shfl_xor(m.w, o)); }
    if (lane < 8) {
#pragma unroll
        for (int i = 0; i < 4; ++i) __hip_atomic_fetch_max(cmax + rowmap<MODE>(n0 + lane * 4 + i), __float_as_uint(m[i]), RLX_AGENT); }
}
__device__ __forceinline__ float inv127() { float k = 1.0f / 127.0f; asm volatile("" : "+v"(k)); return k; }
__device__ __forceinline__ float clamp127(float v) { return fminf(fmaxf(v, -127.0f), 127.0f); }
__device__ __forceinline__ unsigned pack_u8x4(float a, float b, float c, float d) {
    const unsigned ia = (unsigned)rintf(a), ib = (unsigned)rintf(b), ic = (unsigned)rintf(c), id = (unsigned)rintf(d);
    return ia | (ib << 8) | (ic << 16) | (id << 24);
}
__device__ __forceinline__ unsigned pack_i8x4(float a, float b, float c, float d) {
    const int ia = (int)rintf(clamp127(a)), ib = (int)rintf(clamp127(b)), ic = (int)rintf(clamp127(c)), id = (int)rintf(clamp127(d));
    return (unsigned)(ia & 255) | ((unsigned)(ib & 255) << 8) | ((unsigned)(ic & 255) << 16) | ((unsigned)(id & 255) << 24);
}
template <int MODE>
__device__ __forceinline__ void tr_item_i8(const float* __restrict__ W, int N, int K, signed char* __restrict__ WT, int row_off, const unsigned* cmax, LAS float* scr, int item, int lane) {
    const int nblk = N / 32, kb = item / nblk, nb = item % nblk, k0 = 64 * kb, n0 = 32 * nb;
    f32x4 v[8];
#pragma unroll
    for (int i = 0; i < 8; ++i) { const int kk = 8 * i + (lane >> 3); v[i] = *(const f32x4*)(W + (size_t)(k0 + kk) * N + n0 + (lane & 7) * 4); }
#pragma unroll
    for (int i = 0; i < 8; ++i) { const int kk = 8 * i + (lane >> 3); LAS float* d = scr + kk * 33 + (lane & 7) * 4; d[0] = v[i].x; d[1] = v[i].y; d[2] = v[i].z; d[3] = v[i].w; }
    LDS_WAIT(); asm volatile("" ::: "memory");
    const int c = lane & 3;
#pragma unroll
    for (int j = 0; j < 2; ++j) { const int n = (lane >> 2) + 16 * j; const int row = row_off + rowmap<MODE>(n0 + n);
        const float cm = __uint_as_float(cmax[row]); const float inv = cm > 0.f ? 127.0f / cm : 0.f; const LAS float* sp = scr + (16 * c) * 33 + n;
        u32x4 o;
#pragma unroll
        for (int q = 0; q < 4; ++q) o[q] = pack_i8x4(sp[(4 * q) * 33] * inv, sp[(4 * q + 1) * 33] * inv, sp[(4 * q + 2) * 33] * inv, sp[(4 * q + 3) * 33] * inv);
        *(u32x4*)(WT + (size_t)row * K + k0 + 16 * c) = o; }
    LDS_WAIT(); asm volatile("" ::: "memory");
}
__device__ __forceinline__ void tr_load(const float* __restrict__ W, int N, int item, int lane, f32x4 (&v)[8]) {
    const int nblk = N / 32, kb = item / nblk, nb = item % nblk, k0 = 64 * kb, n0 = 32 * nb;
#pragma unroll
    for (int i = 0; i < 8; ++i) { const int kk = 8 * i + (lane >> 3); v[i] = *(const f32x4*)(W + (size_t)(k0 + kk) * N + n0 + (lane & 7) * 4); }
}
template <int MODE>
__device__ __forceinline__ void tr_store_bf16(const f32x4 (&v)[8], int N, int K, bf16_t* __restrict__ WT, int row_off, LAS float* scr, int item, int lane) {
    const int nblk = N / 32, kb = item / nblk, nb = item % nblk, k0 = 64 * kb, n0 = 32 * nb;
#pragma unroll
    for (int i = 0; i < 8; ++i) { const int kk = 8 * i + (lane >> 3); LAS float* d = scr + kk * 33 + (lane & 7) * 4; d[0] = v[i].x; d[1] = v[i].y; d[2] = v[i].z; d[3] = v[i].w; }
    LDS_WAIT(); asm volatile("" ::: "memory");
    const int c = lane & 7;
#pragma unroll
    for (int j = 0; j < 4; ++j) { const int n = (lane >> 3) + 8 * j; const LAS float* s = scr + (8 * c) * 33 + n;
        u32x4 o; o.x = cvt_pk_bf16(s[0 * 33], s[1 * 33]); o.y = cvt_pk_bf16(s[2 * 33], s[3 * 33]); o.z = cvt_pk_bf16(s[4 * 33], s[5 * 33]); o.w = cvt_pk_bf16(s[6 * 33], s[7 * 33]);
        *(u32x4*)(WT + (size_t)(row_off + rowmap<MODE>(n0 + n)) * K + k0 + 8 * c) = o; }
    LDS_WAIT(); asm volatile("" ::: "memory");
}
template <int MODE>
__device__ __forceinline__ void tr_store_i8(const f32x4 (&v)[8], int N, int K, signed char* __restrict__ WT, int row_off, const unsigned* cmax, LAS float* scr, int item, int lane) {
    const int nblk = N / 32, kb = item / nblk, nb = item % nblk, k0 = 64 * kb, n0 = 32 * nb;
#pragma unroll
    for (int i = 0; i < 8; ++i) { const int kk = 8 * i + (lane >> 3); LAS float* d = scr + kk * 33 + (lane & 7) * 4; d[0] = v[i].x; d[1] = v[i].y; d[2] = v[i].z; d[3] = v[i].w; }
    LDS_WAIT(); asm volatile("" ::: "memory");
    const int c = lane & 3;
#pragma unroll
    for (int j = 0; j < 2; ++j) { const int n = (lane >> 2) + 16 * j; const int row = row_off + rowmap<MODE>(n0 + n);
        const float cm = __uint_as_float(cmax[row]); const float inv = cm > 0.f ? 127.0f / cm : 0.f; const LAS float* sp = scr + (16 * c) * 33 + n;
        u32x4 o;
#pragma unroll
        for (int q = 0; q < 4; ++q) o[q] = pack_i8x4(sp[(4 * q) * 33] * inv, sp[(4 * q + 1) * 33] * inv, sp[(4 * q + 2) * 33] * inv, sp[(4 * q + 3) * 33] * inv);
        *(u32x4*)(WT + (size_t)row * K + k0 + 16 * c) = o; }
    LDS_WAIT(); asm volatile("" ::: "memory");
}
__device__ __forceinline__ void sincos_d(double a, float& s, float& c) {
    const double twopi = 6.283185307179586476925286766559;
    const double r = a - twopi * rint(a / twopi), r2 = r * r;
    double ts = 1.0, tc = 1.0;
#pragma unroll
    for (int k = 16; k >= 1; --k) { ts = 1.0 - ts * r2 / (double)((2 * k) * (2 * k + 1)); tc = 1.0 - tc * r2 / (double)((2 * k - 1) * (2 * k)); }
    s = (float)(r * ts); c = (float)tc;
}

__device__ __forceinline__ float clamp448(float v) {
    float t; asm("v_min_f32 %0, |%1|, %2" : "=v"(t) : "v"(v), "s"(448.0f)); float r; asm("v_bfi_b32 %0, %1, %2, %3" : "=v"(r) : "s"(0x7fffffff), "v"(t), "v"(v)); return r; }
__device__ __forceinline__ unsigned pack_f8x4(float a, float b, float c, float d) {
    a = clamp448(a); b = clamp448(b); c = clamp448(c); d = clamp448(d);
    unsigned w = 0; w = __builtin_amdgcn_cvt_pk_fp8_f32(a, b, w, false); w = __builtin_amdgcn_cvt_pk_fp8_f32(c, d, w, true); return w;
}
template <int KROWS>
__device__ __forceinline__ void w_block_f8(const float* __restrict__ W, const float* __restrict__ W2, int N, int n0, unsigned char* __restrict__ WT8, int dstride, int koff, float* invs, LAS unsigned char* lds, int wave, int lane) {
    constexpr int TSB = 4104, RPW = KROWS / 8;
    LAS float* wm = (LAS float*)(lds + 32 * TSB);
    const int c4 = (lane & 7) * 4;
    float m0 = 0.f, m1 = 0.f, m2 = 0.f, m3 = 0.f;
#pragma unroll 1
    for (int bt = 0; bt < RPW / 64; ++bt) {
        f32x4 v[8];
#pragma unroll
        for (int i = 0; i < 8; ++i) { const int kk = wave * RPW + bt * 64 + i * 8 + (lane >> 3); v[i] = *(const f32x4*)((kk < KROWS / 2 ? W : W2 - (size_t)(KROWS / 2) * N) + (size_t)kk * N + n0 + c4); }
#pragma unroll
        for (int i = 0; i < 8; ++i) { const int kk = wave * RPW + bt * 64 + i * 8 + (lane >> 3);
            m0 = fmaxf(m0, fabsf(v[i].x)); m1 = fmaxf(m1, fabsf(v[i].y)); m2 = fmaxf(m2, fabsf(v[i].z)); m3 = fmaxf(m3, fabsf(v[i].w));
            const unsigned p01 = cvt_pk_bf16(v[i].x, v[i].y), p23 = cvt_pk_bf16(v[i].z, v[i].w);
            *(LAS bf16_t*)(lds + (c4 + 0) * TSB + kk * 2) = (bf16_t)(p01 & 0xffffu); *(LAS bf16_t*)(lds + (c4 + 1) * TSB + kk * 2) = (bf16_t)(p01 >> 16);
            *(LAS bf16_t*)(lds + (c4 + 2) * TSB + kk * 2) = (bf16_t)(p23 & 0xffffu); *(LAS bf16_t*)(lds + (c4 + 3) * TSB + kk * 2) = (bf16_t)(p23 >> 16); }
    }
#pragma unroll
    for (int o = 8; o < 64; o <<= 1) { m0 = fmaxf(m0, __shfl_xor(m0, o)); m1 = fmaxf(m1, __shfl_xor(m1, o)); m2 = fmaxf(m2, __shfl_xor(m2, o)); m3 = fmaxf(m3, __shfl_xor(m3, o)); }
    if (lane < 8) { wm[wave * 32 + c4] = m0; wm[wave * 32 + c4 + 1] = m1; wm[wave * 32 + c4 + 2] = m2; wm[wave * 32 + c4 + 3] = m3; }
    __syncthreads();
#pragma unroll 1
    for (int r = 0; r < 4; ++r) { const int n = wave * 4 + r; float cm = wm[n];
#pragma unroll
        for (int w = 1; w < 8; ++w) cm = fmaxf(cm, wm[w * 32 + n]);
        const float sc = cm > 0.f ? exp2f(floorf(log2f(224.0f / cm))) : 1.0f;
        if (lane == 0) invs[n0 + n] = 1.0f / sc;
#pragma unroll
        for (int j = 0; j < KROWS / 256; ++j) { const int ch = j * 64 + lane; const u32x2 w = *(const LAS u32x2*)(lds + n * TSB + ch * 8);
            *(unsigned*)(WT8 + (size_t)(n0 + n) * dstride + koff + ch * 4) = pack_f8x4(bflo(w.x) * sc, bfhi(w.x) * sc, bflo(w.y) * sc, bfhi(w.y) * sc); } }
    __syncthreads();
}
struct Ptrs {
    const float *x, *c, *ctx, *c_ctx, *w_mod, *b_mod, *norm_mix, *norm_ffn, *w_in, *a_q_norm, *a_k_norm, *b_kv_norm, *w_ukv, *w_br_a, *w_br_b, *w_out,
                *w_group, *b_group, *w_router, *b_router, *w_e_gate, *w_e_up, *w_e_down, *norm_final;
    float* out; unsigned char* ws;
};

__device__ __forceinline__ void p0_prologue(const Ptrs& P, LAS unsigned char* lds, int G, int blk, int gw, int NGW, int wave, int lane) {
    LAS float* scr = (LAS float*)(lds + wave * 16384);
    unsigned char* ws = P.ws;
    bf16_t* WIN = (bf16_t*)(ws + WS_WIN); bf16_t* WUKV = (bf16_t*)(ws + WS_WUKV);
    constexpr int I_GEMV = 48 * 32, I_ROPE = 64, I_ZERO = 192;
    constexpr int I_IN = (DM / 256) * (DIN / 32), I_UKV = (512 / 64) * (2048 / 32), I_BR = (1024 / 64) * (2048 / 32), I_OUT = (2048 / 256) * (2048 / 32);
    constexpr int NITEMS = I_GEMV + I_ROPE + I_ZERO + I_IN + I_UKV;
    for (int it = blk; it < 128; it += G) {
        if (it < 64) w_block_f8<2048>(P.w_br_a, P.w_br_b, 2048, it * 32, ws + WS_WBRA, 2048, 0, (float*)(ws + WS_SAO), lds, wave, lane);
        else w_block_f8<2048>(P.w_out, P.w_out + (size_t)1024 * 2048, 2048, (it - 64) * 32, ws + WS_WOUT, 2048, 0, (float*)(ws + WS_SAO) + 2048, lds, wave, lane); }
    for (int it = gw; it < NITEMS; it += NGW) {
        int r = it;
        if (r < I_GEMV) {
            const int nc = r % 48, kc = r / 48, n = nc * 256 + lane * 4, k0 = kc * 64;
            float sv[5];
#pragma unroll
            for (int q = 0; q < 5; ++q) { const float cv = (q < 4) ? P.c[q * DM + k0 + lane] : P.c_ctx[k0 + lane]; sv[q] = cv * sigmoidf_(cv); }
            f32x4 a[5];
#pragma unroll
            for (int q = 0; q < 5; ++q) a[q] = (f32x4){0.f, 0.f, 0.f, 0.f};
#pragma unroll 16
            for (int kk = 0; kk < 64; ++kk) { const f32x4 w = *(const f32x4*)(P.w_mod + (size_t)(k0 + kk) * NMOD + n);
#pragma unroll
                for (int q = 0; q < 5; ++q) { const float s = __uint_as_float(__builtin_amdgcn_readlane(__float_as_uint(sv[q]), kk)); a[q] += w * s; } }
            float* MP = (float*)(ws + WS_MODP);
#pragma unroll
            for (int q = 0; q < 5; ++q) *(f32x4*)(MP + (size_t)(kc * 5 + q) * NMOD + n) = a[q];
            continue;
        } r -= I_GEMV;
        if (r < I_ROPE) {
            if (lane < 32) { const float fr = powf(10000.0f, -(float)lane / 32.0f); const float ang = (float)r * fr; float s, c; sincos_d((double)ang, s, c);
                ((f32x2*)(ws + WS_ROPEA))[r * 32 + lane] = (f32x2){c, s}; }
            if (lane < 16) { const float fr = powf(10000.0f, -(float)lane / 16.0f); const float ang = (float)r * fr; float s, c; sincos_d((double)ang, s, c);
                ((f32x2*)(ws + WS_ROPEB))[r * 16 + lane] = (f32x2){c, s}; }
            continue;
        } r -= I_ROPE;
        if (r < I_ZERO) {
            u32x4* p = (u32x4*)((signed char*)WIN + (size_t)(3648 + r) * DM);
#pragma unroll
            for (int j = 0; j < 2; ++j) p[j * 64 + lane] = (u32x4){0u, 0u, 0u, 0u};
            continue;
        } r -= I_ZERO;
        if (r < I_IN) { absmax_item<1>(P.w_in, DIN, (unsigned*)(ws + WS_CTL) + CW_CMAX_IN, r, lane); continue; } r -= I_IN;
        if (r < I_UKV) { tr_item<0>(P.w_ukv, 2048, 512, WUKV, 0, P.b_kv_norm, scr, r, lane); continue; } r -= I_UKV;

        absmax_item<0>(P.w_out, 2048, (unsigned*)(ws + WS_CTL) + CW_CMAX_OUT, r, lane);
    }
}
template <int MODE>
__device__ __forceinline__ void gu_block_i8(const float* __restrict__ W, int n0, signed char* __restrict__ WT8, int row_off, unsigned* cmax, LAS unsigned char* lds, int wave, int lane) {
    constexpr int TSB = 4104;
    LAS float* wm = (LAS float*)(lds + 32 * TSB);
    const int c4 = (lane & 7) * 4;
    float m0 = 0.f, m1 = 0.f, m2 = 0.f, m3 = 0.f;
#pragma unroll 1
    for (int bt = 0; bt < 4; ++bt) {
        f32x4 v[8];
#pragma unroll
        for (int i = 0; i < 8; ++i) { const int kk = wave * 256 + bt * 64 + i * 8 + (lane >> 3); v[i] = *(const f32x4*)(W + (size_t)kk * 1024 + n0 + c4); }
#pragma unroll
        for (int i = 0; i < 8; ++i) { const int kk = wave * 256 + bt * 64 + i * 8 + (lane >> 3);
            m0 = fmaxf(m0, fabsf(v[i].x)); m1 = fmaxf(m1, fabsf(v[i].y)); m2 = fmaxf(m2, fabsf(v[i].z)); m3 = fmaxf(m3, fabsf(v[i].w));
            const unsigned p01 = cvt_pk_bf16(v[i].x, v[i].y), p23 = cvt_pk_bf16(v[i].z, v[i].w);
            *(LAS bf16_t*)(lds + (c4 + 0) * TSB + kk * 2) = (bf16_t)(p01 & 0xffffu); *(LAS bf16_t*)(lds + (c4 + 1) * TSB + kk * 2) = (bf16_t)(p01 >> 16);
            *(LAS bf16_t*)(lds + (c4 + 2) * TSB + kk * 2) = (bf16_t)(p23 & 0xffffu); *(LAS bf16_t*)(lds + (c4 + 3) * TSB + kk * 2) = (bf16_t)(p23 >> 16); }
    }
#pragma unroll
    for (int o = 8; o < 64; o <<= 1) { m0 = fmaxf(m0, __shfl_xor(m0, o)); m1 = fmaxf(m1, __shfl_xor(m1, o)); m2 = fmaxf(m2, __shfl_xor(m2, o)); m3 = fmaxf(m3, __shfl_xor(m3, o)); }
    if (lane < 8) { wm[wave * 32 + c4] = m0; wm[wave * 32 + c4 + 1] = m1; wm[wave * 32 + c4 + 2] = m2; wm[wave * 32 + c4 + 3] = m3; }
    __syncthreads();
#pragma unroll 1
    for (int r = 0; r < 4; ++r) { const int n = wave * 4 + r; float cm = wm[n];
#pragma unroll
        for (int w = 1; w < 8; ++w) cm = fmaxf(cm, wm[w * 32 + n]);
        const int row = row_off + rowmap<MODE>(n0 + n); if (lane == 0) cmax[row] = __float_as_uint(cm);
        const float inv = cm > 0.f ? 127.0f / cm : 0.f;
#pragma unroll
        for (int j = 0; j < 8; ++j) { const int ch = j * 64 + lane; const u32x2 w = *(const LAS u32x2*)(lds + n * TSB + ch * 8);
            *(unsigned*)(WT8 + (size_t)row * 2048 + ch * 4) = pack_i8x4(bflo(w.x) * inv, bfhi(w.x) * inv, bflo(w.y) * inv, bfhi(w.y) * inv); } }
    __syncthreads();
}
__device__ __forceinline__ void p6_expert_copies(const Ptrs& P, LAS unsigned char* lds, int G, int blk, int wave, int lane) {
    for (int it = blk; it < NEXP * 64; it += G) { const int e = it >> 6, nb = it & 63; const float* W = P.w_e_down + (size_t)e * 1024 * 2048;
        w_block_f8<1024>(W, W + (size_t)512 * 2048, 2048, nb * 32, P.ws + WS_WD + (size_t)e * 2048 * 1024, 1024, 0, (float*)(P.ws + WS_INVD) + e * 2048, lds, wave, lane); }
}
__device__ __forceinline__ void p3_expert_gateup(const Ptrs& P, LAS unsigned char* lds, int G, int blk, int wave, int lane) {
    signed char* WG8 = (signed char*)(P.ws + WS_WG); unsigned* cm = (unsigned*)(P.ws + WS_CTL) + CW_CMAX_WG;
    for (int it = blk; it < NEXP * 2 * 32; it += G) { const int e = it >> 6, up = (it >> 5) & 1, nb = it & 31;
        if (!up) gu_block_i8<2>(P.w_e_gate + (size_t)e * 2048 * 1024, nb * 32, WG8, e * 2048, cm, lds, wave, lane);
        else     gu_block_i8<3>(P.w_e_up + (size_t)e * 2048 * 1024, nb * 32, WG8, e * 2048, cm, lds, wave, lane); }
}
__device__ __forceinline__ void p1_win_i8(const Ptrs& P, LAS unsigned char* lds, int gw, int NGW, int wave, int lane) {
    LAS float* scr = (LAS float*)(lds + wave * 16384);
    constexpr int J_IN = (DM / 64) * (DIN / 32), TOT = J_IN;
    const unsigned* ctl = (const unsigned*)(P.ws + WS_CTL);
#define P1_DECODE(it_, kind_, W_, N_, r_) do { int r0_ = (it_); \
        if (r0_ < J_IN) { kind_ = 0; W_ = P.w_in; N_ = DIN; r_ = r0_; } \
        else { kind_ = 0; W_ = P.w_in; N_ = DIN; r_ = 0; } } while (0)
    f32x4 vn[8]; int kind, N, r; const float* W;
    if (gw < TOT) { P1_DECODE(gw, kind, W, N, r); tr_load(W, N, r, lane, vn); }
#pragma unroll 1
    for (int it = gw; it < TOT; it += NGW) {
        f32x4 vc[8];
#pragma unroll
        for (int i = 0; i < 8; ++i) vc[i] = vn[i];
        const int ckind = kind, cr = r;
        if (it + NGW < TOT) { P1_DECODE(it + NGW, kind, W, N, r); tr_load(W, N, r, lane, vn); }
        if (ckind == 0) tr_store_i8<1>(vc, DIN, DM, (signed char*)(P.ws + WS_WIN), 0, ctl + CW_CMAX_IN, scr, cr, lane);
    }
#undef P1_DECODE
}
template <int C>
__device__ __forceinline__ void requant_rows(const bf16_t* __restrict__ src, signed char* __restrict__ dst, float* __restrict__ sc, int R, int gw, int NGW, int lane) {
    constexpr int NV = C / 512;
    for (int row = gw; row < R; row += NGW) {
        u32x4 w[NV]; float am = 0.f;
#pragma unroll
        for (int j = 0; j < NV; ++j) { w[j] = *(const u32x4*)(src + (size_t)row * C + (j * 64 + lane) * 8);
#pragma unroll
            for (int i = 0; i < 4; ++i) am = fmaxf(am, fmaxf(fabsf(bflo(w[j][i])), fabsf(bfhi(w[j][i])))); }
#pragma unroll
        for (int o = 1; o < 64; o <<= 1) am = fmaxf(am, __shfl_xor(am, o));
        const float inv = am > 0.f ? 127.0f / am : 0.f;
        if (lane == 0) sc[row] = am * (1.0f / 127.0f);
#pragma unroll
        for (int j = 0; j < NV; ++j) { u32x2 o;
            o.x = pack_i8x4(bflo(w[j].x) * inv, bfhi(w[j].x) * inv, bflo(w[j].y) * inv, bfhi(w[j].y) * inv);
            o.y = pack_i8x4(bflo(w[j].z) * inv, bfhi(w[j].z) * inv, bflo(w[j].w) * inv, bfhi(w[j].w) * inv);
            *(u32x2*)(dst + (size_t)row * C + (j * 64 + lane) * 8) = o; }
    }
}
__device__ __forceinline__ void p1_modreduce(const Ptrs& P, int gtid, int NGT) {
    const float* MP = (const float*)(P.ws + WS_MODP); float* MOD = (float*)(P.ws + WS_MOD);
    for (int idx = gtid; idx < 5 * NMOD; idx += NGT) { const int q = idx / NMOD, n = idx % NMOD; float s = P.b_mod[n];
#pragma unroll 8
        for (int kc = 0; kc < 32; ++kc) s += MP[(size_t)(kc * 5 + q) * NMOD + n];
        MOD[idx] = s; }
}
__device__ __forceinline__ void p2_hx(const Ptrs& P, int gw, int NGW, int lane) {
    const float* MOD = (const float*)(P.ws + WS_MOD); signed char* HX8 = (signed char*)(P.ws + WS_R1);
    for (int t = gw; t < 80; t += NGW) {
        const int b = t / 20, j = t % 20; const float* sh2 = MOD + (size_t)b * NMOD + 3 * DM; float a = 0.f;
        for (int i = 0; i < 32; ++i) { const int k = i * 64 + lane; const float w = (j < 4) ? P.w_group[(size_t)k * 4 + j] : P.w_router[((size_t)((j - 4) >> 2) * DM + k) * 4 + ((j - 4) & 3)]; a += sh2[k] * w; }
        a = wave_sum(a);
        if (lane == 0) ((float*)(P.ws + WS_BIASR))[t] = a + ((j < 4) ? P.b_group[j] : P.b_router[j - 4]);
    }
#define P2_SRC(kr_) (((kr_) % KEYS) < CTXL ? P.ctx + ((size_t)((kr_) / KEYS) * CTXL + ((kr_) % KEYS)) * DM : P.x + ((size_t)((kr_) / KEYS) * SEQ + (((kr_) % KEYS) - CTXL)) * DM)
    f32x4 vn[8];
    if (gw < NKEY) { const float* s0 = P2_SRC(gw);
#pragma unroll
        for (int j = 0; j < 8; ++j) vn[j] = *(const f32x4*)(s0 + j * 256 + lane * 4); }
#pragma unroll 1
    for (int kr = gw; kr < NKEY; kr += NGW) {
        const int b = kr / KEYS, t = kr % KEYS; const bool isctx = t < CTXL;
        const float* md = MOD + (size_t)(isctx ? 4 : b) * NMOD;
        f32x4 v[8]; float ss = 0.f;
#pragma unroll
        for (int j = 0; j < 8; ++j) v[j] = vn[j];
        if (kr + NGW < NKEY) { const float* s1 = P2_SRC(kr + NGW);
#pragma unroll
            for (int j = 0; j < 8; ++j) vn[j] = *(const f32x4*)(s1 + j * 256 + lane * 4); }
#pragma unroll
        for (int j = 0; j < 8; ++j) ss += (v[j].x * v[j].x + v[j].y * v[j].y) + (v[j].z * v[j].z + v[j].w * v[j].w);
        const float rstd = rsqrtf(wave_sum(ss) * (1.0f / DM) + EPS);
        float am = 0.f;
#pragma unroll
        for (int j = 0; j < 8; ++j) { const int col = j * 256 + lane * 4;
            const f32x4 g = *(const f32x4*)(P.norm_mix + col), sh = *(const f32x4*)(md + col), sc = *(const f32x4*)(md + DM + col);
            v[j] = (v[j] * rstd) * g * (sc + 1.0f) + sh;
            am = fmaxf(fmaxf(am, fmaxf(fabsf(v[j].x), fabsf(v[j].y))), fmaxf(fabsf(v[j].z), fabsf(v[j].w))); }
#pragma unroll
        for (int o = 1; o < 64; o <<= 1) am = fmaxf(am, __shfl_xor(am, o));
        const float inv = am > 0.f ? 127.0f / am : 0.f;
        if (lane == 0) ((float*)(P.ws + WS_SAHX))[kr] = am * (1.0f / 127.0f);
#pragma unroll
        for (int j = 0; j < 8; ++j) *(unsigned*)(HX8 + (size_t)kr * DM + j * 256 + lane * 4) = pack_i8x4(v[j].x * inv, v[j].y * inv, v[j].z * inv, v[j].w * inv);
    }
}
__device__ __forceinline__ unsigned rope_pair(float x1, float x2, f32x2 cs) { return cvt_pk_bf16(x1 * cs.x - x2 * cs.y, x1 * cs.y + x2 * cs.x); }
__device__ __forceinline__ void p4_post(const Ptrs& P, int row_lo, int row_hi, int wave, int lane) {
    unsigned char* r2 = P.ws + WS_R2;
    bf16_t* QA = (bf16_t*)(r2 + R2_QA); bf16_t* KA = (bf16_t*)(r2 + R2_KA); bf16_t* QB = (bf16_t*)(r2 + R2_QB); bf16_t* CKV = (bf16_t*)(r2 + R2_CKV); bf16_t* KR = (bf16_t*)(r2 + R2_KR);
    const f32x2* TA = (const f32x2*)(P.ws + WS_ROPEA); const f32x2* TB = (const f32x2*)(P.ws + WS_ROPEB); float* RSTD = (float*)(P.ws + WS_RSTD);
    for (int kr = row_lo + wave; kr < row_hi; kr += NWAVES) {
        const int b = kr / KEYS, t = kr % KEYS; const bool lat = t >= CTXL; const int s = t - CTXL, prow = s >> 6, pcol = s & 63; const size_t lr = (size_t)b * SEQ + s;
        {
            u32x2 w = *(u32x2*)(KA + (size_t)kr * 256 + lane * 4);
            float e0 = bflo(w.x), e1 = bfhi(w.x), e2 = bflo(w.y), e3 = bfhi(w.y);
            float ss = (e0 * e0 + e1 * e1) + (e2 * e2 + e3 * e3);
#pragma unroll
            for (int o = 1; o < 32; o <<= 1) ss += __shfl_xor(ss, o);
            const float rstd = rsqrtf(ss * (1.0f / 128.0f) + EPS);
            const int p0 = ((lane * 4) & 127) >> 1;
            e0 *= rstd * P.a_k_norm[p0]; e1 *= rstd * P.a_k_norm[64 + p0]; e2 *= rstd * P.a_k_norm[p0 + 1]; e3 *= rstd * P.a_k_norm[65 + p0];
            if (lat) { const f32x2 c0 = (p0 < 32) ? TA[prow * 32 + p0] : TA[pcol * 32 + p0 - 32], c1 = (p0 + 1 < 32) ? TA[prow * 32 + p0 + 1] : TA[pcol * 32 + p0 + 1 - 32];
                w.x = rope_pair(e0, e1, c0); w.y = rope_pair(e2, e3, c1); }
            else { w.x = cvt_pk_bf16(e0, e1); w.y = cvt_pk_bf16(e2, e3); }
            *(u32x2*)(KA + (size_t)kr * 256 + lane * 4) = w;
        }
        if (lat) {
            if (lane < 32) {
                const unsigned w = *(const unsigned*)(KR + (size_t)kr * 64 + lane * 2);
                const f32x2 cs = (lane < 16) ? TB[prow * 16 + lane] : TB[pcol * 16 + lane - 16];
                *(unsigned*)(KR + (size_t)kr * 64 + lane * 2) = rope_pair(bflo(w), bfhi(w), cs);
            }
            {
                bf16_t* q = QA + lr * 1024 + lane * 16;
                u32x4 w0 = *(u32x4*)q, w1 = *(u32x4*)(q + 8);
                float x1[8], x2[8]; float ss = 0.f;
#pragma unroll
                for (int i = 0; i < 4; ++i) { x1[i] = bflo(w0[i]); x2[i] = bfhi(w0[i]); x1[4 + i] = bflo(w1[i]); x2[4 + i] = bfhi(w1[i]); }
#pragma unroll
                for (int i = 0; i < 8; ++i) ss += x1[i] * x1[i] + x2[i] * x2[i];
                ss += __shfl_xor(ss, 1); ss += __shfl_xor(ss, 2); ss += __shfl_xor(ss, 4);
                const float rstd = rsqrtf(ss * (1.0f / 128.0f) + EPS) * (0.08838834764831845f * 1.4426950408889634f);
                const int p0 = ((lane * 16) & 127) >> 1;
                const f32x2* tb = (p0 < 32) ? TA + prow * 32 + p0 : TA + pcol * 32 + p0 - 32;
                unsigned o[8];
#pragma unroll
                for (int i = 0; i < 8; ++i) o[i] = rope_pair(x1[i] * rstd * P.a_q_norm[p0 + i], x2[i] * rstd * P.a_q_norm[64 + p0 + i], tb[i]);
                *(u32x4*)q = (u32x4){o[0], o[1], o[2], o[3]}; *(u32x4*)(q + 8) = (u32x4){o[4], o[5], o[6], o[7]};
            }
            {
                bf16_t* q = QB + lr * 1536 + (lane >> 3) * 192 + 128 + (lane & 7) * 8;
                const u32x4 w = *(u32x4*)q; const int p0 = (lane & 7) * 4;
                const f32x2* tb = (p0 < 16) ? TB + prow * 16 + p0 : TB + pcol * 16 + p0 - 16;
                u32x4 o;
#pragma unroll
                for (int i = 0; i < 4; ++i) o[i] = rope_pair(bflo(w[i]), bfhi(w[i]), tb[i]);
                *(u32x4*)q = o;
            }
        }
    }
}
__device__ __forceinline__ void p9_route(const Ptrs& P, LAS unsigned char* lds, int G, int blk, int tid, int wave, int lane, bool do_append) {
    const float* XN = (const float*)(P.ws + WS_R3); signed char* H28 = (signed char*)(P.ws + WS_R4); const float* MOD = (const float*)(P.ws + WS_MOD); const float* BIASR = (const float*)(P.ws + WS_BIASR);
    unsigned* LIST = (unsigned*)(P.ws + WS_LIST); float* WL = (float*)(P.ws + WS_WLIST); unsigned* ctl = (unsigned*)(P.ws + WS_CTL);
    LAS f32x4* W4 = (LAS f32x4*)lds;
    LAS unsigned char* ex = lds + RING_BYTES;
    LAS int* ent_e = (LAS int*)ex; LAS float* ent_w = (LAS float*)(ex + 512); LAS int* ent_p = (LAS int*)(ex + 1024); LAS int* lcnt = (LAS int*)(ex + 1536); LAS int* lbase = (LAS int*)(ex + 1600);
    LAS float* rinfo = (LAS float*)(ex + 2048) + wave * 32;
    for (int chunk = blk; chunk < NTOK / 64; chunk += G) {
        const int b = chunk / (SEQ / 64); const float* md = MOD + (size_t)b * NMOD; const float* br = BIASR + b * 20;
        unsigned lo = (unsigned)opaque_v(lane * 16);
        f32x4 gs[8];
#pragma unroll
        for (int j = 0; j < 8; ++j) gs[j] = *(const f32x4*)((const char*)P.norm_ffn + j * 1024 + lo) * (*(const f32x4*)((const char*)(md + 4 * DM) + j * 1024 + lo) + 1.0f);
        if (tid < 16) lcnt[tid] = 0;
        for (int k = tid; k < DM; k += NWAVES * 64) W4[(((k >> 8) * 4 + (k & 3)) << 6) + ((k >> 2) & 63)] = *(const f32x4*)(P.w_group + (size_t)k * 4);
        __syncthreads();
        f32x4 vn[8];
        { const char* s0 = (const char*)(XN + (size_t)(chunk * 64 + wave * 8) * DM);
#pragma unroll
          for (int j = 0; j < 8; ++j) vn[j] = *(const f32x4*)(s0 + j * 1024 + lo); }
#pragma unroll 1
        for (int rr = 0; rr < 8; ++rr) {
            const int tok = chunk * 64 + wave * 8 + rr; const char* src = (const char*)(XN + (size_t)(tok + (rr < 7 ? 1 : 0)) * DM); lo = (unsigned)opaque_v((int)lo);
            f32x4 acc = {0.f, 0.f, 0.f, 0.f}; float ss = 0.f; f32x4 vc[8];
#pragma unroll
            for (int j = 0; j < 8; ++j) vc[j] = vn[j];
#pragma unroll
            for (int j = 0; j < 8; ++j) vn[j] = *(const f32x4*)(src + j * 1024 + lo);
#pragma unroll
            for (int j = 0; j < 8; ++j) { const f32x4 v = vc[j]; ss += (v.x * v.x + v.y * v.y) + (v.z * v.z + v.w * v.w); const f32x4 u = v * gs[j];
#pragma unroll
                for (int i = 0; i < 4; ++i) acc += W4[((j * 4 + i) << 6) + lane] * u[i]; }
            ss = wave_sum(ss);
#pragma unroll
            for (int q = 0; q < 4; ++q) acc[q] = wave_sum(acc[q]);
            const float rstd = rsqrtf(ss * (1.0f / DM) + EPS);
            const f32x4 glv = acc * rstd + *(const f32x4*)br;
            int gi = 0; float gm = glv[0];
            if (glv[1] > gm) { gm = glv[1]; gi = 1; }
            if (glv[2] > gm) { gm = glv[2]; gi = 2; }
            if (glv[3] > gm) { gm = glv[3]; gi = 3; }
            const float gsum = (expf(glv[0] - gm) + expf(glv[1] - gm)) + (expf(glv[2] - gm) + expf(glv[3] - gm));
            if (lane == 0) { rinfo[rr * 4 + 0] = rstd; rinfo[rr * 4 + 1] = 1.0f / gsum; rinfo[rr * 4 + 2] = __int_as_float(gi); }
        }
        __syncthreads();
        for (int idx = tid; idx < 4 * DM; idx += NWAVES * 64) { const int k = idx & (DM - 1); W4[(idx & ~(DM - 1)) + (((k >> 8) * 4 + (k & 3)) << 6) + ((k >> 2) & 63)] = *(const f32x4*)(P.w_router + (size_t)idx * 4); }
        LAS f32x4* SHL = (LAS f32x4*)(lds + RING_BYTES + 4096);
        LAS f32x4* GSL = SHL + 512;
        SHL[tid] = *(const f32x4*)(md + 3 * DM + tid * 4);
        GSL[tid] = *(const f32x4*)(P.norm_ffn + tid * 4) * (*(const f32x4*)(md + 4 * DM + tid * 4) + 1.0f);
        __syncthreads();
        { const char* s0 = (const char*)(XN + (size_t)(chunk * 64 + wave * 8) * DM);
#pragma unroll
          for (int j = 0; j < 8; ++j) vn[j] = *(const f32x4*)(s0 + j * 1024 + lo); }
#pragma unroll 1
        for (int rr = 0; rr < 8; ++rr) {
            const int lrow = wave * 8 + rr, tok = chunk * 64 + lrow; const char* src = (const char*)(XN + (size_t)(tok + (rr < 7 ? 1 : 0)) * DM); lo = (unsigned)opaque_v((int)lo);
            const float rstd = rinfo[rr * 4 + 0], gval = rinfo[rr * 4 + 1]; const int gi = __builtin_amdgcn_readfirstlane(__float_as_int(rinfo[rr * 4 + 2]));
            const LAS f32x4* Wg = W4 + gi * DM;
            f32x4 acc = {0.f, 0.f, 0.f, 0.f}; u32x2 hv[8]; float am = 0.f;
            const LAS f32x4* shl = (const LAS f32x4*)(unsigned long)(unsigned)opaque_v(RING_BYTES + 4096 + lane * 16);
#pragma unroll
            for (int j = 0; j < 8; ++j) { const f32x4 v = vn[j]; const f32x4 u = v * shl[512 + j * 64];
                const f32x4 h = u * rstd + shl[j * 64]; hv[j].x = cvt_pk_bf16(h.x, h.y); hv[j].y = cvt_pk_bf16(h.z, h.w);
                am = fmaxf(fmaxf(am, fmaxf(fabsf(h.x), fabsf(h.y))), fmaxf(fabsf(h.z), fabsf(h.w)));
#pragma unroll
                for (int i = 0; i < 4; ++i) acc += Wg[((j * 4 + i) << 6) + lane] * u[i];
                __builtin_amdgcn_sched_barrier(0); }
#pragma unroll
            for (int j = 0; j < 8; ++j) vn[j] = *(const f32x4*)(src + j * 1024 + lo);
            __builtin_amdgcn_sched_barrier(0);
#pragma unroll
            for (int o = 1; o < 64; o <<= 1) am = fmaxf(am, __shfl_xor(am, o));
            { const float inv = am > 0.f ? 127.0f / am : 0.f;
              if (lane == 0) ((float*)(P.ws + WS_SAH2))[tok] = am * (1.0f / 127.0f);
#pragma unroll
              for (int j = 0; j < 8; ++j) *(unsigned*)((char*)(H28 + (size_t)tok * DM) + j * 256 + (lo >> 2)) = pack_i8x4(bflo(hv[j].x) * inv, bfhi(hv[j].x) * inv, bflo(hv[j].y) * inv, bfhi(hv[j].y) * inv); }
#pragma unroll
            for (int q = 0; q < 4; ++q) acc[q] = wave_sum(acc[q]);
            const f32x4 elv = acc * rstd + *(const f32x4*)(br + 4 + gi * 4);
            int e1 = 0; float m1 = elv[0];
            if (elv[1] > m1) { m1 = elv[1]; e1 = 1; }
            if (elv[2] > m1) { m1 = elv[2]; e1 = 2; }
            if (elv[3] > m1) { m1 = elv[3]; e1 = 3; }
            int e2 = (e1 + 1) & 3; float m2 = -3.0e38f;
            if (e1 != 0 && elv[0] > m2) { m2 = elv[0]; e2 = 0; }
            if (e1 != 1 && elv[1] > m2) { m2 = elv[1]; e2 = 1; }
            if (e1 != 2 && elv[2] > m2) { m2 = elv[2]; e2 = 2; }
            if (e1 != 3 && elv[3] > m2) { m2 = elv[3]; e2 = 3; }
            const float x2 = expf(m2 - m1), w1 = gval / (1.0f + x2), w2 = gval * x2 / (1.0f + x2);
            if (lane == 0) { ent_e[lrow * 2] = gi * 4 + e1; ent_w[lrow * 2] = w1; ent_e[lrow * 2 + 1] = gi * 4 + e2; ent_w[lrow * 2 + 1] = w2; }
        }
        __syncthreads();
        if (tid < 128) ent_p[tid] = __hip_atomic_fetch_add(lcnt + ent_e[tid], 1, __ATOMIC_RELAXED, __HIP_MEMORY_SCOPE_WORKGROUP);
        __syncthreads();
        if (tid < 16 && do_append) lbase[tid] = (int)__hip_atomic_fetch_add(ctl + CW_ECNT + 64 * tid, (unsigned)lcnt[tid], RLX_AGENT);
        __syncthreads();
        if (tid < 128 && do_append) { const int e = ent_e[tid], pos = lbase[e] + ent_p[tid]; const int tok = chunk * 64 + (tid >> 1);
            LIST[(size_t)e * NTOK + pos] = (unsigned)(tok * 2 + (tid & 1)); WL[(size_t)e * NTOK + pos] = ent_w[tid]; }
        __syncthreads();
    }
}
__device__ __forceinline__ void p12_final(const Ptrs& P, int gw, int NGW, int lane) {
    const float* XN = (const float*)(P.ws + WS_R3); const bf16_t* SL = (const bf16_t*)(P.ws + WS_R2); const float* MOD = (const float*)(P.ws + WS_MOD);
    for (int tok = gw; tok < NTOK; tok += NGW) {
        const int b = tok / SEQ; const float* md = MOD + (size_t)b * NMOD + 5 * DM;
        f32x4 v[8]; float ss = 0.f;
#pragma unroll
        for (int j = 0; j < 8; ++j) { const int col = j * 256 + lane * 4;
            const f32x4 xv = *(const f32x4*)(XN + (size_t)tok * DM + col), g2 = *(const f32x4*)(md + col);
            const u32x2 s0 = *(const u32x2*)(SL + (size_t)(2 * tok) * DM + col), s1 = *(const u32x2*)(SL + (size_t)(2 * tok + 1) * DM + col);
            f32x4 y; y.x = bflo(s0.x) + bflo(s1.x); y.y = bfhi(s0.x) + bfhi(s1.x); y.z = bflo(s0.y) + bflo(s1.y); y.w = bfhi(s0.y) + bfhi(s1.y);
            v[j] = xv + g2 * y; ss += (v[j].x * v[j].x + v[j].y * v[j].y) + (v[j].z * v[j].z + v[j].w * v[j].w); }
        const float rstd = rsqrtf(wave_sum(ss) * (1.0f / DM) + EPS);
#pragma unroll
        for (int j = 0; j < 8; ++j) { const int col = j * 256 + lane * 4; const f32x4 g = *(const f32x4*)(P.norm_final + col);
            *(f32x4*)(P.out + (size_t)tok * DM + col) = (v[j] * rstd) * g; }
    }
}

using pg8::Unit;
struct InOrder {
    int G, c;
    __device__ __forceinline__ bool next(int i, Unit& u) const {
        long L = (long)i * G + c;
        if (L < 64 * 31) { int pm, pn; pg8::tile_map((int)L, 64, 31, pm, pn); u.pm = (pm >> 4) * 17 + 1 + (pm & 15); u.pn = pn; u.x = pm * 256; u.y = 0; return true; }
        L -= 64 * 31; if (L >= 20) return false;
        const int b = (int)L / 5, t = (int)L % 5; u.pm = b * 17; u.pn = (t < 2) ? 4 + t : 10 + t; u.x = -1; u.y = 0; return true;
    }
    __device__ __forceinline__ int src_row(const Unit&, int) const { return 0; }
    __device__ __forceinline__ void done(const Unit&) const {}
};
struct EpiIn {
    static constexpr bool PERM = true, MIDHOOK = false;
    bf16_t *QA, *KA, *VA, *QB, *CKV, *KR, *GL; const float* sa; const unsigned* cmax; float* ssc;
    __device__ __forceinline__ void operator()(const i32x4 (&acc)[2][2][4][2], const Unit& u, int wr, int wc, int fr, int fq) const {
        const int pn = u.pn; bf16_t* base; int ldc, colt; long row0; bool sig = false; int ncv = 256;
        const long krow0 = (long)u.pm * 256, lrow0 = u.x;
        if (pn < 4) { base = QA; ldc = 1024; colt = pn * 256; row0 = lrow0; }
        else if (pn == 4) { base = KA; ldc = 256; colt = 0; row0 = krow0; }
        else if (pn == 5) { base = VA; ldc = 256; colt = 0; row0 = krow0; }
        else if (pn < 12) { base = QB; ldc = 1536; colt = (pn - 6) * 256; row0 = lrow0; }
        else if (pn < 14) { base = CKV; ldc = 512; colt = (pn - 12) * 256; row0 = krow0; }
        else if (pn == 14) { base = KR; ldc = 64; colt = 0; row0 = krow0; ncv = 64; }
        else { base = GL; ldc = 4096; colt = (pn - 15) * 256; row0 = lrow0; sig = true; }
        const int c0 = wc * 32 + 8 * fq; const float k127 = inv127() * ((pn >= 6 && pn < 12) ? (0.07216878364870322f * 1.4426950408889634f) : 1.0f);
        float sr[2][4], ssq[2][4];
#pragma unroll
        for (int ai = 0; ai < 2; ++ai)
#pragma unroll
            for (int m = 0; m < 4; ++m) { sr[ai][m] = sa[krow0 + ai * 128 + wr * 64 + m * 16 + fr]; ssq[ai][m] = 0.f; }
#pragma unroll
        for (int bj = 0; bj < 2; ++bj) {
            const u32x4 cm0 = *(const u32x4*)(cmax + pn * 256 + bj * 128 + c0), cm1 = *(const u32x4*)(cmax + pn * 256 + bj * 128 + c0 + 4);
            const f32x4 sb0 = (f32x4){__uint_as_float(cm0.x), __uint_as_float(cm0.y), __uint_as_float(cm0.z), __uint_as_float(cm0.w)} * k127;
            const f32x4 sb1 = (f32x4){__uint_as_float(cm1.x), __uint_as_float(cm1.y), __uint_as_float(cm1.z), __uint_as_float(cm1.w)} * k127;
            if (bj * 128 + c0 < ncv) {
#pragma unroll
                for (int ai = 0; ai < 2; ++ai)
#pragma unroll
                    for (int m = 0; m < 4; ++m) { const int rt = ai * 128 + wr * 64 + m * 16 + fr; bf16_t* rowp = base + (size_t)(row0 + rt) * ldc + colt + c0 + bj * 128;
                        f32x4 v0, v1;
#pragma unroll
                        for (int i = 0; i < 4; ++i) { v0[i] = (float)acc[ai][bj][m][0][i] * (sr[ai][m] * sb0[i]); v1[i] = (float)acc[ai][bj][m][1][i] * (sr[ai][m] * sb1[i]); }
                        if (sig) {
                            u32x2 w; w.x = pack_i8x4(v0[0] * 16.0f, v0[1] * 16.0f, v0[2] * 16.0f, v0[3] * 16.0f); w.y = pack_i8x4(v1[0] * 16.0f, v1[1] * 16.0f, v1[2] * 16.0f, v1[3] * 16.0f);
                            *(u32x2*)((unsigned char*)GL + (size_t)(row0 + rt) * 4096 + colt + c0 + bj * 128) = w;
                        } else {
                        u32x4 w; w.x = cvt_pk_bf16(v0[0], v0[1]); w.y = cvt_pk_bf16(v0[2], v0[3]); w.z = cvt_pk_bf16(v1[0], v1[1]); w.w = cvt_pk_bf16(v1[2], v1[3]);
                        *(u32x4*)rowp = w;
                        if (pn == 12 || pn == 13) ssq[ai][m] += (v0[0] * v0[0] + v0[1] * v0[1]) + (v0[2] * v0[2] + v0[3] * v0[3]) + (v1[0] * v1[0] + v1[1] * v1[1]) + (v1[2] * v1[2] + v1[3] * v1[3]); } } }
        }
        if (pn == 12 || pn == 13) {
#pragma unroll
            for (int ai = 0; ai < 2; ++ai)
#pragma unroll
                for (int m = 0; m < 4; ++m) { float q = ssq[ai][m]; q += __shfl_xor(q, 16); q += __shfl_xor(q, 32);
                    if (fq == 0) ssc[(size_t)(krow0 + ai * 128 + wr * 64 + m * 16 + fr) * 8 + (pn - 12) * 4 + wc] = q; } }
    }
};
struct EpiKvUp {
    static constexpr bool PERM = true, MIDHOOK = false;
    bf16_t* O; const float* ssc;
    __device__ __forceinline__ void operator()(const f32x4 (&acc)[2][2][4][2], const Unit& u, int wr, int wc, int fr, int fq) const {
        const int c0 = u.pn * 256 + wc * 32 + 8 * fq;
#pragma unroll
        for (int ai = 0; ai < 2; ++ai)
#pragma unroll
            for (int m = 0; m < 4; ++m) { const size_t row = (size_t)u.pm * 256 + ai * 128 + wr * 64 + m * 16 + fr; const f32x4 p0 = *(const f32x4*)(ssc + row * 8), p1 = *(const f32x4*)(ssc + row * 8 + 4);
                const float s = rsqrtf(((p0.x + p0.y) + (p0.z + p0.w) + (p1.x + p1.y) + (p1.z + p1.w)) * (1.0f / 512.0f) + EPS); bf16_t* rowp = O + row * 2048 + c0;
#pragma unroll
                for (int bj = 0; bj < 2; ++bj) { const f32x4 v0 = acc[ai][bj][m][0] * s, v1 = acc[ai][bj][m][1] * s;
                    u32x4 w; w.x = cvt_pk_bf16(v0[0], v0[1]); w.y = cvt_pk_bf16(v0[2], v0[3]); w.z = cvt_pk_bf16(v1[0], v1[1]); w.w = cvt_pk_bf16(v1[2], v1[3]);
                    *(u32x4*)(rowp + bj * 128) = w; } }
    }
};
template <bool SECOND> struct EpiMerge {
    static constexpr bool PERM = true, MIDHOOK = false;
    const bf16_t* GL; const bf16_t* Tin; bf16_t* O; const float* sa; const unsigned* cmax;
    __device__ __forceinline__ void operator()(const i32x4 (&acc)[2][2][4][2], const Unit& u, int wr, int wc, int fr, int fq) const {
        const int c0 = u.pn * 256 + wc * 32 + 8 * fq;
        const float k127 = inv127(); f32x4 sb[2][2];
#pragma unroll
        for (int bj = 0; bj < 2; ++bj)
#pragma unroll
            for (int n = 0; n < 2; ++n) { const u32x4 cm = *(const u32x4*)(cmax + c0 + bj * 128 + 4 * n);
                sb[bj][n] = (f32x4){__uint_as_float(cm.x), __uint_as_float(cm.y), __uint_as_float(cm.z), __uint_as_float(cm.w)} * k127; }
#pragma unroll
        for (int ai = 0; ai < 2; ++ai)
#pragma unroll
            for (int m = 0; m < 4; ++m) { const size_t row = (size_t)u.pm * 256 + ai * 128 + wr * 64 + m * 16 + fr; const float sr = sa[row];
#pragma unroll
                for (int bj = 0; bj < 2; ++bj) { const int col = c0 + bj * 128;
                    const u32x2 gw = *(const u32x2*)((const unsigned char*)GL + row * 4096 + (SECOND ? 2048 : 0) + col);
                    f32x4 v0, v1;
#pragma unroll
                    for (int i = 0; i < 4; ++i) { v0[i] = (float)acc[ai][bj][m][0][i] * (sr * sb[bj][0][i]); v1[i] = (float)acc[ai][bj][m][1][i] * (sr * sb[bj][1][i]); }
#pragma unroll
                    for (int i = 0; i < 4; ++i) { v0[i] *= sigmoidf_((float)((int)(gw.x << (24 - 8 * i)) >> 24) * (1.0f / 16.0f)); v1[i] *= sigmoidf_((float)((int)(gw.y << (24 - 8 * i)) >> 24) * (1.0f / 16.0f)); }
                    if constexpr (SECOND) { const u32x4 tw = *(const u32x4*)(Tin + row * 2048 + col);
                        v0[0] += bflo(tw.x); v0[1] += bfhi(tw.x); v0[2] += bflo(tw.y); v0[3] += bfhi(tw.y); v1[0] += bflo(tw.z); v1[1] += bfhi(tw.z); v1[2] += bflo(tw.w); v1[3] += bfhi(tw.w); }
                    u32x4 w; w.x = cvt_pk_bf16(v0[0], v0[1]); w.y = cvt_pk_bf16(v0[2], v0[3]); w.z = cvt_pk_bf16(v1[0], v1[1]); w.w = cvt_pk_bf16(v1[2], v1[3]);
                    *(u32x4*)(O + row * 2048 + col) = w; } }
    }
};
struct EpiMergeF {
    static constexpr bool PERM = true, MIDHOOK = true;
    const signed char* GL; bf16_t* M; const float* invs;
    __device__ __forceinline__ void mid(f32x4 (&acc)[2][2][4][2], const Unit& u, int wr, int wc, int fr, int fq) const {
        const int c0 = u.pn * 256 + wc * 32 + 8 * fq;
        const signed char* gp = GL + ((size_t)u.pm * 256 + wr * 64 + fr) * 4096 + c0;
        u32x2 ga_n = *(const u32x2*)gp, gb_n = *(const u32x2*)(gp + 2048);
#pragma unroll
        for (int ai = 0; ai < 2; ++ai)
#pragma unroll
            for (int m = 0; m < 4; ++m) {
#pragma unroll
                for (int bj = 0; bj < 2; ++bj) {
                    const u32x2 ga = ga_n, gb = gb_n;
                    { const int g1 = ai * 8 + m * 2 + bj + 1; if (g1 < 16) { const signed char* q = gp + (size_t)((g1 >> 3) * 128 + ((g1 >> 1) & 3) * 16) * 4096 + (g1 & 1) * 128;
                        ga_n = *(const u32x2*)q; gb_n = *(const u32x2*)(q + 2048); } }
#pragma unroll
                    for (int i = 0; i < 4; ++i) {
                        const float a0 = (float)((int)(ga.x << (24 - 8 * i)) >> 24), b0 = (float)((int)(gb.x << (24 - 8 * i)) >> 24);
                        const float a1 = (float)((int)(ga.y << (24 - 8 * i)) >> 24), b1 = (float)((int)(gb.y << (24 - 8 * i)) >> 24);
                        constexpr float C = -1.4426950408889634f / 16.0f;
                        acc[ai][bj][m][0][i] *= (1.0f + __builtin_amdgcn_exp2f(C * b0)) * __builtin_amdgcn_rcpf(1.0f + __builtin_amdgcn_exp2f(C * a0));
                        acc[ai][bj][m][1][i] *= (1.0f + __builtin_amdgcn_exp2f(C * b1)) * __builtin_amdgcn_rcpf(1.0f + __builtin_amdgcn_exp2f(C * a1)); }
                    __builtin_amdgcn_sched_barrier(0); } }
    }
    __device__ __forceinline__ void operator()(const f32x4 (&acc)[2][2][4][2], const Unit& u, int wr, int wc, int fr, int fq) const {
        const int c0 = u.pn * 256 + wc * 32 + 8 * fq;
        const signed char* gp = GL + ((size_t)u.pm * 256 + wr * 64 + fr) * 4096 + 2048 + c0;
        u32x2 gb_n = *(const u32x2*)gp;
#pragma unroll
        for (int ai = 0; ai < 2; ++ai)
#pragma unroll
            for (int m = 0; m < 4; ++m) { const size_t row = (size_t)u.pm * 256 + ai * 128 + wr * 64 + m * 16 + fr;
#pragma unroll
                for (int bj = 0; bj < 2; ++bj) { const int col = c0 + bj * 128;
                    const u32x2 gb = gb_n;
                    { const int g1 = ai * 8 + m * 2 + bj + 1; if (g1 < 16) gb_n = *(const u32x2*)(gp + (size_t)((g1 >> 3) * 128 + ((g1 >> 1) & 3) * 16) * 4096 + (g1 & 1) * 128); }
                    const f32x4 rb0 = *(const f32x4*)(invs + col), rb1 = *(const f32x4*)(invs + col + 4);
                    f32x4 v0, v1;
#pragma unroll
                    for (int i = 0; i < 4; ++i) { v0[i] = acc[ai][bj][m][0][i] * rb0[i] * sigmoidf_((float)((int)(gb.x << (24 - 8 * i)) >> 24) * (1.0f / 16.0f));
                                                  v1[i] = acc[ai][bj][m][1][i] * rb1[i] * sigmoidf_((float)((int)(gb.y << (24 - 8 * i)) >> 24) * (1.0f / 16.0f)); }
                    u32x2 w; w.x = pack_f8x4(v0[0], v0[1], v0[2], v0[3]); w.y = pack_f8x4(v1[0], v1[1], v1[2], v1[3]);
                    *(u32x2*)((unsigned char*)M + row * 2048 + col) = w; } }
    }
};
struct EpiOut {
    static constexpr bool PERM = false, MIDHOOK = false;
    const float* x; const float* mod; float* O; const float* invs;
    __device__ __forceinline__ void operator()(const f32x4 (&acc)[2][2][4][2], const Unit& u, int wr, int wc, int fr, int fq) const {
        const int c0 = u.pn * 256 + wc * 32 + 4 * fq; const int b = (u.pm * 256) / SEQ; const float* g1 = mod + (size_t)b * NMOD + 2 * DM;
        f32x4 gsb[2][2];
#pragma unroll
        for (int bj = 0; bj < 2; ++bj)
#pragma unroll
            for (int n = 0; n < 2; ++n) { const int col = c0 + bj * 128 + n * 16; gsb[bj][n] = *(const f32x4*)(invs + col) * (1.0f / 64.0f) * *(const f32x4*)(g1 + col); }
        const float* xp = x + ((size_t)u.pm * 256 + wr * 64 + fr) * DM + c0; float* op = O + ((size_t)u.pm * 256 + wr * 64 + fr) * DM + c0;
        f32x4 xa[8], xb[8];
#define EO_OFF(b, k) ((size_t)(((b) >> 1) * 128 + (((b) & 1) * 2 + ((k) >> 2)) * 16) * DM + (((k) >> 1) & 1) * 128 + ((k) & 1) * 16)
#define EO_LD(b, xx) do { _Pragma("unroll") for (int k = 0; k < 8; ++k) xx[k] = *(const f32x4*)(xp + EO_OFF(b, k)); __builtin_amdgcn_sched_barrier(0); } while (0)
#define EO_ST(b, xx) do { _Pragma("unroll") for (int k = 0; k < 8; ++k) *(f32x4*)(op + EO_OFF(b, k)) = xx[k] + gsb[(k >> 1) & 1][k & 1] * acc[(b) >> 1][(k >> 1) & 1][((b) & 1) * 2 + (k >> 2)][k & 1]; __builtin_amdgcn_sched_barrier(0); } while (0)
        EO_LD(0, xa); EO_LD(1, xb); EO_ST(0, xa); EO_LD(2, xa); EO_ST(1, xb); EO_LD(3, xb); EO_ST(2, xa); EO_ST(3, xb);
#undef EO_OFF
#undef EO_LD
#undef EO_ST
    }
};
struct MoeOrder {
    const LAS int* tab; const unsigned* list; int G, c;
    __device__ __forceinline__ bool next(int i, Unit& u) const {
        int rt, j;
        if ((G & 15) == 0) { const int x = c & 7, q = c >> 3; j = 2 * (x & 3) + (q & 1); rt = i * (G >> 3) + (x >> 2) * (G >> 4) + (q >> 1); }
        else { const long L = (long)i * G + c; rt = (int)(L >> 3); j = (int)(L & 7); }
        if (rt >= tab[16]) return false;
        int e = 0;
#pragma unroll
        for (int k = 1; k < 16; ++k) e += (rt >= tab[k]) ? 1 : 0;
        const int m = rt - tab[e]; int rows = tab[32 + e] - m * 256; rows = rows > 256 ? 256 : rows;
        u.pm = rt; u.pn = e * 8 + j; u.x = e * NTOK + m * 256; u.y = rows; return true;
    }
    __device__ __forceinline__ int src_row(const Unit& u, int r) const { return (r < u.y) ? (int)(list[u.x + r] >> 1) : 0; }
    unsigned* qcnt;
    __device__ __forceinline__ void done(const Unit& u) const {
        if (my_lane() == 0) __hip_atomic_fetch_add(qcnt + 64 * u.pm, 1u, RLX_AGENT);
    }
};
struct MoeQueue {
    const LAS int* tab; volatile LAS int* slot; unsigned* qhead; unsigned* qcnt; const unsigned* list; int G, c;
    __device__ __forceinline__ bool next(int i, Unit& u) const {
        const int tid_ = my_tid();
        if (__builtin_amdgcn_readfirstlane(tid_ >> 6) == 0) {
            int L = 0;
            if ((tid_ & 63) == 0) {
                L = (i == 0) ? c : G + (int)__hip_atomic_fetch_add(qhead, 1u, RLX_AGENT);
                if (L < tab[16] * 8) { unsigned* c = qcnt + 64 * (L >> 3); unsigned sp = 0;
                    while (__hip_atomic_load(c, RLX_AGENT) < 64u) { __builtin_amdgcn_s_sleep(2); if (++sp > (1u << 22)) break; } }
            }
            L = __builtin_amdgcn_readfirstlane(L);
            __builtin_amdgcn_fence(__ATOMIC_ACQUIRE, "agent");
            asm volatile("s_waitcnt vmcnt(0)" ::: "memory");
            if ((tid_ & 63) == 0) slot[i & 1] = L;
        }
        asm volatile("s_waitcnt lgkmcnt(0)" ::: "memory"); __builtin_amdgcn_s_barrier(); asm volatile("" ::: "memory");
        const int L = slot[i & 1];
        if (L >= tab[16] * 8) return false;
        const int rt = L >> 3, j = L & 7; int e = 0;
#pragma unroll
        for (int k = 1; k < 16; ++k) e += (rt >= tab[k]) ? 1 : 0;
        const int m = rt - tab[e]; int rows = tab[32 + e] - m * 256; rows = rows > 256 ? 256 : rows;
        u.pm = rt; u.pn = e * 8 + j; u.x = e * NTOK + m * 256; u.y = rows; return true;
    }
    __device__ __forceinline__ int src_row(const Unit&, int) const { return 0; }
    __device__ __forceinline__ void done(const Unit&) const {}
};
struct EpiGateUp {
    static constexpr bool PERM = true, MIDHOOK = false;
    bf16_t* O; const unsigned* list; const float* sa; const unsigned* cmax;
    __device__ __forceinline__ void operator()(const i32x4 (&acc)[2][2][4][2], const Unit& u, int wr, int wc, int fr, int fq) const {
        const int c0 = (u.pn & 7) * 128 + wc * 32 + 8 * fq, ct = wc * 32 + 8 * fq;
        const __amdgpu_buffer_rsrc_t rsrc = __builtin_amdgcn_make_buffer_rsrc((void*)O, 0, 0x7ffffff0, 0x00020000);
        const float k127 = inv127(); f32x4 sb[2][2];
#pragma unroll
        for (int bj = 0; bj < 2; ++bj)
#pragma unroll
            for (int n = 0; n < 2; ++n) { const u32x4 cm = *(const u32x4*)(cmax + u.pn * 256 + bj * 128 + ct + 4 * n);
                sb[bj][n] = (f32x4){__uint_as_float(cm.x), __uint_as_float(cm.y), __uint_as_float(cm.z), __uint_as_float(cm.w)} * k127; }
#pragma unroll
        for (int ai = 0; ai < 2; ++ai)
#pragma unroll
            for (int m = 0; m < 4; ++m) { const int rt = ai * 128 + wr * 64 + m * 16 + fr; const size_t row = (size_t)u.pm * 256 + rt;
                const float sr = sa[(rt < u.y) ? (list[u.x + rt] >> 1) : 0u];
                f32x4 h0, h1;
#pragma unroll
                for (int i = 0; i < 4; ++i) { const float g0 = (float)acc[ai][0][m][0][i] * (sr * sb[0][0][i]), g1 = (float)acc[ai][0][m][1][i] * (sr * sb[0][1][i]);
                    h0[i] = g0 * sigmoidf_(g0) * ((float)acc[ai][1][m][0][i] * (sr * sb[1][0][i])); h1[i] = g1 * sigmoidf_(g1) * ((float)acc[ai][1][m][1][i] * (sr * sb[1][1][i])); }
                u32x2 w; w.x = pack_f8x4(h0[0] * 8.0f, h0[1] * 8.0f, h0[2] * 8.0f, h0[3] * 8.0f); w.y = pack_f8x4(h1[0] * 8.0f, h1[1] * 8.0f, h1[2] * 8.0f, h1[3] * 8.0f);
                __builtin_amdgcn_raw_buffer_store_b64(w, rsrc, (int)(row * DEXP + c0), 0, 16); }
    }
};
struct EpiDown {
    static constexpr bool PERM = true, MIDHOOK = false;
    bf16_t* O; const unsigned* list; const float* wl; const float* invs;
    __device__ __forceinline__ void operator()(const f32x4 (&acc)[2][2][4][2], const Unit& u, int wr, int wc, int fr, int fq) const {
        const int c0 = (u.pn & 7) * 256 + wc * 32 + 8 * fq; const int ce = u.pn * 256 + wc * 32 + 8 * fq;
        f32x4 sb[2][2];
#pragma unroll
        for (int bj = 0; bj < 2; ++bj)
#pragma unroll
            for (int n = 0; n < 2; ++n) sb[bj][n] = *(const f32x4*)(invs + ce + bj * 128 + 4 * n) * (1.0f / 8.0f);
#pragma unroll
        for (int ai = 0; ai < 2; ++ai)
#pragma unroll
            for (int m = 0; m < 4; ++m) { const int r = ai * 128 + wr * 64 + m * 16 + fr;
                if (r < u.y) { const size_t dst = list[u.x + r]; const float s = wl[u.x + r]; bf16_t* rowp = O + dst * DM + c0;
#pragma unroll
                    for (int bj = 0; bj < 2; ++bj) { const f32x4 v0 = acc[ai][bj][m][0] * sb[bj][0] * s, v1 = acc[ai][bj][m][1] * sb[bj][1] * s;
                        u32x4 w; w.x = cvt_pk_bf16(v0[0], v0[1]); w.y = cvt_pk_bf16(v0[2], v0[3]); w.z = cvt_pk_bf16(v1[0], v1[1]); w.w = cvt_pk_bf16(v1[2], v1[3]);
                        *(u32x4*)(rowp + bj * 128) = w; } } }
    }
};

enum { PH_P0, PH_P1, PH_HX, PH_IN, PH_POST, PH_KVUP, PH_ATT, PH_RQ1, PH_MERGE, PH_RQ2, PH_OUT, PH_ROUTE, PH_GU, PH_DOWN, PH_FINAL, NPH };
#ifndef MK_ONE_LAUNCH
#define MK_ONE_LAUNCH 1
#endif
struct Args { Ptrs p; int ph_lo, ph_hi, use_bar, pad; };
__global__ void __launch_bounds__(NWAVES * 64, 2) fwd_kernel(Args args) {
    extern __shared__ __attribute__((aligned(16))) unsigned char lds_raw[];
    LAS unsigned char* lds = (LAS unsigned char*)lds_raw;
    const int G = gridDim.x, blk = blockIdx.x, NGW = G * NWAVES;
#if defined(__HIP_DEVICE_COMPILE__)
#define PDECL() const __attribute__((address_space(4))) Ptrs* pp_ = (const __attribute__((address_space(4))) Ptrs*)__builtin_amdgcn_kernarg_segment_ptr(); asm volatile("" : "+s"(pp_)); \
    const Ptrs P = *pp_; unsigned char* const ws = P.ws; unsigned* const ctl = (unsigned*)(ws + WS_CTL); (void)ctl
#else
#define PDECL() const Ptrs P = args.p; unsigned char* const ws = P.ws; unsigned* const ctl = (unsigned*)(ws + WS_CTL); (void)ctl
#endif
#define TIDS() const int tid = opaque_v(my_tid()), lane = tid & 63, wave = __builtin_amdgcn_readfirstlane(tid >> 6), gw = blk * NWAVES + wave; (void)lane; (void)gw
    for (int u = threadIdx.x; u < (LDS_BYTES - CTL_OFF) / 4; u += NWAVES * 64) ((LAS unsigned*)(lds + CTL_OFF))[u] = 0u;
    __syncthreads();
    static_assert(WTAB_OFF_ == CTL_OFF + 1792 && WTAB_OFF_ + 256 <= LDS_BYTES, "wave table inside the LDS control region");
    if ((threadIdx.x & 63) == 0) ((LAS int*)(lds + WTAB_OFF_))[(unsigned)__builtin_amdgcn_s_getreg((5 << 11) | 4) & 63u] = (int)(threadIdx.x >> 6);
    __syncthreads();
    volatile LAS unsigned* MISC = (volatile LAS unsigned*)(lds + MISC_OFF);
    XcdBarrier bar; { PDECL(); bar.bar = ctl + CW_BAR; bar.x = 0; bar.st = nullptr;
    if (args.use_bar) bar = xcd_barrier_post(ctl + CW_BAR, MISC + 8); }
    const int lo = args.ph_lo, hi = args.ph_hi;
#ifndef PHASE_MASK
#define PHASE_MASK 0xFFFFF
#endif
#define IN(k) (((PHASE_MASK >> (k)) & 1) && lo <= (k) && (k) < hi)
#ifndef PROBE_DUP
#define PROBE_DUP -1
#endif
#define REP(k) for (int rep_ = 0; rep_ < ((PROBE_DUP == (k)) ? 2 : 1); ++rep_)
#define SEAM(k) do { if (IN(k) && IN((k) + 1)) xcd_barrier(bar); } while (0)

    if (IN(PH_P0)) REP(PH_P0) { PDECL(); TIDS(); p0_prologue(P, lds, G, blk, gw, NGW, wave, lane); } SEAM(PH_P0);
    if (IN(PH_P1)) { PDECL(); TIDS(); p1_modreduce(P, blk * NWAVES * 64 + tid, G * NWAVES * 64); p1_win_i8(P, lds, gw, NGW, wave, lane); } SEAM(PH_P1);
    if (IN(PH_HX)) REP(PH_HX) { PDECL(); TIDS(); p2_hx(P, gw, NGW, lane); } SEAM(PH_HX);
    if (IN(PH_IN)) REP(PH_IN) { PDECL();
        pg8::Gemm g{(const bf16_t*)(ws + WS_R1), (const bf16_t*)(ws + WS_WIN), DM}; InOrder S{G, blk};
        unsigned char* r2 = ws + WS_R2;
        EpiIn E{(bf16_t*)(r2 + R2_QA), (bf16_t*)(r2 + R2_KA), (bf16_t*)(r2 + R2_VA), (bf16_t*)(r2 + R2_QB), (bf16_t*)(r2 + R2_CKV), (bf16_t*)(r2 + R2_KR), (bf16_t*)(ws + WS_R3), (const float*)(ws + WS_SAHX), (const unsigned*)(ws + WS_CTL) + CW_CMAX_IN, (float*)(ws + WS_SSC)};
        if ((blk & 1) == 0) { TIDS(); p3_expert_gateup(P, lds, G, blk, wave, lane); }
        pg8::gemm_phase<EpiIn, InOrder, false, true>(lds, g, S, E);
        if ((blk & 1) == 1) { TIDS(); p3_expert_gateup(P, lds, G, blk, wave, lane); }
    } SEAM(PH_IN);
    if (IN(PH_KVUP)) REP(PH_KVUP) { PDECL();
        pg8::Gemm g{(const bf16_t*)(ws + WS_R2 + R2_CKV), (const bf16_t*)(ws + WS_WUKV), 512}; pg8::TileOrder S{NKEY / 256, 8, G, blk};
        EpiKvUp E{(bf16_t*)(ws + WS_R1), (const float*)(ws + WS_SSC)};
        pg8::gemm_phase<EpiKvUp, pg8::TileOrder, false>(lds, g, S, E);
        {
            TIDS(); const int nu3 = (NKEY / 256) * 8 - 2 * G;
            const bool w3 = (G == 256) && blk < nu3; const int shares = (G == 256) ? nu3 + 2 * (G - nu3) : G;
            const int s0 = (G == 256) ? (w3 ? blk : nu3 + 2 * (blk - nu3)) : blk, s1 = s0 + ((G == 256 && !w3) ? 2 : 1);
            p4_post(P, (int)((long)NKEY * s0 / shares), (int)((long)NKEY * s1 / shares), wave, lane); }
    } SEAM(PH_KVUP);
    if (IN(PH_ATT)) { PDECL();
        const bf16_t* QA = (const bf16_t*)(ws + WS_R2 + R2_QA); const bf16_t* KA = (const bf16_t*)(ws + WS_R2 + R2_KA); const bf16_t* VA = (const bf16_t*)(ws + WS_R2 + R2_VA);
        const bf16_t* QB = (const bf16_t*)(ws + WS_R2 + R2_QB); const bf16_t* KR = (const bf16_t*)(ws + WS_R2 + R2_KR); const bf16_t* KVB = (const bf16_t*)(ws + WS_R1);
        unsigned char* OA = ws + WS_R4; unsigned char* OB = OA + (size_t)NTOK * 1024;
#ifndef ATT_SKIP_A
        const int cslot = blk % 5; int ucnt = 0;
#define P6_COPIES() do { TIDS(); for (int q_ = 0; q_ < ((PROBE_DUP == 200 + PH_ATT) ? 2 : 1); ++q_) p6_expert_copies(P, lds, G, blk, wave, lane); __syncthreads(); } while (0)
        for (int L_ = blk; L_ < ((PROBE_DUP == PH_ATT) ? 1024 : 512); L_ += G) { const int L = L_ & 511;
            if (ucnt++ == cslot) P6_COPIES();
            const int i2 = L >> 8, cc = L & 255, xcd = cc & 7, j = cc >> 3;
            const int b = 2 * i2 + (xcd >> 2), kvh = (xcd >> 1) & 1, h = kvh * 4 + (xcd & 1) * 2 + (j >> 4), qb = j & 15;
            const size_t qrow = (size_t)b * SEQ + qb * 256, krow = (size_t)b * KEYS;
            if (att::attn_body<0, -1, 2, 1024, 256, 256, 1024, true, true>(QA + qrow * 1024 + h * 128, KA + krow * 256 + kvh * 128, VA + krow * 256 + kvh * 128, nullptr, (bf16_t*)(OA + qrow * 1024 + h * 128), KEYS, (char*)lds_raw))
                att::attn_body<0, -1, 2, 1024, 256, 256, 1024, true, false>(QA + qrow * 1024 + h * 128, KA + krow * 256 + kvh * 128, VA + krow * 256 + kvh * 128, nullptr, (bf16_t*)(OA + qrow * 1024 + h * 128), KEYS, (char*)lds_raw);
        }
#endif
#ifndef ATT_SKIP_B
        for (int L_ = blk; L_ < ((PROBE_DUP == 100 + PH_ATT) ? 1024 : 512); L_ += G) { const int L = L_ & 511;
            if (ucnt++ == cslot) P6_COPIES();
            const int i2 = L >> 8, cc = L & 255, xcd = cc & 7, j = cc >> 3;
            const int b = 2 * i2 + (xcd >> 2), h = (xcd & 3) * 2 + (j >> 4), qb = j & 15;
            const size_t qrow = (size_t)b * SEQ + qb * 256, krow = (size_t)b * KEYS;
            if (att::attn_body<64, ATT_B_QPARK, ATT_B_SDEPTH, 1536, 2048, 2048, 1024, true, true>(QB + qrow * 1536 + h * 192, KVB + krow * 2048 + h * 256, KVB + krow * 2048 + h * 256 + 128, KR + krow * 64, (bf16_t*)(OB + qrow * 1024 + h * 128), KEYS, (char*)lds_raw))
                att::attn_body<64, ATT_B_QPARK, ATT_B_SDEPTH, 1536, 2048, 2048, 1024, true, false>(QB + qrow * 1536 + h * 192, KVB + krow * 2048 + h * 256, KVB + krow * 2048 + h * 256 + 128, KR + krow * 64, (bf16_t*)(OB + qrow * 1024 + h * 128), KEYS, (char*)lds_raw);
        }
#endif
        if (ucnt <= cslot) P6_COPIES();
#undef P6_COPIES
    } SEAM(PH_ATT);
    if (IN(PH_MERGE)) REP(PH_MERGE) { PDECL();
        pg8::Gemm g{(const bf16_t*)(ws + WS_R4), (const bf16_t*)(ws + WS_WBRA), DM, 1024, (long)NTOK * 1024 - 8 * 128}; pg8::TileOrder S{NTOK / 256, 8, G, blk};
        EpiMergeF E{(const signed char*)(ws + WS_R3), (bf16_t*)(ws + WS_R1), (const float*)(ws + WS_SAO)};
        pg8::gemm_phase<EpiMergeF, pg8::TileOrder, false, 2>(lds, g, S, E);
    } SEAM(PH_MERGE);
    if (IN(PH_OUT)) REP(PH_OUT) { PDECL();
        pg8::Gemm g{(const bf16_t*)(ws + WS_R1), (const bf16_t*)(ws + WS_WOUT), DM}; pg8::TileOrder S{NTOK / 256, 8, G, blk};
        EpiOut E{P.x, (const float*)(ws + WS_MOD), (float*)(ws + WS_R3), (const float*)(ws + WS_SAO) + 2048};
        pg8::gemm_phase<EpiOut, pg8::TileOrder, false, 2>(lds, g, S, E);
    } SEAM(PH_OUT);
    if (IN(PH_ROUTE)) REP(PH_ROUTE) { PDECL(); TIDS(); p9_route(P, lds, G, blk, tid, wave, lane, !(PROBE_DUP == PH_ROUTE && rep_ == 0)); } SEAM(PH_ROUTE);
    if (IN(PH_GU) || IN(PH_DOWN)) { PDECL();
        LAS int* tab = (LAS int*)(lds + MOETAB_OFF);
        if (my_tid() == 0) { int pre = 0;
            for (int e = 0; e < 16; ++e) { const int n = (int)__hip_atomic_load(ctl + CW_ECNT + 64 * e, RLX_AGENT); tab[e] = pre; tab[32 + e] = n; pre += (n + 255) >> 8; }
            tab[16] = pre; }
        __syncthreads();
    }
    if (IN(PH_GU)) REP(PH_GU) { PDECL();
        const LAS int* tab = (const LAS int*)(lds + MOETAB_OFF);
        pg8::Gemm g{(const bf16_t*)(ws + WS_R4), (const bf16_t*)(ws + WS_WG), DM}; MoeOrder S{tab, (const unsigned*)(ws + WS_LIST), G, blk, ctl + CW_QCNT};
        EpiGateUp E{(bf16_t*)(ws + WS_R1), (const unsigned*)(ws + WS_LIST), (const float*)(ws + WS_SAH2), (const unsigned*)(ws + WS_CTL) + CW_CMAX_WG};
        pg8::gemm_phase<EpiGateUp, MoeOrder, true, true>(lds, g, S, E);
    }
    if (IN(PH_DOWN)) REP(PH_DOWN) { PDECL();
        const LAS int* tab = (const LAS int*)(lds + MOETAB_OFF);
        pg8::Gemm g{(const bf16_t*)(ws + WS_R1), (const bf16_t*)(ws + WS_WD), DEXP}; MoeQueue S{tab, (volatile LAS int*)(lds + QSLOT_OFF), ctl + CW_QHEAD, ctl + CW_QCNT, (const unsigned*)(ws + WS_LIST), G, blk};
        EpiDown E{(bf16_t*)(ws + WS_R2), (const unsigned*)(ws + WS_LIST), (const float*)(ws + WS_WLIST), (const float*)(ws + WS_INVD)};
        pg8::gemm_phase<EpiDown, MoeQueue, false, 2>(lds, g, S, E);
    } SEAM(PH_DOWN);
    if (IN(PH_FINAL)) REP(PH_FINAL) { PDECL(); TIDS(); p12_final(P, gw, NGW, lane); }
#undef IN
#undef SEAM
}

extern "C" void kernel_launch(void* const* d_in, const int* in_sizes, int n_in, void* d_out, int out_size, void* d_ws, size_t ws_size, hipStream_t stream) {
    static int grid = 0;
    if (grid == 0) {
        if (n_in != 24 || in_sizes[0] != NTOK * DM || out_size != NTOK * DM || ws_size < WS_END) {
            fprintf(stderr, "kernel_launch: shape mismatch (n_in %d, in0 %d, out %d, ws %zu; need ws >= %zu); nothing launched\n", n_in, n_in > 0 ? in_sizes[0] : -1, out_size, ws_size, (size_t)WS_END); grid = -1; return; }
        int dev = 0, cus = 0, per_cu = 0;
        if (hipGetDevice(&dev) != hipSuccess || hipDeviceGetAttribute(&cus, hipDeviceAttributeMultiprocessorCount, dev) != hipSuccess) { fprintf(stderr, "kernel_launch: device query failed\n"); grid = -1; return; }
        if (hipFuncSetAttribute((const void*)fwd_kernel, hipFuncAttributeMaxDynamicSharedMemorySize, LDS_BYTES) != hipSuccess) { fprintf(stderr, "kernel_launch: hipFuncSetAttribute failed\n"); grid = -1; return; }
        if (hipOccupancyMaxActiveBlocksPerMultiprocessor(&per_cu, (const void*)fwd_kernel, NWAVES * 64, LDS_BYTES) != hipSuccess || per_cu < 1) {
            fprintf(stderr, "kernel_launch: occupancy query reports %d workgroups per CU\n", per_cu); }
        (void)hipGetLastError();
        grid = cus;
    }
    if (grid < 0) return;
    if (hipMemsetAsync((char*)d_ws + WS_CTL, 0, CTL_ZERO_BYTES, stream) != hipSuccess) { fprintf(stderr, "kernel_launch: memset failed\n"); return; }
    Args a{};
    const float** pp = (const float**)&a.p;
    for (int i = 0; i < 24; ++i) pp[i] = (const float*)d_in[i];
    a.p.out = (float*)d_out; a.p.ws = (unsigned char*)d_ws;
#if MK_ONE_LAUNCH
    a.ph_lo = 0; a.ph_hi = NPH; a.use_bar = 1; a.pad = 0;
    hipLaunchKernelGGL(fwd_kernel, dim3(grid), dim3(NWAVES * 64), LDS_BYTES, stream, a);
#else
    for (int k = 0; k < NPH; ++k) { a.ph_lo = k; a.ph_hi = k + 1; a.use_bar = 0; a.pad = 0;
        hipLaunchKernelGGL(fwd_kernel, dim3(grid), dim3(NWAVES * 64), LDS_BYTES, stream, a); }
#endif
    const hipError_t le = hipPeekAtLastError();
    if (le != hipSuccess) fprintf(stderr, "kernel_launch: launch failed: %s\n", hipGetErrorName(le));
}
```

```cpp
#include <hip/hip_runtime.h>
#include <cstdio>
#include <cstdint>
#include <type_traits>

#define LAS __attribute__((address_space(3)))
#define GAS __attribute__((address_space(1)))
typedef unsigned short bf16_t;
typedef short bf16x8 __attribute__((ext_vector_type(8)));
typedef short s16x4 __attribute__((ext_vector_type(4)));
typedef float f32x2 __attribute__((ext_vector_type(2)));
typedef float f32x4 __attribute__((ext_vector_type(4)));
typedef float f32x16 __attribute__((ext_vector_type(16)));
typedef unsigned u32x2 __attribute__((ext_vector_type(2)));
typedef unsigned u32x4 __attribute__((ext_vector_type(4)));
typedef int i32x4 __attribute__((ext_vector_type(4)));
typedef int i32x8 __attribute__((ext_vector_type(8)));
typedef GAS unsigned gu32;

constexpr int DM = 2048, NB = 4, SEQ = 4096, CTXL = 256, KEYS = SEQ + CTXL, NTOK = NB * SEQ, NKEY = NB * KEYS;
constexpr int NMOD = 6 * DM;
constexpr int DIN = 7744, NINP = 7936;
constexpr int C_QA = 0, C_KA = 1024, C_VA = 1280, C_QB = 1536, C_CKV = 3072, C_KR = 3584, C_GL = 3840;
constexpr int NEXP = 16, DEXP = 1024;
constexpr float EPS = 1e-6f;
constexpr int NWAVES = 8;

constexpr size_t MiB = 1u << 20;
constexpr size_t WS_CTL = 0, CTL_ZERO_BYTES = 1 * MiB;
constexpr size_t WS_MOD = 1 * MiB;
constexpr size_t WS_ROPEA = WS_MOD + 256 * 1024;
constexpr size_t WS_ROPEB = WS_ROPEA + 16 * 1024;
constexpr size_t WS_RSTD = WS_ROPEB + 16 * 1024;
constexpr size_t WS_SAHX = WS_RSTD + 96 * 1024;
constexpr size_t WS_BIASR = WS_RSTD + 192 * 1024;
constexpr size_t WS_SAH2 = WS_RSTD + 256 * 1024;
constexpr size_t WS_SAO = WS_RSTD + 384 * 1024;
constexpr size_t WS_SAM = WS_RSTD + 512 * 1024;
constexpr size_t WS_LIST = 2 * MiB;
constexpr size_t WS_WLIST = 3 * MiB;
constexpr size_t WS_MODP = 4 * MiB;
constexpr size_t WS_WIN = 12 * MiB;
constexpr size_t WS_WUKV = 43 * MiB;
constexpr size_t WS_WBRA = 45 * MiB;
constexpr size_t WS_WBRB = 49 * MiB;
constexpr size_t WS_WOUT = 53 * MiB;
constexpr size_t WS_R1 = 61 * MiB;
constexpr size_t WS_R2 = 133 * MiB;
constexpr size_t WS_R3 = 261 * MiB;
constexpr size_t WS_R4 = 389 * MiB;
constexpr size_t WS_WG = 453 * MiB;
constexpr size_t WS_WD = 581 * MiB;
constexpr size_t WS_END = 645 * MiB;
constexpr size_t WS_INVD = WS_MODP + 3 * MiB;
constexpr size_t WS_SSC = WS_MODP + 2 * MiB;
constexpr size_t R2_QA = 0, R2_KA = 32 * MiB, R2_VA = R2_KA + (size_t)NKEY * 256 * 2, R2_QB = 49 * MiB, R2_CKV = 97 * MiB, R2_KR = 114 * MiB;
static_assert(R2_VA + (size_t)NKEY * 256 * 2 <= R2_QB && R2_CKV + (size_t)NKEY * 512 * 2 <= R2_KR && R2_KR + (size_t)NKEY * 64 * 2 <= 128 * MiB, "R2 map");
constexpr int CW_BAR = 4096;
constexpr int CW_ECNT = 16384;
constexpr int CW_CMAX_IN = 32768;
constexpr int CW_CMAX_BR = 98304, CW_CMAX_OUT = 98304 + 4096;
constexpr int CW_QHEAD = 131072, CW_QCNT = 131072 + 64;
constexpr int CW_CMAX_WG = 65536;
constexpr int RING_BYTES = 131072;
constexpr int CTL_OFF = 159744;
constexpr int MISC_OFF = CTL_OFF + 320;
constexpr int MOETAB_OFF = CTL_OFF + 1024;
constexpr int QSLOT_OFF = CTL_OFF + 1536;
constexpr int LDS_BYTES = 161792;
static_assert(83968 + 8 * 9216 <= CTL_OFF && LDS_BYTES <= 163840, "attention scratch below the control region");

#define RLX_AGENT __ATOMIC_RELAXED, __HIP_MEMORY_SCOPE_AGENT
#define LDS_WAIT() asm volatile("s_waitcnt lgkmcnt(0)" ::: "memory")
#define VM_WAIT() asm volatile("s_waitcnt vmcnt(0)" ::: "memory")
__device__ __forceinline__ unsigned cvt_pk_bf16(float lo, float hi) { unsigned r; asm volatile("v_cvt_pk_bf16_f32 %0, %1, %2" : "=v"(r) : "v"(lo), "v"(hi)); return r; }
__device__ __forceinline__ float bflo(unsigned w) { return __uint_as_float(w << 16); }
__device__ __forceinline__ float bfhi(unsigned w) { return __uint_as_float(w & 0xffff0000u); }
__device__ __forceinline__ float sigmoidf_(float v) { return __builtin_amdgcn_rcpf(1.0f + __builtin_amdgcn_exp2f(-1.4426950408889634f * v)); }
__device__ __forceinline__ float wave_sum(float v) {
#pragma unroll
    for (int o = 1; o < 64; o <<= 1) v += __shfl_xor(v, o);
    return v;
}

constexpr int WTAB_OFF_ = 159744 + 1792;
__device__ __forceinline__ int my_lane() { return (int)__builtin_amdgcn_mbcnt_hi(~0u, __builtin_amdgcn_mbcnt_lo(~0u, 0u)); }
__device__ __forceinline__ int my_wave() { const unsigned key = (unsigned)__builtin_amdgcn_s_getreg((5 << 11) | 4) & 63u;
    return __builtin_amdgcn_readfirstlane(((const LAS int*)(unsigned long)WTAB_OFF_)[key]); }
__device__ __forceinline__ int my_tid() { return my_wave() * 64 + my_lane(); }
__device__ __forceinline__ int opaque_v(int v) { asm volatile("" : "+v"(v)); return v; }

namespace pg8 {
constexpr int BM = 256, BK = 64, HALF = 128, HTB = HALF * BK * 2, STAGE_BYTES = 8 * HTB, NXCD = 8, WGM = 8;
__host__ __device__ __forceinline__ int lds_byte(int r, int c) { const int st = (r >> 4) * 2 + (c >> 5), rr = r & 15, cc = c & 31, ob = rr * 64 + cc * 2; return st * 1024 + (ob ^ (((ob >> 9) & 1) << 5)); }
__host__ __device__ __forceinline__ void stage_rc(int b, int& R, int& C) { const int st = b / 1024, sb = b % 1024, swz = sb ^ (((sb >> 9) & 1) << 5); R = (st >> 1) * 16 + swz / 64; C = (st & 1) * 32 + (swz % 64) / 2; }
__host__ __device__ __forceinline__ int perm32(int rho) { const int n = rho >> 4, i = rho & 15; return 8 * (i >> 2) + 4 * n + (i & 3); }

struct Unit { int pm, pn, x, y; };
struct Gemm { const bf16_t* A; const bf16_t* Bt; int K; int lda = 0; long asplit = 0; };

__device__ __forceinline__ void tile_map(int L, int nM, int nN, int& pm, int& pn) {
    const int nwg = nM * nN; int wgid = L;
    { const int q = nwg / NXCD, r = nwg % NXCD, xcd = wgid % NXCD, off = wgid / NXCD; wgid = (xcd < r ? xcd * (q + 1) : r * (q + 1) + (xcd - r) * q) + off; }
    const int nig = WGM * nN, gid = wgid / nig, fm = gid * WGM, gsz = (nM - fm) < WGM ? (nM - fm) : WGM;
    pm = fm + ((wgid % nig) % gsz); pn = (wgid % nig) / gsz;
}
struct TileOrder {
    int nM, nN, G, c;
    __device__ __forceinline__ bool next(int i, Unit& u) const {
        const long L = (long)i * G + c; if (L >= (long)nM * nN) return false;
        tile_map((int)L, nM, nN, u.pm, u.pn); u.x = 0; u.y = 0; return true;
    }
    __device__ __forceinline__ int src_row(const Unit&, int) const { return 0; }
    __device__ __forceinline__ void done(const Unit&) const {}
};

template <class Epi, class Sched, bool GATHER, int PR = 0, bool ALIGN_EPI = true, bool SP2 = true>
__device__ __forceinline__ void gemm_phase(LAS unsigned char* lds, const Gemm g, const Sched& S, const Epi& E) {
    constexpr bool I8 = (PR == 1), BYTES = (PR != 0);
    typedef typename std::conditional<I8, i32x4, f32x4>::type acc_t;
    const int tid = opaque_v(my_tid()), wid = __builtin_amdgcn_readfirstlane(tid >> 6), lane = tid & 63, wr = wid >> 2, wc = wid & 3, fr = lane & 15, fq = lane >> 4;
    const int K = BYTES ? g.K / 2 : g.K, nt = K / BK;
    const int LA = g.lda ? (BYTES ? g.lda / 2 : g.lda) : K;
    unsigned voffA[2], voffB[2];
#pragma unroll
    for (int i = 0; i < 2; ++i) { int R, C; stage_rc(tid * 16 + i * 8192, R, C); const int Rb = Epi::PERM ? ((R & ~31) + perm32(R & 31)) : R;
        voffA[i] = (unsigned)(R * LA + C) * 2u; voffB[i] = (unsigned)(Rb * K + C) * 2u; }
    const size_t kstep = (size_t)(BK * 2);
    const size_t hstep = (size_t)HALF * K * 2;
    const size_t tstep = 2 * hstep;
    const size_t hstepA = (size_t)HALF * LA * 2, tstepA = 2 * hstepA; const long asplit = g.asplit;
    const __amdgpu_buffer_rsrc_t rsA = __builtin_amdgcn_make_buffer_rsrc((void*)g.A, 0, 0x7ffffff0, 0x00020000), rsB = __builtin_amdgcn_make_buffer_rsrc((void*)g.Bt, 0, 0x7ffffff0, 0x00020000);
#define PG8_KOFFA(t_) ((size_t)(t_) * kstep + ((t_) >= nt / 2 ? asplit : 0L))
    const unsigned ldsw = (unsigned)wid * 1024u;
    const int aoff = lds_byte(wr * 64 + fr, fq * 8), boff = lds_byte(wc * 32 + fr, fq * 8);
#define PG8_SA(b, h) (((b) * 2 + (h)) * HTB)
#define PG8_SB(b, h) ((4 + (b) * 2 + (h)) * HTB)
#define PG8_STAGE_R(bufoff, gbase, voff, RS, BP) do { const unsigned so_ = (unsigned)((const char*)(gbase) - (const char*)(BP)); _Pragma("unroll") for (int _i = 0; _i < 2; ++_i) \
        __builtin_amdgcn_raw_ptr_buffer_load_lds(RS, (LAS unsigned*)(lds + (bufoff) + ldsw + _i * 8192), 16, (int)(voff)[_i], (int)so_, 0, 0); } while (0)
#define PG8_STAGE(bufoff, gbase, voff) PG8_STAGE_R(bufoff, gbase, voff, rsB, g.Bt)
#define PG8_STAGE_A(bufoff, h, dptr, koff, vg) do { if constexpr (GATHER) PG8_STAGE_R(bufoff, (const char*)g.A + (koff), (vg)[h], rsA, g.A); else PG8_STAGE_R(bufoff, (dptr) + (h) * hstepA, voffA, rsA, g.A); } while (0)
#define PG8_LDA(dst, b, h) do { _Pragma("unroll") for (int m = 0; m < 4; ++m) { dst[m].lo = __builtin_bit_cast(i32x4, *(const LAS bf16x8*)(lds + PG8_SA(b, h) + aoff + m * 2048)); dst[m].hi = __builtin_bit_cast(i32x4, *(const LAS bf16x8*)(lds + PG8_SA(b, h) + aoff + m * 2048 + 1024)); } } while (0)
#define PG8_LDB(dst, b, h) do { _Pragma("unroll") for (int n = 0; n < 2; ++n) { dst[n].lo = __builtin_bit_cast(i32x4, *(const LAS bf16x8*)(lds + PG8_SB(b, h) + boff + n * 2048)); dst[n].hi = __builtin_bit_cast(i32x4, *(const LAS bf16x8*)(lds + PG8_SB(b, h) + boff + n * 2048 + 1024)); } } while (0)
#define PG8_FR(v, k) ((k) ? (v).hi : (v).lo)
#define PG8_MMA(ai, bj, At, Bt) do { __builtin_amdgcn_s_setprio(1); _Pragma("unroll") for (int m = 0; m < 4; ++m) _Pragma("unroll") for (int n = 0; n < 2; ++n) { \
        if constexpr (PR == 2) { acc[ai][bj][m][n] = __builtin_amdgcn_mfma_scale_f32_16x16x128_f8f6f4(Bt[n], At[m], acc[ai][bj][m][n], 0, 0, 0, 0x7F7F7F7F, 0, 0x7F7F7F7F); } \
        else { _Pragma("unroll") for (int k = 0; k < 2; ++k) { \
        if constexpr (I8) acc[ai][bj][m][n] = __builtin_amdgcn_mfma_i32_16x16x64_i8(PG8_FR(Bt[n], k), PG8_FR(At[m], k), acc[ai][bj][m][n], 0, 0, 0); \
        else acc[ai][bj][m][n] = __builtin_amdgcn_mfma_f32_16x16x32_bf16(__builtin_bit_cast(bf16x8, PG8_FR(Bt[n], k)), __builtin_bit_cast(bf16x8, PG8_FR(At[m], k)), acc[ai][bj][m][n], 0, 0, 0); } } } __builtin_amdgcn_s_setprio(0); } while (0)
#define PG8_WAIT_V(n) asm volatile("s_waitcnt vmcnt(" #n ")" ::: "memory")
#define PG8_WAIT_L(n) asm volatile("s_waitcnt lgkmcnt(" #n ")" ::: "memory")
#define PG8_BAR __builtin_amdgcn_s_barrier()
#define PG8_SCHED __builtin_amdgcn_sched_barrier(0)
#define PG8_GOFF(dst, u) do { const int t_ = opaque_v(tid); _Pragma("unroll") for (int _i = 0; _i < 2; ++_i) { int R_, C_; stage_rc(t_ * 16 + _i * 8192, R_, C_); \
        _Pragma("unroll") for (int _h = 0; _h < 2; ++_h) dst[_h][_i] = (unsigned)(S.src_row(u, _h * HALF + R_) * K + C_) * 2u; } } while (0)
    Unit cur, nxt, prv; int ui = 0;
    if (!S.next(0, cur)) return;
    prv = cur;
    unsigned vgC[2][2] = {{0u, 0u}, {0u, 0u}}, vgN[2][2] = {{0u, 0u}, {0u, 0u}};
    if constexpr (GATHER) PG8_GOFF(vgC, cur);
    acc_t acc[2][2][4][2];
#pragma unroll
    for (int a = 0; a < 2; ++a)
#pragma unroll
        for (int b = 0; b < 2; ++b)
#pragma unroll
            for (int m = 0; m < 4; ++m)
#pragma unroll
                for (int n = 0; n < 2; ++n) { int z0_, z1_, z2_, z3_; asm volatile("v_mov_b32 %0, 0\n\tv_mov_b32 %1, 0\n\tv_mov_b32 %2, 0\n\tv_mov_b32 %3, 0" : "=v"(z0_), "=v"(z1_), "=v"(z2_), "=v"(z3_)); acc[a][b][m][n] = __builtin_bit_cast(acc_t, (i32x4){z0_, z1_, z2_, z3_}); }
    i32x8 At[4], B0[2], B1[2];
    const char* cA = (const char*)g.A + (GATHER ? (size_t)0 : (size_t)cur.pm * tstepA); const char* cB = (const char*)g.Bt + (size_t)cur.pn * tstep;
    static_assert(SP2, "only the two-super-phase loop is kept");
    PG8_STAGE(PG8_SB(0, 0), cB, voffB); PG8_STAGE(PG8_SB(0, 1), cB + hstep, voffB); PG8_STAGE_A(PG8_SA(0, 0), 0, cA, 0, vgC); PG8_STAGE_A(PG8_SA(0, 1), 1, cA, 0, vgC);
    if (wr == 1) PG8_BAR;
    PG8_WAIT_V(2); PG8_BAR;
    PG8_STAGE(PG8_SB(1, 0), cB + kstep, voffB); PG8_STAGE_A(PG8_SA(1, 0), 0, cA + kstep, kstep, vgC); PG8_STAGE(PG8_SB(1, 1), cB + hstep + kstep, voffB);
    PG8_WAIT_V(6); PG8_BAR;
    for (;;) {
        const bool has_next = S.next(ui + 1, nxt);
        if constexpr (GATHER) { if (has_next) PG8_GOFF(vgN, nxt); else {
#pragma unroll
            for (int h_ = 0; h_ < 2; ++h_)
#pragma unroll
                for (int i_ = 0; i_ < 2; ++i_) vgN[h_][i_] = vgC[h_][i_]; } }
        const char* nA = (has_next && !GATHER) ? (const char*)g.A + (size_t)nxt.pm * tstepA : cA; const char* nB = has_next ? (const char*)g.Bt + (size_t)nxt.pn * tstep : cB;
#pragma unroll 1
        for (int t = 0; t < nt; t += 2) {
            const bool last = (t == nt - 2);
            if constexpr (Epi::MIDHOOK) { if (t == nt / 2) E.mid(acc, cur, wr, wc, opaque_v(fr), fq); }
            const char* a1 = cA + PG8_KOFFA(t + 1); const size_t k1 = (size_t)(t + 1) * kstep;
            const char* a2 = last ? nA : cA + PG8_KOFFA(t + 2); const char* b2 = last ? nB : cB + (size_t)(t + 2) * kstep;
            const size_t k2 = last ? (size_t)0 : (size_t)(t + 2) * kstep, k3 = k2 + kstep;
            const char* a3 = a2 + kstep; const char* b3 = b2 + kstep;
            PG8_LDB(B0, 0, 0); PG8_LDB(B1, 0, 1); PG8_SCHED; PG8_LDA(At, 0, 0); PG8_STAGE_A(PG8_SA(1, 1), 1, a1, k1, vgC);
            if constexpr (GATHER) { if (last) {
#pragma unroll
                for (int h_ = 0; h_ < 2; ++h_)
#pragma unroll
                    for (int i_ = 0; i_ < 2; ++i_) vgC[h_][i_] = vgN[h_][i_]; } }
            PG8_WAIT_V(8); PG8_WAIT_L(0); PG8_BAR; PG8_MMA(0, 0, At, B0); PG8_MMA(0, 1, At, B1); PG8_BAR; PG8_SCHED;
            PG8_LDA(At, 0, 1); PG8_STAGE(PG8_SB(0, 0), b2, voffB); PG8_STAGE(PG8_SB(0, 1), b2 + hstep, voffB); PG8_STAGE_A(PG8_SA(0, 0), 0, a2, k2, vgC);
            PG8_WAIT_V(8); PG8_WAIT_L(0); PG8_BAR; PG8_MMA(1, 0, At, B0); PG8_MMA(1, 1, At, B1); PG8_BAR; PG8_SCHED;
            PG8_LDB(B0, 1, 0); PG8_LDB(B1, 1, 1); PG8_SCHED; PG8_LDA(At, 1, 0); PG8_STAGE_A(PG8_SA(0, 1), 1, a2, k2, vgC);
            PG8_WAIT_V(8); PG8_WAIT_L(0); PG8_BAR; PG8_MMA(0, 0, At, B0); PG8_MMA(0, 1, At, B1); PG8_BAR; PG8_SCHED;
            PG8_LDA(At, 1, 1); PG8_STAGE(PG8_SB(1, 0), b3, voffB); PG8_STAGE(PG8_SB(1, 1), b3 + hstep, voffB); PG8_STAGE_A(PG8_SA(1, 0), 0, a3, k3, vgC);
            PG8_WAIT_V(8); PG8_WAIT_L(0); PG8_BAR; PG8_MMA(1, 0, At, B0); PG8_MMA(1, 1, At, B1); PG8_BAR; PG8_SCHED;
        }
        if constexpr (ALIGN_EPI) { if (wr == 0) PG8_BAR; }
        if (ui > 0) S.done(prv);
        E(acc, cur, wr, wc, opaque_v(fr), fq);
        prv = cur;
        if (!has_next) break;
#pragma unroll
        for (int a = 0; a < 2; ++a)
#pragma unroll
            for (int b = 0; b < 2; ++b)
#pragma unroll
                for (int m = 0; m < 4; ++m)
#pragma unroll
                    for (int n = 0; n < 2; ++n) { int z0_, z1_, z2_, z3_; asm volatile("v_mov_b32 %0, 0\n\tv_mov_b32 %1, 0\n\tv_mov_b32 %2, 0\n\tv_mov_b32 %3, 0" : "=v"(z0_), "=v"(z1_), "=v"(z2_), "=v"(z3_)); acc[a][b][m][n] = __builtin_bit_cast(acc_t, (i32x4){z0_, z1_, z2_, z3_}); }
        cur = nxt; cA = nA; cB = nB; ++ui;
        if constexpr (ALIGN_EPI) { if (wr == 1) PG8_BAR; }
    }
    PG8_WAIT_V(0);
    S.done(prv);
    if constexpr (!ALIGN_EPI) { if (wr == 0) PG8_BAR; }
    PG8_BAR;
#undef PG8_SA
#undef PG8_SB
#undef PG8_STAGE
#undef PG8_STAGE_R
#undef PG8_STAGE_A
#undef PG8_LDA
#undef PG8_LDB
#undef PG8_MMA
#undef PG8_WAIT_V
#undef PG8_WAIT_L
#undef PG8_BAR
#undef PG8_SCHED
#undef PG8_GOFF
#undef PG8_FR
#undef PG8_KOFFA
}
}

#define XB_TMO      128
#define XB_XCNT(j)  (256  + 64 * (j))
#define XB_XSUB(j)  (1280 + 64 * (j))
#define XB_XGEN(j)  (2304 + 64 * (j))
#define XB_TOP      3328
#define XB_TOPGEN   3392
#define XCD_BAR_WORDS 3456
#define XB_SPIN_CAP (1u << 18)

__device__ __forceinline__ unsigned xb_ld(unsigned* p)              { return __hip_atomic_load(p, __ATOMIC_RELAXED, __HIP_MEMORY_SCOPE_AGENT); }
__device__ __forceinline__ unsigned xb_add(unsigned* p, unsigned v) { return __hip_atomic_fetch_add(p, v, __ATOMIC_RELAXED, __HIP_MEMORY_SCOPE_AGENT); }
__device__ __forceinline__ unsigned xb_xcc_id() { return (unsigned)__builtin_amdgcn_s_getreg((3 << 11) | 20) & 0xFu; }
#define XB_SPIN(cond, bar) do { unsigned _sp = 0; while (cond) { __builtin_amdgcn_s_sleep(1); \
    if ((++_sp & 255u) == 0u) { if (xb_ld(&(bar)[XB_TMO])) break; if (_sp > XB_SPIN_CAP) { atomicAdd(&(bar)[XB_TMO], 1u); break; } } } } while (0)

struct XcdBarrier {
    unsigned* bar; unsigned x;
    volatile LAS unsigned* st;
};

__device__ __forceinline__ XcdBarrier xcd_barrier_post(unsigned* bar, volatile LAS unsigned* st) {
    XcdBarrier b; b.bar = bar; b.x = xb_xcc_id(); b.st = st;
    if (threadIdx.x == 0) (void)xb_add(&bar[XB_XCNT(b.x)], 1u);
    return b;
}
__device__ __forceinline__ void xcd_barrier_complete(unsigned* bar, unsigned x, unsigned& nloc, unsigned& nx) {
    const unsigned G = gridDim.x * gridDim.y * gridDim.z;
    unsigned sum, cnt, mine, sp = 0u;
    for (;;) {
        sum = 0u; cnt = 0u; mine = 0u;
#pragma unroll
        for (unsigned j = 0; j < 16; ++j) { const unsigned c = xb_ld(&bar[XB_XCNT(j)]); sum += c; cnt += (c > 0u) ? 1u : 0u; mine = (j == x) ? c : mine; }
        if (sum == G) break;
        __builtin_amdgcn_s_sleep(1);
        if ((++sp & 255u) == 0u) { if (xb_ld(&bar[XB_TMO])) break; if (sp > XB_SPIN_CAP) { atomicAdd(&bar[XB_TMO], 1u); break; } }
    }
    nloc = mine > 0u ? mine : 1u; nx = cnt > 0u ? cnt : 1u;
}

__device__ __forceinline__ void xcd_barrier(const XcdBarrier& b) {
    asm volatile("s_waitcnt vmcnt(0)" ::: "memory");
    __syncthreads();
    if (my_tid() == 0) {
        unsigned* bar = b.bar;
        __builtin_amdgcn_s_waitcnt(0);
        unsigned nloc = b.st[0], nx = b.st[1];
        if (nloc == 0u) { xcd_barrier_complete(bar, b.x, nloc, nx); b.st[0] = nloc; b.st[1] = nx; }
        const unsigned old = xb_add(&bar[XB_XSUB(b.x)], 1u);
        const unsigned gen = old / nloc;
        if (old + 1u == (gen + 1u) * nloc) {
            __builtin_amdgcn_fence(__ATOMIC_RELEASE, "agent");
            asm volatile("s_waitcnt vmcnt(0)" ::: "memory");
            const unsigned og = xb_add(&bar[XB_TOP], 1u);
            const unsigned tg = og / nx;
            if (og + 1u == (tg + 1u) * nx) xb_add(&bar[XB_TOPGEN], 1u);
            else XB_SPIN(xb_ld(&bar[XB_TOPGEN]) == tg, bar);
            __builtin_amdgcn_fence(__ATOMIC_ACQUIRE, "agent");
            xb_add(&bar[XB_XGEN(b.x)], 1u);
            asm volatile("s_waitcnt vmcnt(0)" ::: "memory");
        } else {
            XB_SPIN(xb_ld(&bar[XB_XGEN(b.x)]) == gen, bar);
            __builtin_amdgcn_fence(__ATOMIC_ACQUIRE, "agent");
            asm volatile("s_waitcnt vmcnt(0)" ::: "memory");
        }
    }
    __syncthreads();
}

#ifndef ATT_B_SDEPTH
#define ATT_B_SDEPTH 2
#endif
#ifndef ATT_B_QPARK
#define ATT_B_QPARK 5
#endif

namespace att {
constexpr int D = 128, NW = 8, QBLK = 32, KVBLK = 64;
constexpr float THR = 8.f;
constexpr size_t SHM_V = KVBLK * D * 2, SHM_K = KVBLK * D * 2, SHM_KR = KVBLK * 64 * 2;
constexpr size_t OFF_V = 0, OFF_K = 2 * SHM_V, OFF_KR = OFF_K + 2 * SHM_K, OFF_WS = OFF_KR + 2 * SHM_KR, OFF_QR = OFF_WS + NW * 64 * 4, SHM_ATTN = OFF_QR + NW * 9216;
#define KSWZ(row, colB) ((row) * 256 + ((colB) ^ ((((row) & 7) | (((row) >> 1) & 8)) << 4)))
#define KRSWZ(row, colB) ((row) * 128 + ((colB) ^ ((((row) >> 1) & 7) << 4)))
#define SBAR() __builtin_amdgcn_sched_barrier(0)
__device__ __forceinline__ int crow(int r, int hi) { return (r & 3) + 8 * (r >> 2) + 4 * hi; }
typedef __bf16 bf16x2_t __attribute__((ext_vector_type(2)));
__device__ __forceinline__ unsigned cvtpk(float lo, float hi) { const f32x2 v = {lo, hi}; return __builtin_bit_cast(unsigned, __builtin_convertvector(v, bf16x2_t)); }
template <int DR> __device__ __forceinline__ void seg1_sched() {
  __builtin_amdgcn_sched_group_barrier(0x100, DR ? 4 : 3, 0);
#pragma unroll
  for (int i = 0; i < 8; ++i) {
    __builtin_amdgcn_sched_group_barrier(0x008, 1, 0); __builtin_amdgcn_sched_group_barrier(0x100, 1, 0); __builtin_amdgcn_sched_group_barrier(0x400, 1, 0); __builtin_amdgcn_sched_group_barrier(0x002, DR ? 3 : 4, 0);
    __builtin_amdgcn_sched_group_barrier(0x008, 1, 0); __builtin_amdgcn_sched_group_barrier(0x100, DR ? 2 : 1, 0); __builtin_amdgcn_sched_group_barrier(0x400, 1, 0); __builtin_amdgcn_sched_group_barrier(0x002, DR ? 3 : 4, 0); }
  if constexpr (DR > 0) {
#pragma unroll
    for (int i = 0; i < 4; ++i) {
      __builtin_amdgcn_sched_group_barrier(0x008, 1, 0); __builtin_amdgcn_sched_group_barrier(0x100, 1, 0); __builtin_amdgcn_sched_group_barrier(0x002, 2, 0);
      __builtin_amdgcn_sched_group_barrier(0x008, 1, 0); __builtin_amdgcn_sched_group_barrier(0x100, 2, 0); __builtin_amdgcn_sched_group_barrier(0x002, 2, 0); }
  }
}
__device__ __forceinline__ bf16x8 ld8(const bf16_t* p) { return *reinterpret_cast<const bf16x8*>(p); }

template <int DR> struct Cfg { static constexpr float SCALE = 0.6931471805599453f; };

template <int DR>
__device__ __forceinline__ void partialSM(f32x16& p0, f32x16& p1, float& m_reg, float& mn, float& alpha) {
  constexpr float SCALE = Cfg<DR>::SCALE; constexpr float C = SCALE * 1.4426950408889634f;
  float pmax = p0[0];
#pragma unroll
  for (int r = 1; r < 16; ++r) pmax = fmaxf(pmax, p0[r]);
#pragma unroll
  for (int r = 0; r < 16; ++r) pmax = fmaxf(pmax, p1[r]);
  { auto rr = __builtin_amdgcn_permlane32_swap(__float_as_uint(pmax), __float_as_uint(pmax), false, false);
    pmax = fmaxf(__uint_as_float(rr[0]), __uint_as_float(rr[1])); }
  if (__builtin_expect(__all(pmax - m_reg <= THR / SCALE), 1)) { mn = m_reg; alpha = 1.f; }
  else { mn = fmaxf(m_reg, pmax); alpha = __builtin_amdgcn_exp2f((m_reg - mn) * C); m_reg = mn; }
  float mnC = -mn * C;
#pragma unroll
  for (int r = 0; r < 16; ++r) p0[r] = fmaf(p0[r], C, mnC);
#pragma unroll
  for (int r = 0; r < 16; ++r) p1[r] = fmaf(p1[r], C, mnC);
#pragma unroll
  for (int r = 0; r < 16; ++r) p0[r] = __builtin_amdgcn_exp2f(p0[r]);
}
__device__ __forceinline__ void finishSM(f32x16& p0, f32x16& p1, float alpha, float& l_reg, bf16x8& pa0, bf16x8& pa1, bf16x8& pa2, bf16x8& pa3) {
#pragma unroll
  for (int r = 0; r < 16; ++r) p1[r] = __builtin_amdgcn_exp2f(p1[r]);
  float ps = 0;
#pragma unroll
  for (int r = 0; r < 16; ++r) ps += p0[r];
#pragma unroll
  for (int r = 0; r < 16; ++r) ps += p1[r];
  { auto rr = __builtin_amdgcn_permlane32_swap(__float_as_uint(ps), __float_as_uint(ps), false, false);
    ps = __uint_as_float(rr[0]) + __uint_as_float(rr[1]); }
  l_reg = l_reg * alpha + ps;
#define PK4(P, BASE, OUT) do { u32x4 w = {cvtpk(P[BASE + 0], P[BASE + 1]), cvtpk(P[BASE + 2], P[BASE + 3]), cvtpk(P[BASE + 4], P[BASE + 5]), cvtpk(P[BASE + 6], P[BASE + 7])}; \
    OUT = __builtin_bit_cast(bf16x8, w); } while (0)
  PK4(p0, 0, pa0); PK4(p0, 8, pa1); PK4(p1, 0, pa2); PK4(p1, 8, pa3);
#undef PK4
}
__device__ __forceinline__ void finishSM_fast(f32x16& p0, f32x16& p1, float& l_reg, bf16x8& pa0, bf16x8& pa1, bf16x8& pa2, bf16x8& pa3) {
#pragma unroll
  for (int r = 0; r < 16; ++r) p1[r] = __builtin_amdgcn_exp2f(p1[r]);
  float ps = 0;
#pragma unroll
  for (int r = 0; r < 16; ++r) ps += p0[r];
#pragma unroll
  for (int r = 0; r < 16; ++r) ps += p1[r];
  { auto rr = __builtin_amdgcn_permlane32_swap(__float_as_uint(ps), __float_as_uint(ps), false, false);
    ps = __uint_as_float(rr[0]) + __uint_as_float(rr[1]); }
  l_reg += ps;
#define PK4(P, BASE, OUT) do { u32x4 w = {cvtpk(P[BASE + 0], P[BASE + 1]), cvtpk(P[BASE + 2], P[BASE + 3]), cvtpk(P[BASE + 4], P[BASE + 5]), cvtpk(P[BASE + 6], P[BASE + 7])}; \
    OUT = __builtin_bit_cast(bf16x8, w); } while (0)
  PK4(p0, 0, pa0); PK4(p0, 8, pa1); PK4(p1, 0, pa2); PK4(p1, 8, pa3);
#undef PK4
}
__device__ __forceinline__ void exp16(f32x16& p) {
#pragma unroll
  for (int r = 0; r < 16; ++r) p[r] = __builtin_amdgcn_exp2f(p[r]);
}
template <int DR, int QPARK>
__device__ __forceinline__ void qkt(f32x16& p0, f32x16& p1, const char* Ks, const char* KRs, const bf16x8* qr, const char* QRs, int r32, int hi) {
  p0 = f32x16{}; p1 = f32x16{};
#pragma unroll
  for (int d0 = 0; d0 < 8; ++d0) { int cb = (d0 * 16 + hi * 8) * 2;
    bf16x8 b0 = *reinterpret_cast<const bf16x8*>(Ks + KSWZ(r32, cb));
    bf16x8 b1 = *reinterpret_cast<const bf16x8*>(Ks + KSWZ(32 + r32, cb));
    bf16x8 q; if (d0 >= 8 - QPARK) q = *reinterpret_cast<const bf16x8*>(QRs + (4 + d0 - (8 - QPARK)) * 1024); else q = qr[d0];
    p0 = __builtin_amdgcn_mfma_f32_32x32x16_bf16(b0, q, p0, 0, 0, 0);
    p1 = __builtin_amdgcn_mfma_f32_32x32x16_bf16(b1, q, p1, 0, 0, 0); }
  if constexpr (DR > 0) {
#pragma unroll
    for (int d0 = 0; d0 < DR / 16; ++d0) { int cb = (d0 * 16 + hi * 8) * 2;
      bf16x8 b0 = *reinterpret_cast<const bf16x8*>(KRs + KRSWZ(r32, cb));
      bf16x8 b1 = *reinterpret_cast<const bf16x8*>(KRs + KRSWZ(32 + r32, cb));
      bf16x8 q; if constexpr (QPARK >= 0) q = *reinterpret_cast<const bf16x8*>(QRs + d0 * 1024); else q = qr[8 + d0];
      p0 = __builtin_amdgcn_mfma_f32_32x32x16_bf16(b0, q, p0, 0, 0, 0);
      p1 = __builtin_amdgcn_mfma_f32_32x32x16_bf16(b1, q, p1, 0, 0, 0); }
  }
}
__device__ __forceinline__ int v_st(int k, int c) { const int kk = k; return ((kk >> 3) * 4 + (c >> 5)) * 512 + ((kk & 7) * 32 + (c & 31)) * 2; }
__device__ __forceinline__ int v_rd_base(int lane) { return ((lane & 3) << 3) | (((lane >> 2) & 3) << 6) | (((lane >> 4) & 1) << 5) | (((lane >> 5) & 1) << 8); }
constexpr int v_rd_off(int d0, int ks, int half) { return d0 * 512 + ks * 4096 + half * 2048; }
template <int OFF> __device__ __forceinline__ s16x4 tr_read(int vb) {
  s16x4 r; asm volatile("ds_read_b64_tr_b16 %0, %1 offset:%2" : "=&v"(r) : "v"(vb), "i"(OFF) : "memory"); return r;
}
template <int D0> __device__ __forceinline__ void pv_one(f32x16& od, int vb, bf16x8 pa0, bf16x8 pa1, bf16x8 pa2, bf16x8 pa3) {
  const s16x4 l0 = tr_read<v_rd_off(D0, 0, 0)>(vb), h0 = tr_read<v_rd_off(D0, 0, 1)>(vb), l1 = tr_read<v_rd_off(D0, 1, 0)>(vb), h1 = tr_read<v_rd_off(D0, 1, 1)>(vb);
  const s16x4 l2 = tr_read<v_rd_off(D0, 2, 0)>(vb), h2 = tr_read<v_rd_off(D0, 2, 1)>(vb), l3 = tr_read<v_rd_off(D0, 3, 0)>(vb), h3 = tr_read<v_rd_off(D0, 3, 1)>(vb);
  asm volatile("s_waitcnt lgkmcnt(0)" ::: "memory"); SBAR();
#define PK(L, H) (bf16x8){L[0], L[1], L[2], L[3], H[0], H[1], H[2], H[3]}
  od = __builtin_amdgcn_mfma_f32_32x32x16_bf16(pa0, PK(l0, h0), od, 0, 0, 0);
  od = __builtin_amdgcn_mfma_f32_32x32x16_bf16(pa1, PK(l1, h1), od, 0, 0, 0);
  od = __builtin_amdgcn_mfma_f32_32x32x16_bf16(pa2, PK(l2, h2), od, 0, 0, 0);
  od = __builtin_amdgcn_mfma_f32_32x32x16_bf16(pa3, PK(l3, h3), od, 0, 0, 0);
#undef PK
}
template <int DR>
__device__ __forceinline__ void pv_partialSM(f32x16* o, int vb, bf16x8 pa0, bf16x8 pa1, bf16x8 pa2, bf16x8 pa3, f32x16& p0, f32x16& p1, float& m_reg, float& mnC, float& alpha) {
  constexpr float SCALE = Cfg<DR>::SCALE; constexpr float C = SCALE * 1.4426950408889634f;
  pv_one<0>(o[0], vb, pa0, pa1, pa2, pa3);
  float pmax = p0[0];
#pragma unroll
  for (int r = 1; r < 16; ++r) pmax = fmaxf(pmax, p0[r]);
#pragma unroll
  for (int r = 0; r < 16; ++r) pmax = fmaxf(pmax, p1[r]);
  { auto rr = __builtin_amdgcn_permlane32_swap(__float_as_uint(pmax), __float_as_uint(pmax), false, false);
    pmax = fmaxf(__uint_as_float(rr[0]), __uint_as_float(rr[1])); }
  alpha = 1.f;
  if (__builtin_expect(!__all(pmax - m_reg <= THR / SCALE), 0)) {
    asm volatile("" ::: "memory");
    const float mn = fmaxf(m_reg, pmax); alpha = __builtin_amdgcn_exp2f((m_reg - mn) * C); m_reg = mn; mnC = -mn * C; }
  pv_one<1>(o[1], vb, pa0, pa1, pa2, pa3);
#pragma unroll
  for (int r = 0; r < 16; ++r) p0[r] = fmaf(p0[r], C, mnC);
#pragma unroll
  for (int r = 0; r < 8; ++r) p0[r] = __builtin_amdgcn_exp2f(p0[r]);
  pv_one<2>(o[2], vb, pa0, pa1, pa2, pa3);
#pragma unroll
  for (int r = 8; r < 16; ++r) p0[r] = __builtin_amdgcn_exp2f(p0[r]);
#pragma unroll
  for (int r = 0; r < 8; ++r) p1[r] = fmaf(p1[r], C, mnC);
  pv_one<3>(o[3], vb, pa0, pa1, pa2, pa3);
#pragma unroll
  for (int r = 8; r < 16; ++r) p1[r] = fmaf(p1[r], C, mnC);
  asm volatile("" : "+v"(p0), "+v"(p1));
}
__device__ __forceinline__ void pv_fast(f32x16* o, int vb, bf16x8 pa0, bf16x8 pa1, bf16x8 pa2, bf16x8 pa3, f32x16& p0) {
  pv_one<0>(o[0], vb, pa0, pa1, pa2, pa3);
#pragma unroll
  for (int r = 0; r < 4; ++r) p0[r] = __builtin_amdgcn_exp2f(p0[r]);
  pv_one<1>(o[1], vb, pa0, pa1, pa2, pa3);
#pragma unroll
  for (int r = 4; r < 8; ++r) p0[r] = __builtin_amdgcn_exp2f(p0[r]);
  pv_one<2>(o[2], vb, pa0, pa1, pa2, pa3);
#pragma unroll
  for (int r = 8; r < 12; ++r) p0[r] = __builtin_amdgcn_exp2f(p0[r]);
  pv_one<3>(o[3], vb, pa0, pa1, pa2, pa3);
#pragma unroll
  for (int r = 12; r < 16; ++r) p0[r] = __builtin_amdgcn_exp2f(p0[r]);
  asm volatile("" : "+v"(p0));
}
__device__ __forceinline__ void pv_d0(f32x16* o, int vb, bf16x8 pa0, bf16x8 pa1, bf16x8 pa2, bf16x8 pa3) {
  pv_one<0>(o[0], vb, pa0, pa1, pa2, pa3); pv_one<1>(o[1], vb, pa0, pa1, pa2, pa3); pv_one<2>(o[2], vb, pa0, pa1, pa2, pa3); pv_one<3>(o[3], vb, pa0, pa1, pa2, pa3);
}

constexpr int ATT_FLAG_OFF = 159744 + 768;
#ifndef ATT_FORCE_SLOW
#define ATT_FORCE_SLOW 0
#endif
template <int DR, int QPARK, int SDEPTH, int LDQ, int LDK, int LDV, int LDO, bool O8 = false, bool FAST = false>
__device__ __forceinline__ bool attn_body(const bf16_t* __restrict__ Qb, const bf16_t* __restrict__ Kh, const bf16_t* __restrict__ Vh, const bf16_t* __restrict__ KRh,
                                          bf16_t* __restrict__ Ob, int seq, char* lds) {
  constexpr int NQ = (QPARK < 0) ? 8 + DR / 16 : (QPARK == 8 ? 1 : 8 - QPARK);
  constexpr int QPB = (QPARK < 0) ? 0 : (DR / 16 + QPARK) * 1024;
  static_assert(LDK == LDV, "K and V share the staging offsets");
  const int tid = opaque_v(my_tid()), wid = tid >> 6, lane = tid & 63, r32 = lane & 31, hi = lane >> 5;
  char* V_lds = lds + OFF_V; char* K_lds = lds + OFF_K; char* KR_lds = lds + OFF_KR;
  float* ws = (float*)(lds + OFF_WS) + wid * 64; float* li_l = ws; float* al_l = ws + 32;
  float m_reg = -1e30f, l_reg = 0; f32x16 o[4] = {}; bf16x8 qr[NQ];
  if constexpr (FAST) { if (tid == 0) *(volatile LAS unsigned*)(unsigned long)ATT_FLAG_OFF = 0u; }
  const bf16_t* Qw = Qb + (long)(wid * QBLK + r32) * LDQ + hi * 8;
#pragma unroll
  for (int d0 = 0; d0 < NQ; ++d0) { if constexpr (QPARK == 8) qr[d0] = bf16x8{}; else qr[d0] = ld8(Qw + d0 * 16); }
  char* QRs = lds + OFF_QR + wid * QPB + lane * 16;
  if constexpr (QPARK >= 0) {
#pragma unroll
    for (int d0 = 0; d0 < DR / 16; ++d0) *(bf16x8*)(QRs + d0 * 1024) = ld8(Qw + 128 + d0 * 16);
#pragma unroll
    for (int d0 = 8 - QPARK; d0 < 8; ++d0) *(bf16x8*)(QRs + (4 + d0 - (8 - QPARK)) * 1024) = ld8(Qw + d0 * 16);
  }
  const int sr = tid >> 4, sc = (tid & 15) * 8, vst0 = v_st(sr, sc), vst1 = v_st(32 + sr, sc);
  const int krr = tid >> 3, krc = (tid & 7) * 8;
  const int vb0 = (int)(uintptr_t)V_lds + v_rd_base(lane);
  struct { bf16x8 vs0, vs1, ks0, ks1, kr; } sr_[SDEPTH];
  const unsigned soff0 = (unsigned)(sr * LDK + sc) * 2u, soff1 = soff0 + (unsigned)(32 * LDK * 2), sofr = (unsigned)(krr * 64 + krc) * 2u;
  const __amdgpu_buffer_rsrc_t rsV = __builtin_amdgcn_make_buffer_rsrc((void*)Vh, 0, 0x7ffffff0, 0x00020000), rsK = __builtin_amdgcn_make_buffer_rsrc((void*)Kh, 0, 0x7ffffff0, 0x00020000);
  const __amdgpu_buffer_rsrc_t rsR = __builtin_amdgcn_make_buffer_rsrc((void*)(DR > 0 ? KRh : Kh), 0, 0x7ffffff0, 0x00020000);
#define BL128(rs, vo, so) __builtin_bit_cast(bf16x8, __builtin_amdgcn_raw_buffer_load_b128(rs, (int)(vo), (int)(so), 0))
#define SLOAD(i, k0) do { const unsigned so_ = (unsigned)(k0) * (unsigned)(LDV * 2); \
    sr_[i].vs0 = BL128(rsV, soff0, so_); sr_[i].vs1 = BL128(rsV, soff1, so_); \
    sr_[i].ks0 = BL128(rsK, soff0, so_); sr_[i].ks1 = BL128(rsK, soff1, so_); \
    if constexpr (DR > 0) sr_[i].kr = BL128(rsR, sofr, (unsigned)(k0) * 128u); } while (0)
#define SWRITE(b, i) do { *(bf16x8*)(V_lds + (b) * SHM_V + vst0) = sr_[i].vs0;          \
    *(bf16x8*)(V_lds + (b) * SHM_V + vst1) = sr_[i].vs1; int kc = sc * 2;               \
    *(bf16x8*)(K_lds + (b) * SHM_K + KSWZ(sr, kc)) = sr_[i].ks0;                       \
    *(bf16x8*)(K_lds + (b) * SHM_K + KSWZ(32 + sr, kc)) = sr_[i].ks1;                  \
    if constexpr (DR > 0) *(bf16x8*)(KR_lds + (b) * SHM_KR + KRSWZ(krr, krc * 2)) = sr_[i].kr; } while (0)
#define SWAIT() do { if constexpr (SDEPTH == 2) { if constexpr (DR > 0) asm volatile("s_waitcnt vmcnt(5)" ::: "memory"); else asm volatile("s_waitcnt vmcnt(4)" ::: "memory"); } \
    else asm volatile("s_waitcnt vmcnt(0)" ::: "memory"); } while (0)
#define RESC(a) do { if (__any((a) < 1.f)) { if (hi == 0) al_l[r32] = (a); asm volatile("s_waitcnt lgkmcnt(0)" ::: "memory"); \
    _Pragma("unroll") for (int d = 0; d < 4; ++d) _Pragma("unroll") for (int r = 0; r < 16; ++r) o[d][r] *= al_l[crow(r, hi)]; } } while (0)
  f32x16 pA0, pA1, pB0, pB1; float mnA, mnB, alA, alB; bf16x8 pa0, pa1, pa2, pa3; const int NT = seq / KVBLK;
  constexpr int SE = 0, SO = SDEPTH - 1;
  SLOAD(SE, 0); asm volatile("s_waitcnt vmcnt(0)" ::: "memory"); SWRITE(0, SE); __syncthreads();
  qkt<DR, QPARK>(pA0, pA1, K_lds, KR_lds, qr, QRs, r32, hi);
  if constexpr (FAST) exp16(pA0); else partialSM<DR>(pA0, pA1, m_reg, mnA, alA);
  float mnC_ = -m_reg * (Cfg<DR>::SCALE * 1.4426950408889634f);
  SLOAD(SO, KVBLK); if constexpr (SDEPTH == 2) { if (2 < NT) SLOAD(SE, 2 * KVBLK); }
  SWAIT(); SWRITE(1, SO); __syncthreads();
  for (int j = 1; j + 1 < NT; j += 2) {
    SBAR(); qkt<DR, QPARK>(pB0, pB1, K_lds + SHM_K, KR_lds + SHM_KR, qr, QRs, r32, hi);
    if constexpr (FAST) finishSM_fast(pA0, pA1, l_reg, pa0, pa1, pa2, pa3); else finishSM(pA0, pA1, alA, l_reg, pa0, pa1, pa2, pa3);
    seg1_sched<DR>(); SBAR();
    SLOAD(SO, (j + SDEPTH) * KVBLK); SBAR();
    if constexpr (FAST) pv_fast(o, vb0, pa0, pa1, pa2, pa3, pB0); else pv_partialSM<DR>(o, vb0, pa0, pa1, pa2, pa3, pB0, pB1, m_reg, mnC_, alB);
    __syncthreads(); SWAIT(); SWRITE(0, SE);
    if constexpr (!FAST) RESC(alB);
    __syncthreads();
    SBAR(); qkt<DR, QPARK>(pA0, pA1, K_lds, KR_lds, qr, QRs, r32, hi);
    if constexpr (FAST) finishSM_fast(pB0, pB1, l_reg, pa0, pa1, pa2, pa3); else finishSM(pB0, pB1, alB, l_reg, pa0, pa1, pa2, pa3);
    seg1_sched<DR>(); SBAR();
    if (SDEPTH == 1 || j + 3 < NT) SLOAD(SE, (j + 1 + SDEPTH) * KVBLK); SBAR();
    if constexpr (FAST) pv_fast(o, vb0 + (int)SHM_V, pa0, pa1, pa2, pa3, pA0); else pv_partialSM<DR>(o, vb0 + (int)SHM_V, pa0, pa1, pa2, pa3, pA0, pA1, m_reg, mnC_, alA);
    __syncthreads(); SWAIT(); SWRITE(1, SO);
    if constexpr (!FAST) RESC(alA);
    __syncthreads();
  }
  SBAR(); qkt<DR, QPARK>(pB0, pB1, K_lds + SHM_K, KR_lds + SHM_KR, qr, QRs, r32, hi);
  if constexpr (FAST) { finishSM_fast(pA0, pA1, l_reg, pa0, pa1, pa2, pa3); SBAR(); pv_fast(o, vb0, pa0, pa1, pa2, pa3, pB0); __syncthreads();
    finishSM_fast(pB0, pB1, l_reg, pa0, pa1, pa2, pa3); SBAR(); }
  else {
  finishSM(pA0, pA1, alA, l_reg, pa0, pa1, pa2, pa3); SBAR();
  pv_d0(o, vb0, pa0, pa1, pa2, pa3); partialSM<DR>(pB0, pB1, m_reg, mnB, alB);
  __syncthreads(); RESC(alB);
  finishSM(pB0, pB1, alB, l_reg, pa0, pa1, pa2, pa3); SBAR(); }
  pv_d0(o, vb0 + (int)SHM_V, pa0, pa1, pa2, pa3);
  if constexpr (FAST) {
    const bool bad = ATT_FORCE_SLOW || !(l_reg > 1e-30f && l_reg < 1e30f);
    if (__any(bad) && lane == 0) *(volatile LAS unsigned*)(unsigned long)ATT_FLAG_OFF = 1u;
    __syncthreads();
    const unsigned wgbad = *(volatile LAS unsigned*)(unsigned long)ATT_FLAG_OFF;
    if (wgbad) { __syncthreads(); return true; }
  }
  if (hi == 0) li_l[r32] = l_reg; asm volatile("s_waitcnt lgkmcnt(0)" ::: "memory");
  float rli[16];
#pragma unroll
  for (int r = 0; r < 16; ++r) rli[r] = __builtin_amdgcn_rcpf(li_l[crow(r, hi)]);
  bf16_t* Ow = Ob + (long)(wid * QBLK) * LDO;
#pragma unroll
  for (int r = 0; r < 16; ++r) { int orow = crow(r, hi);
#pragma unroll
    for (int d0 = 0; d0 < 4; ++d0) {
      if constexpr (O8) { const float v = fminf(fmaxf(o[d0][r] * rli[r] * 64.0f, -448.f), 448.f);
        ((unsigned char*)Ob)[(long)(wid * QBLK + orow) * LDO + d0 * 32 + r32] = (unsigned char)(__builtin_amdgcn_cvt_pk_fp8_f32(v, 0.f, 0u, false) & 0xffu); }
      else { const unsigned w = cvtpk(o[d0][r] * rli[r], 0.f); Ow[(long)orow * LDO + d0 * 32 + r32] = (bf16_t)(w & 0xffffu); } } }
  __syncthreads();
  return false;
#undef SLOAD
#undef SWRITE
#undef SWAIT
#undef RESC
}
}

__device__ __forceinline__ int rope_perm128(int j) { return j < 64 ? 2 * j : 2 * (j - 64) + 1; }
__device__ __forceinline__ int rope_perm64(int r) { return r < 32 ? 2 * r : 2 * (r - 32) + 1; }
template <int MODE> __device__ __forceinline__ int rowmap(int n) {
    if constexpr (MODE == 0) return n;
    else if constexpr (MODE == 1) {
        if (n < 1280) return (n & ~127) + rope_perm128(n & 127);
        if (n < 1536) return n;
        if (n < 3072) { const int q = n - 1536, h = q / 192, j = q % 192; return 1536 + h * 192 + (j < 128 ? j : 128 + rope_perm64(j - 128)); }
        if (n < 3584) return n;
        if (n < 3648) return C_KR + rope_perm64(n - 3584);
        return n + 192;
    } else if constexpr (MODE == 2) return (n >> 7) * 256 + (n & 127);
    else return (n >> 7) * 256 + 128 + (n & 127);
}
template <int MODE>
__device__ __forceinline__ void tr_item(const float* __restrict__ W, int N, int K, bf16_t* __restrict__ WT, int row_off, const float* __restrict__ kscale, LAS float* scr, int item, int lane) {
    const int nblk = N / 32, kb = item / nblk, nb = item % nblk, k0 = 64 * kb, n0 = 32 * nb;
    f32x4 v[8];
#pragma unroll
    for (int i = 0; i < 8; ++i) { const int kk = 8 * i + (lane >> 3); v[i] = *(const f32x4*)(W + (size_t)(k0 + kk) * N + n0 + (lane & 7) * 4); }
    if (kscale) {
#pragma unroll
        for (int i = 0; i < 8; ++i) { const int kk = 8 * i + (lane >> 3); v[i] = v[i] * kscale[k0 + kk]; }
    }
#pragma unroll
    for (int i = 0; i < 8; ++i) { const int kk = 8 * i + (lane >> 3); LAS float* d = scr + kk * 33 + (lane & 7) * 4; d[0] = v[i].x; d[1] = v[i].y; d[2] = v[i].z; d[3] = v[i].w; }
    LDS_WAIT(); asm volatile("" ::: "memory");
    const int c = lane & 7;
#pragma unroll
    for (int j = 0; j < 4; ++j) { const int n = (lane >> 3) + 8 * j; const LAS float* s = scr + (8 * c) * 33 + n;
        u32x4 o; o.x = cvt_pk_bf16(s[0 * 33], s[1 * 33]); o.y = cvt_pk_bf16(s[2 * 33], s[3 * 33]); o.z = cvt_pk_bf16(s[4 * 33], s[5 * 33]); o.w = cvt_pk_bf16(s[6 * 33], s[7 * 33]);
        *(u32x4*)(WT + (size_t)(row_off + rowmap<MODE>(n0 + n)) * K + k0 + 8 * c) = o; }
    LDS_WAIT(); asm volatile("" ::: "memory");
}
template <int MODE>
__device__ __forceinline__ void absmax_item(const float* __restrict__ W, int N, unsigned* cmax, int item, int lane) {
    const int nblk = N / 32, kb = item / nblk, nb = item % nblk, k0 = 256 * kb, n0 = 32 * nb;
    f32x4 m = {0.f, 0.f, 0.f, 0.f};
#pragma unroll 16
    for (int i = 0; i < 32; ++i) { const int kk = 8 * i + (lane >> 3); const f32x4 v = *(const f32x4*)(W + (size_t)(k0 + kk) * N + n0 + (lane & 7) * 4);
        m.x = fmaxf(m.x, fabsf(v.x)); m.y = fmaxf(m.y, fabsf(v.y)); m.z = fmaxf(m.z, fabsf(v.z)); m.w = fmaxf(m.w, fabsf(v.w)); }
#pragma unroll
    for (int o = 8; o < 64; o <<= 1) { m.x = fmaxf(m.x, __shfl_xor(m.x, o)); m.y = fmaxf(m.y, __shfl_xor(m.y, o)); m.z = fmaxf(m.z, __shfl_xor(m.z, o)); m.w = fmaxf(m.w, __shfl_xor(m.w, o)); }
    if (lane < 8) {
#pragma unroll
        for (int i = 0; i < 4; ++i) __hip_atomic_fetch_max(cmax + rowmap<MODE>(n0 + lane * 4 + i), __float_as_uint(m[i]), RLX_AGENT); }
}
__device__ __forceinline__ float inv127() { float k = 1.0f / 127.0f; asm volatile("" : "+v"(k)); return k; }
__device__ __forceinline__ float clamp127(float v) { return fminf(fmaxf(v, -127.0f), 127.0f); }
__device__ __forceinline__ unsigned pack_u8x4(float a, float b, float c, float d) {
    const unsigned ia = (unsigned)rintf(a), ib = (unsigned)rintf(b), ic = (unsigned)rintf(c), id = (unsigned)rintf(d);
    return ia | (ib << 8) | (ic << 16) | (id << 24);
}
__device__ __forceinline__ unsigned pack_i8x4(float a, float b, float c, float d) {
    const int ia = (int)rintf(clamp127(a)), ib = (int)rintf(clamp127(b)), ic = (int)rintf(clamp127(c)), id = (int)rintf(clamp127(d));
    return (unsigned)(ia & 255) | ((unsigned)(ib & 255) << 8) | ((unsigned)(ic & 255) << 16) | ((unsigned)(id & 255) << 24);
}
template <int MODE>
__device__ __forceinline__ void tr_item_i8(const float* __restrict__ W, int N, int K, signed char* __restrict__ WT, int row_off, const unsigned* cmax, LAS float* scr, int item, int lane) {
    const int nblk = N / 32, kb = item / nblk, nb = item % nblk, k0 = 64 * kb, n0 = 32 * nb;
    f32x4 v[8];
#pragma unroll
    for (int i = 0; i < 8; ++i) { const int kk = 8 * i + (lane >> 3); v[i] = *(const f32x4*)(W + (size_t)(k0 + kk) * N + n0 + (lane & 7) * 4); }
#pragma unroll
    for (int i = 0; i < 8; ++i) { const int kk = 8 * i + (lane >> 3); LAS float* d = scr + kk * 33 + (lane & 7) * 4; d[0] = v[i].x; d[1] = v[i].y; d[2] = v[i].z; d[3] = v[i].w; }
    LDS_WAIT(); asm volatile("" ::: "memory");
    const int c = lane & 3;
#pragma unroll
    for (int j = 0; j < 2; ++j) { const int n = (lane >> 2) + 16 * j; const int row = row_off + rowmap<MODE>(n0 + n);
        const float cm = __uint_as_float(cmax[row]); const float inv = cm > 0.f ? 127.0f / cm : 0.f; const LAS float* sp = scr + (16 * c) * 33 + n;
        u32x4 o;
#pragma unroll
        for (int q = 0; q < 4; ++q) o[q] = pack_i8x4(sp[(4 * q) * 33] * inv, sp[(4 * q + 1) * 33] * inv, sp[(4 * q + 2) * 33] * inv, sp[(4 * q + 3) * 33] * inv);
        *(u32x4*)(WT + (size_t)row * K + k0 + 16 * c) = o; }
    LDS_WAIT(); asm volatile("" ::: "memory");
}
__device__ __forceinline__ void tr_load(const float* __restrict__ W, int N, int item, int lane, f32x4 (&v)[8]) {
    const int nblk = N / 32, kb = item / nblk, nb = item % nblk, k0 = 64 * kb, n0 = 32 * nb;
#pragma unroll
    for (int i = 0; i < 8; ++i) { const int kk = 8 * i + (lane >> 3); v[i] = *(const f32x4*)(W + (size_t)(k0 + kk) * N + n0 + (lane & 7) * 4); }
}
template <int MODE>
__device__ __forceinline__ void tr_store_bf16(const f32x4 (&v)[8], int N, int K, bf16_t* __restrict__ WT, int row_off, LAS float* scr, int item, int lane) {
    const int nblk = N / 32, kb = item / nblk, nb = item % nblk, k0 = 64 * kb, n0 = 32 * nb;
#pragma unroll
    for (int i = 0; i < 8; ++i) { const int kk = 8 * i + (lane >> 3); LAS float* d = scr + kk * 33 + (lane & 7) * 4; d[0] = v[i].x; d[1] = v[i].y; d[2] = v[i].z; d[3] = v[i].w; }
    LDS_WAIT(); asm volatile("" ::: "memory");
    const int c = lane & 7;
#pragma unroll
    for (int j = 0; j < 4; ++j) { const int n = (lane >> 3) + 8 * j; const LAS float* s = scr + (8 * c) * 33 + n;
        u32x4 o; o.x = cvt_pk_bf16(s[0 * 33], s[1 * 33]); o.y = cvt_pk_bf16(s[2 * 33], s[3 * 33]); o.z = cvt_pk_bf16(s[4 * 33], s[5 * 33]); o.w = cvt_pk_bf16(s[6 * 33], s[7 * 33]);
        *(u32x4*)(WT + (size_t)(row_off + rowmap<MODE>(n0 + n)) * K + k0 + 8 * c) = o; }
    LDS_WAIT(); asm volatile("" ::: "memory");
}
template <int MODE>
__device__ __forceinline__ void tr_store_i8(const f32x4 (&v)[8], int N, int K, signed char* __restrict__ WT, int row_off, const unsigned* cmax, LAS float* scr, int item, int lane) {
    const int nblk = N / 32, kb = item / nblk, nb = item % nblk, k0 = 64 * kb, n0 = 32 * nb;
#pragma unroll
    for (int i = 0; i < 8; ++i) { const int kk = 8 * i + (lane >> 3); LAS float* d = scr + kk * 33 + (lane & 7) * 4; d[0] = v[i].x; d[1] = v[i].y; d[2] = v[i].z; d[3] = v[i].w; }
    LDS_WAIT(); asm volatile("" ::: "memory");
    const int c = lane & 3;
#pragma unroll
    for (int j = 0; j < 2; ++j) { const int n = (lane >> 2) + 16 * j; const int row = row_off + rowmap<MODE>(n0 + n);
        const float cm = __uint_as_float(cmax[row]); const float inv = cm > 0.f ? 127.0f / cm : 0.f; const LAS float* sp = scr + (16 * c) * 33 + n;
        u32x4 o;
#pragma unroll
        for (int q = 0; q < 4; ++q) o[q] = pack_i8x4(sp[(4 * q) * 33] * inv, sp[(4 * q + 1) * 33] * inv, sp[(4 * q + 2) * 33] * inv, sp[(4 * q + 3) * 33] * inv);
        *(u32x4*)(WT + (size_t)row * K + k0 + 16 * c) = o; }
    LDS_WAIT(); asm volatile("" ::: "memory");
}
__device__ __forceinline__ void sincos_d(double a, float& s, float& c) {
    const double twopi = 6.283185307179586476925286766559;
    const double r = a - twopi * rint(a / twopi), r2 = r * r;
    double ts = 1.0, tc = 1.0;
#pragma unroll
    for (int k = 16; k >= 1; --k) { ts = 1.0 - ts * r2 / (double)((2 * k) * (2 * k + 1)); tc = 1.0 - tc * r2 / (double)((2 * k - 1) * (2 * k)); }
    s = (float)(r * ts); c = (float)tc;
}

__device__ __forceinline__ float clamp448(float v) {
    float t; asm("v_min_f32 %0, |%1|, %2" : "=v"(t) : "v"(v), "s"(448.0f)); float r; asm("v_bfi_b32 %0, %1, %2, %3" : "=v"(r) : "s"(0x7fffffff), "v"(t), "v"(v)); return r; }
__device__ __forceinline__ unsigned pack_f8x4(float a, float b, float c, float d) {
    a = clamp448(a); b = clamp448(b); c = clamp448(c); d = clamp448(d);
    unsigned w = 0; w = __builtin_amdgcn_cvt_pk_fp8_f32(a, b, w, false); w = __builtin_amdgcn_cvt_pk_fp8_f32(c, d, w, true); return w;
}
template <int KROWS>
__device__ __forceinline__ void w_block_f8(const float* __restrict__ W, const float* __restrict__ W2, int N, int n0, unsigned char* __restrict__ WT8, int dstride, int koff, float* invs, LAS unsigned char* lds, int wave, int lane) {
    constexpr int TSB = 4104, RPW = KROWS / 8;
    LAS float* wm = (LAS float*)(lds + 32 * TSB);
    const int c4 = (lane & 7) * 4;
    float m0 = 0.f, m1 = 0.f, m2 = 0.f, m3 = 0.f;
#pragma unroll 1
    for (int bt = 0; bt < RPW / 64; ++bt) {
        f32x4 v[8];
#pragma unroll
        for (int i = 0; i < 8; ++i) { const int kk = wave * RPW + bt * 64 + i * 8 + (lane >> 3); v[i] = *(const f32x4*)((kk < KROWS / 2 ? W : W2 - (size_t)(KROWS / 2) * N) + (size_t)kk * N + n0 + c4); }
#pragma unroll
        for (int i = 0; i < 8; ++i) { const int kk = wave * RPW + bt * 64 + i * 8 + (lane >> 3);
            m0 = fmaxf(m0, fabsf(v[i].x)); m1 = fmaxf(m1, fabsf(v[i].y)); m2 = fmaxf(m2, fabsf(v[i].z)); m3 = fmaxf(m3, fabsf(v[i].w));
            const unsigned p01 = cvt_pk_bf16(v[i].x, v[i].y), p23 = cvt_pk_bf16(v[i].z, v[i].w);
            *(LAS bf16_t*)(lds + (c4 + 0) * TSB + kk * 2) = (bf16_t)(p01 & 0xffffu); *(LAS bf16_t*)(lds + (c4 + 1) * TSB + kk * 2) = (bf16_t)(p01 >> 16);
            *(LAS bf16_t*)(lds + (c4 + 2) * TSB + kk * 2) = (bf16_t)(p23 & 0xffffu); *(LAS bf16_t*)(lds + (c4 + 3) * TSB + kk * 2) = (bf16_t)(p23 >> 16); }
    }
#pragma unroll
    for (int o = 8; o < 64; o <<= 1) { m0 = fmaxf(m0, __shfl_xor(m0, o)); m1 = fmaxf(m1, __shfl_xor(m1, o)); m2 = fmaxf(m2, __shfl_xor(m2, o)); m3 = fmaxf(m3, __shfl_xor(m3, o)); }
    if (lane < 8) { wm[wave * 32 + c4] = m0; wm[wave * 32 + c4 + 1] = m1; wm[wave * 32 + c4 + 2] = m2; wm[wave * 32 + c4 + 3] = m3; }
    __syncthreads();
#pragma unroll 1
    for (int r = 0; r < 4; ++r) { const int n = wave * 4 + r; float cm = wm[n];
#pragma unroll
        for (int w = 1; w < 8; ++w) cm = fmaxf(cm, wm[w * 32 + n]);
        const float sc = cm > 0.f ? exp2f(floorf(log2f(224.0f / cm))) : 1.0f;
        if (lane == 0) invs[n0 + n] = 1.0f / sc;
#pragma unroll
        for (int j = 0; j < KROWS / 256; ++j) { const int ch = j * 64 + lane; const u32x2 w = *(const LAS u32x2*)(lds + n * TSB + ch * 8);
            *(unsigned*)(WT8 + (size_t)(n0 + n) * dstride + koff + ch * 4) = pack_f8x4(bflo(w.x) * sc, bfhi(w.x) * sc, bflo(w.y) * sc, bfhi(w.y) * sc); } }
    __syncthreads();
}
struct Ptrs {
    const float *x, *c, *ctx, *c_ctx, *w_mod, *b_mod, *norm_mix, *norm_ffn, *w_in, *a_q_norm, *a_k_norm, *b_kv_norm, *w_ukv, *w_br_a, *w_br_b, *w_out,
                *w_group, *b_group, *w_router, *b_router, *w_e_gate, *w_e_up, *w_e_down, *norm_final;
    float* out; unsigned char* ws;
};

__device__ __forceinline__ void p0_prologue(const Ptrs& P, LAS unsigned char* lds, int G, int blk, int gw, int NGW, int wave, int lane) {
    LAS float* scr = (LAS float*)(lds + wave * 16384);
    unsigned char* ws = P.ws;
    bf16_t* WIN = (bf16_t*)(ws + WS_WIN); bf16_t* WUKV = (bf16_t*)(ws + WS_WUKV);
    constexpr int I_GEMV = 48 * 32, I_ROPE = 64, I_ZERO = 192;
    constexpr int I_IN = (DM / 256) * (DIN / 32), I_UKV = (512 / 64) * (2048 / 32), I_BR = (1024 / 64) * (2048 / 32), I_OUT = (2048 / 256) * (2048 / 32);
    constexpr int NITEMS = I_GEMV + I_ROPE + I_ZERO + I_IN + I_UKV;
    for (int it = blk; it < 128; it += G) {
        if (it < 64) w_block_f8<2048>(P.w_br_a, P.w_br_b, 2048, it * 32, ws + WS_WBRA, 2048, 0, (float*)(ws + WS_SAO), lds, wave, lane);
        else w_block_f8<2048>(P.w_out, P.w_out + (size_t)1024 * 2048, 2048, (it - 64) * 32, ws + WS_WOUT, 2048, 0, (float*)(ws + WS_SAO) + 2048, lds, wave, lane); }
    for (int it = gw; it < NITEMS; it += NGW) {
        int r = it;
        if (r < I_GEMV) {
            const int nc = r % 48, kc = r / 48, n = nc * 256 + lane * 4, k0 = kc * 64;
            float sv[5];
#pragma unroll
            for (int q = 0; q < 5; ++q) { const float cv = (q < 4) ? P.c[q * DM + k0 + lane] : P.c_ctx[k0 + lane]; sv[q] = cv * sigmoidf_(cv); }
            f32x4 a[5];
#pragma unroll
            for (int q = 0; q < 5; ++q) a[q] = (f32x4){0.f, 0.f, 0.f, 0.f};
#pragma unroll 16
            for (int kk = 0; kk < 64; ++kk) { const f32x4 w = *(const f32x4*)(P.w_mod + (size_t)(k0 + kk) * NMOD + n);
#pragma unroll
                for (int q = 0; q < 5; ++q) { const float s = __uint_as_float(__builtin_amdgcn_readlane(__float_as_uint(sv[q]), kk)); a[q] += w * s; } }
            float* MP = (float*)(ws + WS_MODP);
#pragma unroll
            for (int q = 0; q < 5; ++q) *(f32x4*)(MP + (size_t)(kc * 5 + q) * NMOD + n) = a[q];
            continue;
        } r -= I_GEMV;
        if (r < I_ROPE) {
            if (lane < 32) { const float fr = powf(10000.0f, -(float)lane / 32.0f); const float ang = (float)r * fr; float s, c; sincos_d((double)ang, s, c);
                ((f32x2*)(ws + WS_ROPEA))[r * 32 + lane] = (f32x2){c, s}; }
            if (lane < 16) { const float fr = powf(10000.0f, -(float)lane / 16.0f); const float ang = (float)r * fr; float s, c; sincos_d((double)ang, s, c);
                ((f32x2*)(ws + WS_ROPEB))[r * 16 + lane] = (f32x2){c, s}; }
            continue;
        } r -= I_ROPE;
        if (r < I_ZERO) {
            u32x4* p = (u32x4*)((signed char*)WIN + (size_t)(3648 + r) * DM);
#pragma unroll
            for (int j = 0; j < 2; ++j) p[j * 64 + lane] = (u32x4){0u, 0u, 0u, 0u};
            continue;
        } r -= I_ZERO;
        if (r < I_IN) { absmax_item<1>(P.w_in, DIN, (unsigned*)(ws + WS_CTL) + CW_CMAX_IN, r, lane); continue; } r -= I_IN;
        if (r < I_UKV) { tr_item<0>(P.w_ukv, 2048, 512, WUKV, 0, P.b_kv_norm, scr, r, lane); continue; } r -= I_UKV;

        absmax_item<0>(P.w_out, 2048, (unsigned*)(ws + WS_CTL) + CW_CMAX_OUT, r, lane);
    }
}
template <int MODE>
__device__ __forceinline__ void gu_block_i8(const float* __restrict__ W, int n0, signed char* __restrict__ WT8, int row_off, unsigned* cmax, LAS unsigned char* lds, int wave, int lane) {
    constexpr int TSB = 4104;
    LAS float* wm = (LAS float*)(lds + 32 * TSB);
    const int c4 = (lane & 7) * 4;
    float m0 = 0.f, m1 = 0.f, m2 = 0.f, m3 = 0.f;
#pragma unroll 1
    for (int bt = 0; bt < 4; ++bt) {
        f32x4 v[8];
#pragma unroll
        for (int i = 0; i < 8; ++i) { const int kk = wave * 256 + bt * 64 + i * 8 + (lane >> 3); v[i] = *(const f32x4*)(W + (size_t)kk * 1024 + n0 + c4); }
#pragma unroll
        for (int i = 0; i < 8; ++i) { const int kk = wave * 256 + bt * 64 + i * 8 + (lane >> 3);
            m0 = fmaxf(m0, fabsf(v[i].x)); m1 = fmaxf(m1, fabsf(v[i].y)); m2 = fmaxf(m2, fabsf(v[i].z)); m3 = fmaxf(m3, fabsf(v[i].w));
            const unsigned p01 = cvt_pk_bf16(v[i].x, v[i].y), p23 = cvt_pk_bf16(v[i].z, v[i].w);
            *(LAS bf16_t*)(lds + (c4 + 0) * TSB + kk * 2) = (bf16_t)(p01 & 0xffffu); *(LAS bf16_t*)(lds + (c4 + 1) * TSB + kk * 2) = (bf16_t)(p01 >> 16);
            *(LAS bf16_t*)(lds + (c4 + 2) * TSB + kk * 2) = (bf16_t)(p23 & 0xffffu); *(LAS bf16_t*)(lds + (c4 + 3) * TSB + kk * 2) = (bf16_t)(p23 >> 16); }
    }
#pragma unroll
    for (int o = 8; o < 64; o <<= 1) { m0 = fmaxf(m0, __shfl_xor(m0, o)); m1 = fmaxf(m1, __shfl_xor(m1, o)); m2 = fmaxf(m2, __shfl_xor(m2, o)); m3 = fmaxf(m3, __shfl_xor(m3, o)); }
    if (lane < 8) { wm[wave * 32 + c4] = m0; wm[wave * 32 + c4 + 1] = m1; wm[wave * 32 + c4 + 2] = m2; wm[wave * 32 + c4 + 3] = m3; }
    __syncthreads();
#pragma unroll 1
    for (int r = 0; r < 4; ++r) { const int n = wave * 4 + r; float cm = wm[n];
#pragma unroll
        for (int w = 1; w < 8; ++w) cm = fmaxf(cm, wm[w * 32 + n]);
        const int row = row_off + rowmap<MODE>(n0 + n); if (lane == 0) cmax[row] = __float_as_uint(cm);
        const float inv = cm > 0.f ? 127.0f / cm : 0.f;
#pragma unroll
        for (int j = 0; j < 8; ++j) { const int ch = j * 64 + lane; const u32x2 w = *(const LAS u32x2*)(lds + n * TSB + ch * 8);
            *(unsigned*)(WT8 + (size_t)row * 2048 + ch * 4) = pack_i8x4(bflo(w.x) * inv, bfhi(w.x) * inv, bflo(w.y) * inv, bfhi(w.y) * inv); } }
    __syncthreads();
}
__device__ __forceinline__ void p6_expert_copies(const Ptrs& P, LAS unsigned char* lds, int G, int blk, int wave, int lane) {
    for (int it = blk; it < NEXP * 64; it += G) { const int e = it >> 6, nb = it & 63; const float* W = P.w_e_down + (size_t)e * 1024 * 2048;
        w_block_f8<1024>(W, W + (size_t)512 * 2048, 2048, nb * 32, P.ws + WS_WD + (size_t)e * 2048 * 1024, 1024, 0, (float*)(P.ws + WS_INVD) + e * 2048, lds, wave, lane); }
}
__device__ __forceinline__ void p3_expert_gateup(const Ptrs& P, LAS unsigned char* lds, int G, int blk, int wave, int lane) {
    signed char* WG8 = (signed char*)(P.ws + WS_WG); unsigned* cm = (unsigned*)(P.ws + WS_CTL) + CW_CMAX_WG;
    for (int it = blk; it < NEXP * 2 * 32; it += G) { const int e = it >> 6, up = (it >> 5) & 1, nb = it & 31;
        if (!up) gu_block_i8<2>(P.w_e_gate + (size_t)e * 2048 * 1024, nb * 32, WG8, e * 2048, cm, lds, wave, lane);
        else     gu_block_i8<3>(P.w_e_up + (size_t)e * 2048 * 1024, nb * 32, WG8, e * 2048, cm, lds, wave, lane); }
}
__device__ __forceinline__ void p1_win_i8(const Ptrs& P, LAS unsigned char* lds, int gw, int NGW, int wave, int lane) {
    LAS float* scr = (LAS float*)(lds + wave * 16384);
    constexpr int J_IN = (DM / 64) * (DIN / 32), TOT = J_IN;
    const unsigned* ctl = (const unsigned*)(P.ws + WS_CTL);
#define P1_DECODE(it_, kind_, W_, N_, r_) do { int r0_ = (it_); \
        if (r0_ < J_IN) { kind_ = 0; W_ = P.w_in; N_ = DIN; r_ = r0_; } \
        else { kind_ = 0; W_ = P.w_in; N_ = DIN; r_ = 0; } } while (0)
    f32x4 vn[8]; int kind, N, r; const float* W;
    if (gw < TOT) { P1_DECODE(gw, kind, W, N, r); tr_load(W, N, r, lane, vn); }
#pragma unroll 1
    for (int it = gw; it < TOT; it += NGW) {
        f32x4 vc[8];
#pragma unroll
        for (int i = 0; i < 8; ++i) vc[i] = vn[i];
        const int ckind = kind, cr = r;
        if (it + NGW < TOT) { P1_DECODE(it + NGW, kind, W, N, r); tr_load(W, N, r, lane, vn); }
        if (ckind == 0) tr_store_i8<1>(vc, DIN, DM, (signed char*)(P.ws + WS_WIN), 0, ctl + CW_CMAX_IN, scr, cr, lane);
    }
#undef P1_DECODE
}
template <int C>
__device__ __forceinline__ void requant_rows(const bf16_t* __restrict__ src, signed char* __restrict__ dst, float* __restrict__ sc, int R, int gw, int NGW, int lane) {
    constexpr int NV = C / 512;
    for (int row = gw; row < R; row += NGW) {
        u32x4 w[NV]; float am = 0.f;
#pragma unroll
        for (int j = 0; j < NV; ++j) { w[j] = *(const u32x4*)(src + (size_t)row * C + (j * 64 + lane) * 8);
#pragma unroll
            for (int i = 0; i < 4; ++i) am = fmaxf(am, fmaxf(fabsf(bflo(w[j][i])), fabsf(bfhi(w[j][i])))); }
#pragma unroll
        for (int o = 1; o < 64; o <<= 1) am = fmaxf(am, __shfl_xor(am, o));
        const float inv = am > 0.f ? 127.0f / am : 0.f;
        if (lane == 0) sc[row] = am * (1.0f / 127.0f);
#pragma unroll
        for (int j = 0; j < NV; ++j) { u32x2 o;
            o.x = pack_i8x4(bflo(w[j].x) * inv, bfhi(w[j].x) * inv, bflo(w[j].y) * inv, bfhi(w[j].y) * inv);
            o.y = pack_i8x4(bflo(w[j].z) * inv, bfhi(w[j].z) * inv, bflo(w[j].w) * inv, bfhi(w[j].w) * inv);
            *(u32x2*)(dst + (size_t)row * C + (j * 64 + lane) * 8) = o; }
    }
}
__device__ __forceinline__ void p1_modreduce(const Ptrs& P, int gtid, int NGT) {
    const float* MP = (const float*)(P.ws + WS_MODP); float* MOD = (float*)(P.ws + WS_MOD);
    for (int idx = gtid; idx < 5 * NMOD; idx += NGT) { const int q = idx / NMOD, n = idx % NMOD; float s = P.b_mod[n];
#pragma unroll 8
        for (int kc = 0; kc < 32; ++kc) s += MP[(size_t)(kc * 5 + q) * NMOD + n];
        MOD[idx] = s; }
}
__device__ __forceinline__ void p2_hx(const Ptrs& P, int gw, int NGW, int lane) {
    const float* MOD = (const float*)(P.ws + WS_MOD); signed char* HX8 = (signed char*)(P.ws + WS_R1);
    for (int t = gw; t < 80; t += NGW) {
        const int b = t / 20, j = t % 20; const float* sh2 = MOD + (size_t)b * NMOD + 3 * DM; float a = 0.f;
        for (int i = 0; i < 32; ++i) { const int k = i * 64 + lane; const float w = (j < 4) ? P.w_group[(size_t)k * 4 + j] : P.w_router[((size_t)((j - 4) >> 2) * DM + k) * 4 + ((j - 4) & 3)]; a += sh2[k] * w; }
        a = wave_sum(a);
        if (lane == 0) ((float*)(P.ws + WS_BIASR))[t] = a + ((j < 4) ? P.b_group[j] : P.b_router[j - 4]);
    }
#define P2_SRC(kr_) (((kr_) % KEYS) < CTXL ? P.ctx + ((size_t)((kr_) / KEYS) * CTXL + ((kr_) % KEYS)) * DM : P.x + ((size_t)((kr_) / KEYS) * SEQ + (((kr_) % KEYS) - CTXL)) * DM)
    f32x4 vn[8];
    if (gw < NKEY) { const float* s0 = P2_SRC(gw);
#pragma unroll
        for (int j = 0; j < 8; ++j) vn[j] = *(const f32x4*)(s0 + j * 256 + lane * 4); }
#pragma unroll 1
    for (int kr = gw; kr < NKEY; kr += NGW) {
        const int b = kr / KEYS, t = kr % KEYS; const bool isctx = t < CTXL;
        const float* md = MOD + (size_t)(isctx ? 4 : b) * NMOD;
        f32x4 v[8]; float ss = 0.f;
#pragma unroll
        for (int j = 0; j < 8; ++j) v[j] = vn[j];
        if (kr + NGW < NKEY) { const float* s1 = P2_SRC(kr + NGW);
#pragma unroll
            for (int j = 0; j < 8; ++j) vn[j] = *(const f32x4*)(s1 + j * 256 + lane * 4); }
#pragma unroll
        for (int j = 0; j < 8; ++j) ss += (v[j].x * v[j].x + v[j].y * v[j].y) + (v[j].z * v[j].z + v[j].w * v[j].w);
        const float rstd = rsqrtf(wave_sum(ss) * (1.0f / DM) + EPS);
        float am = 0.f;
#pragma unroll
        for (int j = 0; j < 8; ++j) { const int col = j * 256 + lane * 4;
            const f32x4 g = *(const f32x4*)(P.norm_mix + col), sh = *(const f32x4*)(md + col), sc = *(const f32x4*)(md + DM + col);
            v[j] = (v[j] * rstd) * g * (sc + 1.0f) + sh;
            am = fmaxf(fmaxf(am, fmaxf(fabsf(v[j].x), fabsf(v[j].y))), fmaxf(fabsf(v[j].z), fabsf(v[j].w))); }
#pragma unroll
        for (int o = 1; o < 64; o <<= 1) am = fmaxf(am, __shfl_xor(am, o));
        const float inv = am > 0.f ? 127.0f / am : 0.f;
        if (lane == 0) ((float*)(P.ws + WS_SAHX))[kr] = am * (1.0f / 127.0f);
#pragma unroll
        for (int j = 0; j < 8; ++j) *(unsigned*)(HX8 + (size_t)kr * DM + j * 256 + lane * 4) = pack_i8x4(v[j].x * inv, v[j].y * inv, v[j].z * inv, v[j].w * inv);
    }
}
__device__ __forceinline__ unsigned rope_pair(float x1, float x2, f32x2 cs) { return cvt_pk_bf16(x1 * cs.x - x2 * cs.y, x1 * cs.y + x2 * cs.x); }
__device__ __forceinline__ void p4_post(const Ptrs& P, int row_lo, int row_hi, int wave, int lane) {
    unsigned char* r2 = P.ws + WS_R2;
    bf16_t* QA = (bf16_t*)(r2 + R2_QA); bf16_t* KA = (bf16_t*)(r2 + R2_KA); bf16_t* QB = (bf16_t*)(r2 + R2_QB); bf16_t* CKV = (bf16_t*)(r2 + R2_CKV); bf16_t* KR = (bf16_t*)(r2 + R2_KR);
    const f32x2* TA = (const f32x2*)(P.ws + WS_ROPEA); const f32x2* TB = (const f32x2*)(P.ws + WS_ROPEB); float* RSTD = (float*)(P.ws + WS_RSTD);
    for (int kr = row_lo + wave; kr < row_hi; kr += NWAVES) {
        const int b = kr / KEYS, t = kr % KEYS; const bool lat = t >= CTXL; const int s = t - CTXL, prow = s >> 6, pcol = s & 63; const size_t lr = (size_t)b * SEQ + s;
        {
            u32x2 w = *(u32x2*)(KA + (size_t)kr * 256 + lane * 4);
            float e0 = bflo(w.x), e1 = bfhi(w.x), e2 = bflo(w.y), e3 = bfhi(w.y);
            float ss = (e0 * e0 + e1 * e1) + (e2 * e2 + e3 * e3);
#pragma unroll
            for (int o = 1; o < 32; o <<= 1) ss += __shfl_xor(ss, o);
            const float rstd = rsqrtf(ss * (1.0f / 128.0f) + EPS);
            const int p0 = ((lane * 4) & 127) >> 1;
            e0 *= rstd * P.a_k_norm[p0]; e1 *= rstd * P.a_k_norm[64 + p0]; e2 *= rstd * P.a_k_norm[p0 + 1]; e3 *= rstd * P.a_k_norm[65 + p0];
            if (lat) { const f32x2 c0 = (p0 < 32) ? TA[prow * 32 + p0] : TA[pcol * 32 + p0 - 32], c1 = (p0 + 1 < 32) ? TA[prow * 32 + p0 + 1] : TA[pcol * 32 + p0 + 1 - 32];
                w.x = rope_pair(e0, e1, c0); w.y = rope_pair(e2, e3, c1); }
            else { w.x = cvt_pk_bf16(e0, e1); w.y = cvt_pk_bf16(e2, e3); }
            *(u32x2*)(KA + (size_t)kr * 256 + lane * 4) = w;
        }
        if (lat) {
            if (lane < 32) {
                const unsigned w = *(const unsigned*)(KR + (size_t)kr * 64 + lane * 2);
                const f32x2 cs = (lane < 16) ? TB[prow * 16 + lane] : TB[pcol * 16 + lane - 16];
                *(unsigned*)(KR + (size_t)kr * 64 + lane * 2) = rope_pair(bflo(w), bfhi(w), cs);
            }
            {
                bf16_t* q = QA + lr * 1024 + lane * 16;
                u32x4 w0 = *(u32x4*)q, w1 = *(u32x4*)(q + 8);
                float x1[8], x2[8]; float ss = 0.f;
#pragma unroll
                for (int i = 0; i < 4; ++i) { x1[i] = bflo(w0[i]); x2[i] = bfhi(w0[i]); x1[4 + i] = bflo(w1[i]); x2[4 + i] = bfhi(w1[i]); }
#pragma unroll
                for (int i = 0; i < 8; ++i) ss += x1[i] * x1[i] + x2[i] * x2[i];
                ss += __shfl_xor(ss, 1); ss += __shfl_xor(ss, 2); ss += __shfl_xor(ss, 4);
                const float rstd = rsqrtf(ss * (1.0f / 128.0f) + EPS) * (0.08838834764831845f * 1.4426950408889634f);
                const int p0 = ((lane * 16) & 127) >> 1;
                const f32x2* tb = (p0 < 32) ? TA + prow * 32 + p0 : TA + pcol * 32 + p0 - 32;
                unsigned o[8];
#pragma unroll
                for (int i = 0; i < 8; ++i) o[i] = rope_pair(x1[i] * rstd * P.a_q_norm[p0 + i], x2[i] * rstd * P.a_q_norm[64 + p0 + i], tb[i]);
                *(u32x4*)q = (u32x4){o[0], o[1], o[2], o[3]}; *(u32x4*)(q + 8) = (u32x4){o[4], o[5], o[6], o[7]};
            }
            {
                bf16_t* q = QB + lr * 1536 + (lane >> 3) * 192 + 128 + (lane & 7) * 8;
                const u32x4 w = *(u32x4*)q; const int p0 = (lane & 7) * 4;
                const f32x2* tb = (p0 < 16) ? TB + prow * 16 + p0 : TB + pcol * 16 + p0 - 16;
                u32x4 o;
#pragma unroll
                for (int i = 0; i < 4; ++i) o[i] = rope_pair(bflo(w[i]), bfhi(w[i]), tb[i]);
                *(u32x4*)q = o;
            }
        }
    }
}
__device__ __forceinline__ void p9_route(const Ptrs& P, LAS unsigned char* lds, int G, int blk, int tid, int wave, int lane, bool do_append) {
    const float* XN = (const float*)(P.ws + WS_R3); signed char* H28 = (signed char*)(P.ws + WS_R4); const float* MOD = (const float*)(P.ws + WS_MOD); const float* BIASR = (const float*)(P.ws + WS_BIASR);
    unsigned* LIST = (unsigned*)(P.ws + WS_LIST); float* WL = (float*)(P.ws + WS_WLIST); unsigned* ctl = (unsigned*)(P.ws + WS_CTL);
    LAS f32x4* W4 = (LAS f32x4*)lds;
    LAS unsigned char* ex = lds + RING_BYTES;
    LAS int* ent_e = (LAS int*)ex; LAS float* ent_w = (LAS float*)(ex + 512); LAS int* ent_p = (LAS int*)(ex + 1024); LAS int* lcnt = (LAS int*)(ex + 1536); LAS int* lbase = (LAS int*)(ex + 1600);
    LAS float* rinfo = (LAS float*)(ex + 2048) + wave * 32;
    for (int chunk = blk; chunk < NTOK / 64; chunk += G) {
        const int b = chunk / (SEQ / 64); const float* md = MOD + (size_t)b * NMOD; const float* br = BIASR + b * 20;
        unsigned lo = (unsigned)opaque_v(lane * 16);
        f32x4 gs[8];
#pragma unroll
        for (int j = 0; j < 8; ++j) gs[j] = *(const f32x4*)((const char*)P.norm_ffn + j * 1024 + lo) * (*(const f32x4*)((const char*)(md + 4 * DM) + j * 1024 + lo) + 1.0f);
        if (tid < 16) lcnt[tid] = 0;
        for (int k = tid; k < DM; k += NWAVES * 64) W4[(((k >> 8) * 4 + (k & 3)) << 6) + ((k >> 2) & 63)] = *(const f32x4*)(P.w_group + (size_t)k * 4);
        __syncthreads();
        f32x4 vn[8];
        { const char* s0 = (const char*)(XN + (size_t)(chunk * 64 + wave * 8) * DM);
#pragma unroll
          for (int j = 0; j < 8; ++j) vn[j] = *(const f32x4*)(s0 + j * 1024 + lo); }
#pragma unroll 1
        for (int rr = 0; rr < 8; ++rr) {
            const int tok = chunk * 64 + wave * 8 + rr; const char* src = (const char*)(XN + (size_t)(tok + (rr < 7 ? 1 : 0)) * DM); lo = (unsigned)opaque_v((int)lo);
            f32x4 acc = {0.f, 0.f, 0.f, 0.f}; float ss = 0.f; f32x4 vc[8];
#pragma unroll
            for (int j = 0; j < 8; ++j) vc[j] = vn[j];
#pragma unroll
            for (int j = 0; j < 8; ++j) vn[j] = *(const f32x4*)(src + j * 1024 + lo);
#pragma unroll
            for (int j = 0; j < 8; ++j) { const f32x4 v = vc[j]; ss += (v.x * v.x + v.y * v.y) + (v.z * v.z + v.w * v.w); const f32x4 u = v * gs[j];
#pragma unroll
                for (int i = 0; i < 4; ++i) acc += W4[((j * 4 + i) << 6) + lane] * u[i]; }
            ss = wave_sum(ss);
#pragma unroll
            for (int q = 0; q < 4; ++q) acc[q] = wave_sum(acc[q]);
            const float rstd = rsqrtf(ss * (1.0f / DM) + EPS);
            const f32x4 glv = acc * rstd + *(const f32x4*)br;
            int gi = 0; float gm = glv[0];
            if (glv[1] > gm) { gm = glv[1]; gi = 1; }
            if (glv[2] > gm) { gm = glv[2]; gi = 2; }
            if (glv[3] > gm) { gm = glv[3]; gi = 3; }
            const float gsum = (expf(glv[0] - gm) + expf(glv[1] - gm)) + (expf(glv[2] - gm) + expf(glv[3] - gm));
            if (lane == 0) { rinfo[rr * 4 + 0] = rstd; rinfo[rr * 4 + 1] = 1.0f / gsum; rinfo[rr * 4 + 2] = __int_as_float(gi); }
        }
        __syncthreads();
        for (int idx = tid; idx < 4 * DM; idx += NWAVES * 64) { const int k = idx & (DM - 1); W4[(idx & ~(DM - 1)) + (((k >> 8) * 4 + (k & 3)) << 6) + ((k >> 2) & 63)] = *(const f32x4*)(P.w_router + (size_t)idx * 4); }
        LAS f32x4* SHL = (LAS f32x4*)(lds + RING_BYTES + 4096);
        LAS f32x4* GSL = SHL + 512;
        SHL[tid] = *(const f32x4*)(md + 3 * DM + tid * 4);
        GSL[tid] = *(const f32x4*)(P.norm_ffn + tid * 4) * (*(const f32x4*)(md + 4 * DM + tid * 4) + 1.0f);
        __syncthreads();
        { const char* s0 = (const char*)(XN + (size_t)(chunk * 64 + wave * 8) * DM);
#pragma unroll
          for (int j = 0; j < 8; ++j) vn[j] = *(const f32x4*)(s0 + j * 1024 + lo); }
#pragma unroll 1
        for (int rr = 0; rr < 8; ++rr) {
            const int lrow = wave * 8 + rr, tok = chunk * 64 + lrow; const char* src = (const char*)(XN + (size_t)(tok + (rr < 7 ? 1 : 0)) * DM); lo = (unsigned)opaque_v((int)lo);
            const float rstd = rinfo[rr * 4 + 0], gval = rinfo[rr * 4 + 1]; const int gi = __builtin_amdgcn_readfirstlane(__float_as_int(rinfo[rr * 4 + 2]));
            const LAS f32x4* Wg = W4 + gi * DM;
            f32x4 acc = {0.f, 0.f, 0.f, 0.f}; u32x2 hv[8]; float am = 0.f;
            const LAS f32x4* shl = (const LAS f32x4*)(unsigned long)(unsigned)opaque_v(RING_BYTES + 4096 + lane * 16);
#pragma unroll
            for (int j = 0; j < 8; ++j) { const f32x4 v = vn[j]; const f32x4 u = v * shl[512 + j * 64];
                const f32x4 h = u * rstd + shl[j * 64]; hv[j].x = cvt_pk_bf16(h.x, h.y); hv[j].y = cvt_pk_bf16(h.z, h.w);
                am = fmaxf(fmaxf(am, fmaxf(fabsf(h.x), fabsf(h.y))), fmaxf(fabsf(h.z), fabsf(h.w)));
#pragma unroll
                for (int i = 0; i < 4; ++i) acc += Wg[((j * 4 + i) << 6) + lane] * u[i];
                __builtin_amdgcn_sched_barrier(0); }
#pragma unroll
            for (int j = 0; j < 8; ++j) vn[j] = *(const f32x4*)(src + j * 1024 + lo);
            __builtin_amdgcn_sched_barrier(0);
#pragma unroll
            for (int o = 1; o < 64; o <<= 1) am = fmaxf(am, __shfl_xor(am, o));
            { const float inv = am > 0.f ? 127.0f / am : 0.f;
              if (lane == 0) ((float*)(P.ws + WS_SAH2))[tok] = am * (1.0f / 127.0f);
#pragma unroll
              for (int j = 0; j < 8; ++j) *(unsigned*)((char*)(H28 + (size_t)tok * DM) + j * 256 + (lo >> 2)) = pack_i8x4(bflo(hv[j].x) * inv, bfhi(hv[j].x) * inv, bflo(hv[j].y) * inv, bfhi(hv[j].y) * inv); }
#pragma unroll
            for (int q = 0; q < 4; ++q) acc[q] = wave_sum(acc[q]);
            const f32x4 elv = acc * rstd + *(const f32x4*)(br + 4 + gi * 4);
            int e1 = 0; float m1 = elv[0];
            if (elv[1] > m1) { m1 = elv[1]; e1 = 1; }
            if (elv[2] > m1) { m1 = elv[2]; e1 = 2; }
            if (elv[3] > m1) { m1 = elv[3]; e1 = 3; }
            int e2 = (e1 + 1) & 3; float m2 = -3.0e38f;
            if (e1 != 0 && elv[0] > m2) { m2 = elv[0]; e2 = 0; }
            if (e1 != 1 && elv[1] > m2) { m2 = elv[1]; e2 = 1; }
            if (e1 != 2 && elv[2] > m2) { m2 = elv[2]; e2 = 2; }
            if (e1 != 3 && elv[3] > m2) { m2 = elv[3]; e2 = 3; }
            const float x2 = expf(m2 - m1), w1 = gval / (1.0f + x2), w2 = gval * x2 / (1.0f + x2);
            if (lane == 0) { ent_e[lrow * 2] = gi * 4 + e1; ent_w[lrow * 2] = w1; ent_e[lrow * 2 + 1] = gi * 4 + e2; ent_w[lrow * 2 + 1] = w2; }
        }
        __syncthreads();
        if (tid < 128) ent_p[tid] = __hip_atomic_fetch_add(lcnt + ent_e[tid], 1, __ATOMIC_RELAXED, __HIP_MEMORY_SCOPE_WORKGROUP);
        __syncthreads();
        if (tid < 16 && do_append) lbase[tid] = (int)__hip_atomic_fetch_add(ctl + CW_ECNT + 64 * tid, (unsigned)lcnt[tid], RLX_AGENT);
        __syncthreads();
        if (tid < 128 && do_append) { const int e = ent_e[tid], pos = lbase[e] + ent_p[tid]; const int tok = chunk * 64 + (tid >> 1);
            LIST[(size_t)e * NTOK + pos] = (unsigned)(tok * 2 + (tid & 1)); WL[(size_t)e * NTOK + pos] = ent_w[tid]; }
        __syncthreads();
    }
}
__device__ __forceinline__ void p12_final(const Ptrs& P, int gw, int NGW, int lane) {
    const float* XN = (const float*)(P.ws + WS_R3); const bf16_t* SL = (const bf16_t*)(P.ws + WS_R2); const float* MOD = (const float*)(P.ws + WS_MOD);
    for (int tok = gw; tok < NTOK; tok += NGW) {
        const int b = tok / SEQ; const float* md = MOD + (size_t)b * NMOD + 5 * DM;
        f32x4 v[8]; float ss = 0.f;
#pragma unroll
        for (int j = 0; j < 8; ++j) { const int col = j * 256 + lane * 4;
            const f32x4 xv = *(const f32x4*)(XN + (size_t)tok * DM + col), g2 = *(const f32x4*)(md + col);
            const u32x2 s0 = *(const u32x2*)(SL + (size_t)(2 * tok) * DM + col), s1 = *(const u32x2*)(SL + (size_t)(2 * tok + 1) * DM + col);
            f32x4 y; y.x = bflo(s0.x) + bflo(s1.x); y.y = bfhi(s0.x) + bfhi(s1.x); y.z = bflo(s0.y) + bflo(s1.y); y.w = bfhi(s0.y) + bfhi(s1.y);
            v[j] = xv + g2 * y; ss += (v[j].x * v[j].x + v[j].y * v[j].y) + (v[j].z * v[j].z + v[j].w * v[j].w); }
        const float rstd = rsqrtf(wave_sum(ss) * (1.0f / DM) + EPS);
#pragma unroll
        for (int j = 0; j < 8; ++j) { const int col = j * 256 + lane * 4; const f32x4 g = *(const f32x4*)(P.norm_final + col);
            *(f32x4*)(P.out + (size_t)tok * DM + col) = (v[j] * rstd) * g; }
    }
}

using pg8::Unit;
struct InOrder {
    int G, c;
    __device__ __forceinline__ bool next(int i, Unit& u) const {
        long L = (long)i * G + c;
        if (L < 64 * 31) { int pm, pn; pg8::tile_map((int)L, 64, 31, pm, pn); u.pm = (pm >> 4) * 17 + 1 + (pm & 15); u.pn = pn; u.x = pm * 256; u.y = 0; return true; }
        L -= 64 * 31; if (L >= 20) return false;
        const int b = (int)L / 5, t = (int)L % 5; u.pm = b * 17; u.pn = (t < 2) ? 4 + t : 10 + t; u.x = -1; u.y = 0; return true;
    }
    __device__ __forceinline__ int src_row(const Unit&, int) const { return 0; }
    __device__ __forceinline__ void done(const Unit&) const {}
};
struct EpiIn {
    static constexpr bool PERM = true, MIDHOOK = false;
    bf16_t *QA, *KA, *VA, *QB, *CKV, *KR, *GL; const float* sa; const unsigned* cmax; float* ssc;
    __device__ __forceinline__ void operator()(const i32x4 (&acc)[2][2][4][2], const Unit& u, int wr, int wc, int fr, int fq) const {
        const int pn = u.pn; bf16_t* base; int ldc, colt; long row0; bool sig = false; int ncv = 256;
        const long krow0 = (long)u.pm * 256, lrow0 = u.x;
        if (pn < 4) { base = QA; ldc = 1024; colt = pn * 256; row0 = lrow0; }
        else if (pn == 4) { base = KA; ldc = 256; colt = 0; row0 = krow0; }
        else if (pn == 5) { base = VA; ldc = 256; colt = 0; row0 = krow0; }
        else if (pn < 12) { base = QB; ldc = 1536; colt = (pn - 6) * 256; row0 = lrow0; }
        else if (pn < 14) { base = CKV; ldc = 512; colt = (pn - 12) * 256; row0 = krow0; }
        else if (pn == 14) { base = KR; ldc = 64; colt = 0; row0 = krow0; ncv = 64; }
        else { base = GL; ldc = 4096; colt = (pn - 15) * 256; row0 = lrow0; sig = true; }
        const int c0 = wc * 32 + 8 * fq; const float k127 = inv127() * ((pn >= 6 && pn < 12) ? (0.07216878364870322f * 1.4426950408889634f) : 1.0f);
        float sr[2][4], ssq[2][4];
#pragma unroll
        for (int ai = 0; ai < 2; ++ai)
#pragma unroll
            for (int m = 0; m < 4; ++m) { sr[ai][m] = sa[krow0 + ai * 128 + wr * 64 + m * 16 + fr]; ssq[ai][m] = 0.f; }
#pragma unroll
        for (int bj = 0; bj < 2; ++bj) {
            const u32x4 cm0 = *(const u32x4*)(cmax + pn * 256 + bj * 128 + c0), cm1 = *(const u32x4*)(cmax + pn * 256 + bj * 128 + c0 + 4);
            const f32x4 sb0 = (f32x4){__uint_as_float(cm0.x), __uint_as_float(cm0.y), __uint_as_float(cm0.z), __uint_as_float(cm0.w)} * k127;
            const f32x4 sb1 = (f32x4){__uint_as_float(cm1.x), __uint_as_float(cm1.y), __uint_as_float(cm1.z), __uint_as_float(cm1.w)} * k127;
            if (bj * 128 + c0 < ncv) {
#pragma unroll
                for (int ai = 0; ai < 2; ++ai)
#pragma unroll
                    for (int m = 0; m < 4; ++m) { const int rt = ai * 128 + wr * 64 + m * 16 + fr; bf16_t* rowp = base + (size_t)(row0 + rt) * ldc + colt + c0 + bj * 128;
                        f32x4 v0, v1;
#pragma unroll
                        for (int i = 0; i < 4; ++i) { v0[i] = (float)acc[ai][bj][m][0][i] * (sr[ai][m] * sb0[i]); v1[i] = (float)acc[ai][bj][m][1][i] * (sr[ai][m] * sb1[i]); }
                        if (sig) {
                            u32x2 w; w.x = pack_i8x4(v0[0] * 16.0f, v0[1] * 16.0f, v0[2] * 16.0f, v0[3] * 16.0f); w.y = pack_i8x4(v1[0] * 16.0f, v1[1] * 16.0f, v1[2] * 16.0f, v1[3] * 16.0f);
                            *(u32x2*)((unsigned char*)GL + (size_t)(row0 + rt) * 4096 + colt + c0 + bj * 128) = w;
                        } else {
                        u32x4 w; w.x = cvt_pk_bf16(v0[0], v0[1]); w.y = cvt_pk_bf16(v0[2], v0[3]); w.z = cvt_pk_bf16(v1[0], v1[1]); w.w = cvt_pk_bf16(v1[2], v1[3]);
                        *(u32x4*)rowp = w;
                        if (pn == 12 || pn == 13) ssq[ai][m] += (v0[0] * v0[0] + v0[1] * v0[1]) + (v0[2] * v0[2] + v0[3] * v0[3]) + (v1[0] * v1[0] + v1[1] * v1[1]) + (v1[2] * v1[2] + v1[3] * v1[3]); } } }
        }
        if (pn == 12 || pn == 13) {
#pragma unroll
            for (int ai = 0; ai < 2; ++ai)
#pragma unroll
                for (int m = 0; m < 4; ++m) { float q = ssq[ai][m]; q += __shfl_xor(q, 16); q += __shfl_xor(q, 32);
                    if (fq == 0) ssc[(size_t)(krow0 + ai * 128 + wr * 64 + m * 16 + fr) * 8 + (pn - 12) * 4 + wc] = q; } }
    }
};
struct EpiKvUp {
    static constexpr bool PERM = true, MIDHOOK = false;
    bf16_t* O; const float* ssc;
    __device__ __forceinline__ void operator()(const f32x4 (&acc)[2][2][4][2], const Unit& u, int wr, int wc, int fr, int fq) const {
        const int c0 = u.pn * 256 + wc * 32 + 8 * fq;
        float sc8[2][4];
#pragma unroll
        for (int ai = 0; ai < 2; ++ai)
#pragma unroll
            for (int m = 0; m < 4; ++m) { const size_t row = (size_t)u.pm * 256 + ai * 128 + wr * 64 + m * 16 + fr; const f32x4 p0 = *(const f32x4*)(ssc + row * 8), p1 = *(const f32x4*)(ssc + row * 8 + 4);
                sc8[ai][m] = rsqrtf(((p0.x + p0.y) + (p0.z + p0.w) + (p1.x + p1.y) + (p1.z + p1.w)) * (1.0f / 512.0f) + EPS); }
        __builtin_amdgcn_sched_barrier(0);
#pragma unroll
        for (int ai = 0; ai < 2; ++ai)
#pragma unroll
            for (int m = 0; m < 4; ++m) { const size_t row = (size_t)u.pm * 256 + ai * 128 + wr * 64 + m * 16 + fr; const float s = sc8[ai][m]; bf16_t* rowp = O + row * 2048 + c0;
#pragma unroll
                for (int bj = 0; bj < 2; ++bj) { const f32x4 v0 = acc[ai][bj][m][0] * s, v1 = acc[ai][bj][m][1] * s;
                    u32x4 w; w.x = cvt_pk_bf16(v0[0], v0[1]); w.y = cvt_pk_bf16(v0[2], v0[3]); w.z = cvt_pk_bf16(v1[0], v1[1]); w.w = cvt_pk_bf16(v1[2], v1[3]);
                    *(u32x4*)(rowp + bj * 128) = w; } }
    }
};
template <bool SECOND> struct EpiMerge {
    static constexpr bool PERM = true, MIDHOOK = false;
    const bf16_t* GL; const bf16_t* Tin; bf16_t* O; const float* sa; const unsigned* cmax;
    __device__ __forceinline__ void operator()(const i32x4 (&acc)[2][2][4][2], const Unit& u, int wr, int wc, int fr, int fq) const {
        const int c0 = u.pn * 256 + wc * 32 + 8 * fq;
        const float k127 = inv127(); f32x4 sb[2][2];
#pragma unroll
        for (int bj = 0; bj < 2; ++bj)
#pragma unroll
            for (int n = 0; n < 2; ++n) { const u32x4 cm = *(const u32x4*)(cmax + c0 + bj * 128 + 4 * n);
                sb[bj][n] = (f32x4){__uint_as_float(cm.x), __uint_as_float(cm.y), __uint_as_float(cm.z), __uint_as_float(cm.w)} * k127; }
#pragma unroll
        for (int ai = 0; ai < 2; ++ai)
#pragma unroll
            for (int m = 0; m < 4; ++m) { const size_t row = (size_t)u.pm * 256 + ai * 128 + wr * 64 + m * 16 + fr; const float sr = sa[row];
#pragma unroll
                for (int bj = 0; bj < 2; ++bj) { const int col = c0 + bj * 128;
                    const u32x2 gw = *(const u32x2*)((const unsigned char*)GL + row * 4096 + (SECOND ? 2048 : 0) + col);
                    f32x4 v0, v1;
#pragma unroll
                    for (int i = 0; i < 4; ++i) { v0[i] = (float)acc[ai][bj][m][0][i] * (sr * sb[bj][0][i]); v1[i] = (float)acc[ai][bj][m][1][i] * (sr * sb[bj][1][i]); }
#pragma unroll
                    for (int i = 0; i < 4; ++i) { v0[i] *= sigmoidf_((float)((int)(gw.x << (24 - 8 * i)) >> 24) * (1.0f / 16.0f)); v1[i] *= sigmoidf_((float)((int)(gw.y << (24 - 8 * i)) >> 24) * (1.0f / 16.0f)); }
                    if constexpr (SECOND) { const u32x4 tw = *(const u32x4*)(Tin + row * 2048 + col);
                        v0[0] += bflo(tw.x); v0[1] += bfhi(tw.x); v0[2] += bflo(tw.y); v0[3] += bfhi(tw.y); v1[0] += bflo(tw.z); v1[1] += bfhi(tw.z); v1[2] += bflo(tw.w); v1[3] += bfhi(tw.w); }
                    u32x4 w; w.x = cvt_pk_bf16(v0[0], v0[1]); w.y = cvt_pk_bf16(v0[2], v0[3]); w.z = cvt_pk_bf16(v1[0], v1[1]); w.w = cvt_pk_bf16(v1[2], v1[3]);
                    *(u32x4*)(O + row * 2048 + col) = w; } }
    }
};
struct EpiMergeF {
    static constexpr bool PERM = true, MIDHOOK = true;
    const signed char* GL; bf16_t* M; const float* invs;
    __device__ __forceinline__ void mid(f32x4 (&acc)[2][2][4][2], const Unit& u, int wr, int wc, int fr, int fq) const {
        const int c0 = u.pn * 256 + wc * 32 + 8 * fq;
        const signed char* gp = GL + ((size_t)u.pm * 256 + wr * 64 + fr) * 4096 + c0;
        u32x2 ga_n = *(const u32x2*)gp, gb_n = *(const u32x2*)(gp + 2048);
#pragma unroll
        for (int ai = 0; ai < 2; ++ai)
#pragma unroll
            for (int m = 0; m < 4; ++m) {
#pragma unroll
                for (int bj = 0; bj < 2; ++bj) {
                    const u32x2 ga = ga_n, gb = gb_n;
                    { const int g1 = ai * 8 + m * 2 + bj + 1; if (g1 < 16) { const signed char* q = gp + (size_t)((g1 >> 3) * 128 + ((g1 >> 1) & 3) * 16) * 4096 + (g1 & 1) * 128;
                        ga_n = *(const u32x2*)q; gb_n = *(const u32x2*)(q + 2048); } }
#pragma unroll
                    for (int i = 0; i < 4; ++i) {
                        const float a0 = (float)((int)(ga.x << (24 - 8 * i)) >> 24), b0 = (float)((int)(gb.x << (24 - 8 * i)) >> 24);
                        const float a1 = (float)((int)(ga.y << (24 - 8 * i)) >> 24), b1 = (float)((int)(gb.y << (24 - 8 * i)) >> 24);
                        constexpr float C = -1.4426950408889634f / 16.0f;
                        acc[ai][bj][m][0][i] *= (1.0f + __builtin_amdgcn_exp2f(C * b0)) * __builtin_amdgcn_rcpf(1.0f + __builtin_amdgcn_exp2f(C * a0));
                        acc[ai][bj][m][1][i] *= (1.0f + __builtin_amdgcn_exp2f(C * b1)) * __builtin_amdgcn_rcpf(1.0f + __builtin_amdgcn_exp2f(C * a1)); }
                    __builtin_amdgcn_sched_barrier(0); } }
    }
    __device__ __forceinline__ void operator()(const f32x4 (&acc)[2][2][4][2], const Unit& u, int wr, int wc, int fr, int fq) const {
        const int c0 = u.pn * 256 + wc * 32 + 8 * fq;
        const signed char* gp = GL + ((size_t)u.pm * 256 + wr * 64 + fr) * 4096 + 2048 + c0;
        u32x2 gb_n = *(const u32x2*)gp;
#pragma unroll
        for (int ai = 0; ai < 2; ++ai)
#pragma unroll
            for (int m = 0; m < 4; ++m) { const size_t row = (size_t)u.pm * 256 + ai * 128 + wr * 64 + m * 16 + fr;
#pragma unroll
                for (int bj = 0; bj < 2; ++bj) { const int col = c0 + bj * 128;
                    const u32x2 gb = gb_n;
                    { const int g1 = ai * 8 + m * 2 + bj + 1; if (g1 < 16) gb_n = *(const u32x2*)(gp + (size_t)((g1 >> 3) * 128 + ((g1 >> 1) & 3) * 16) * 4096 + (g1 & 1) * 128); }
                    const f32x4 rb0 = *(const f32x4*)(invs + col), rb1 = *(const f32x4*)(invs + col + 4);
                    f32x4 v0, v1;
#pragma unroll
                    for (int i = 0; i < 4; ++i) { v0[i] = acc[ai][bj][m][0][i] * rb0[i] * sigmoidf_((float)((int)(gb.x << (24 - 8 * i)) >> 24) * (1.0f / 16.0f));
                                                  v1[i] = acc[ai][bj][m][1][i] * rb1[i] * sigmoidf_((float)((int)(gb.y << (24 - 8 * i)) >> 24) * (1.0f / 16.0f)); }
                    u32x2 w; w.x = pack_f8x4(v0[0], v0[1], v0[2], v0[3]); w.y = pack_f8x4(v1[0], v1[1], v1[2], v1[3]);
                    *(u32x2*)((unsigned char*)M + row * 2048 + col) = w; } }
    }
};
struct EpiOut {
    static constexpr bool PERM = false, MIDHOOK = false;
    const float* x; const float* mod; float* O; const float* invs;
    __device__ __forceinline__ void operator()(const f32x4 (&acc)[2][2][4][2], const Unit& u, int wr, int wc, int fr, int fq) const {
        const int c0 = u.pn * 256 + wc * 32 + 4 * fq; const int b = (u.pm * 256) / SEQ; const float* g1 = mod + (size_t)b * NMOD + 2 * DM;
        f32x4 gsb[2][2];
#pragma unroll
        for (int bj = 0; bj < 2; ++bj)
#pragma unroll
            for (int n = 0; n < 2; ++n) { const int col = c0 + bj * 128 + n * 16; gsb[bj][n] = *(const f32x4*)(invs + col) * (1.0f / 64.0f) * *(const f32x4*)(g1 + col); }
        const float* xp = x + ((size_t)u.pm * 256 + wr * 64 + fr) * DM + c0; float* op = O + ((size_t)u.pm * 256 + wr * 64 + fr) * DM + c0;
        f32x4 xa[8], xb[8];
#define EO_OFF(b, k) ((size_t)(((b) >> 1) * 128 + (((b) & 1) * 2 + ((k) >> 2)) * 16) * DM + (((k) >> 1) & 1) * 128 + ((k) & 1) * 16)
#define EO_LD(b, xx) do { _Pragma("unroll") for (int k = 0; k < 8; ++k) xx[k] = *(const f32x4*)(xp + EO_OFF(b, k)); __builtin_amdgcn_sched_barrier(0); } while (0)
#define EO_ST(b, xx) do { _Pragma("unroll") for (int k = 0; k < 8; ++k) *(f32x4*)(op + EO_OFF(b, k)) = xx[k] + gsb[(k >> 1) & 1][k & 1] * acc[(b) >> 1][(k >> 1) & 1][((b) & 1) * 2 + (k >> 2)][k & 1]; __builtin_amdgcn_sched_barrier(0); } while (0)
        EO_LD(0, xa); EO_LD(1, xb); EO_ST(0, xa); EO_LD(2, xa); EO_ST(1, xb); EO_LD(3, xb); EO_ST(2, xa); EO_ST(3, xb);
#undef EO_OFF
#undef EO_LD
#undef EO_ST
    }
};
struct MoeOrder {
    const LAS int* tab; const unsigned* list; int G, c;
    __device__ __forceinline__ bool next(int i, Unit& u) const {
        int rt, j;
        if ((G & 15) == 0) { const int x = c & 7, q = c >> 3; j = 2 * (x & 3) + (q & 1); rt = i * (G >> 3) + (x >> 2) * (G >> 4) + (q >> 1); }
        else { const long L = (long)i * G + c; rt = (int)(L >> 3); j = (int)(L & 7); }
        if (rt >= tab[16]) return false;
        int e = 0;
#pragma unroll
        for (int k = 1; k < 16; ++k) e += (rt >= tab[k]) ? 1 : 0;
        const int m = rt - tab[e]; int rows = tab[32 + e] - m * 256; rows = rows > 256 ? 256 : rows;
        u.pm = rt; u.pn = e * 8 + j; u.x = e * NTOK + m * 256; u.y = rows; return true;
    }
    __device__ __forceinline__ int src_row(const Unit& u, int r) const { return (r < u.y) ? (int)(list[u.x + r] >> 1) : 0; }
    unsigned* qcnt;
    __device__ __forceinline__ void done(const Unit& u) const {
        if (my_lane() == 0) __hip_atomic_fetch_add(qcnt + 64 * u.pm, 1u, RLX_AGENT);
    }
};
struct MoeQueue {
    const LAS int* tab; volatile LAS int* slot; unsigned* qhead; unsigned* qcnt; const unsigned* list; int G, c;
    __device__ __forceinline__ bool next(int i, Unit& u) const {
        const int tid_ = my_tid();
        if (__builtin_amdgcn_readfirstlane(tid_ >> 6) == 0) {
            int L = 0;
            if ((tid_ & 63) == 0) {
                L = (i == 0) ? c : G + (int)__hip_atomic_fetch_add(qhead, 1u, RLX_AGENT);
                if (L < tab[16] * 8) { unsigned* c = qcnt + 64 * (L >> 3); unsigned sp = 0;
                    while (__hip_atomic_load(c, RLX_AGENT) < 64u) { __builtin_amdgcn_s_sleep(2); if (++sp > (1u << 22)) break; } }
            }
            L = __builtin_amdgcn_readfirstlane(L);
            __builtin_amdgcn_fence(__ATOMIC_ACQUIRE, "agent");
            asm volatile("s_waitcnt vmcnt(0)" ::: "memory");
            if ((tid_ & 63) == 0) slot[i & 1] = L;
        }
        asm volatile("s_waitcnt lgkmcnt(0)" ::: "memory"); __builtin_amdgcn_s_barrier(); asm volatile("" ::: "memory");
        const int L = slot[i & 1];
        if (L >= tab[16] * 8) return false;
        const int rt = L >> 3, j = L & 7; int e = 0;
#pragma unroll
        for (int k = 1; k < 16; ++k) e += (rt >= tab[k]) ? 1 : 0;
        const int m = rt - tab[e]; int rows = tab[32 + e] - m * 256; rows = rows > 256 ? 256 : rows;
        u.pm = rt; u.pn = e * 8 + j; u.x = e * NTOK + m * 256; u.y = rows; return true;
    }
    __device__ __forceinline__ int src_row(const Unit&, int) const { return 0; }
    __device__ __forceinline__ void done(const Unit&) const {}
};
struct EpiGateUp {
    static constexpr bool PERM = true, MIDHOOK = false;
    bf16_t* O; const unsigned* list; const float* sa; const unsigned* cmax;
    __device__ __forceinline__ void operator()(const i32x4 (&acc)[2][2][4][2], const Unit& u, int wr, int wc, int fr, int fq) const {
        const int c0 = (u.pn & 7) * 128 + wc * 32 + 8 * fq, ct = wc * 32 + 8 * fq;
        const __amdgpu_buffer_rsrc_t rsrc = __builtin_amdgcn_make_buffer_rsrc((void*)O, 0, 0x7ffffff0, 0x00020000);
        const float k127 = inv127(); f32x4 sb[2][2];
#pragma unroll
        for (int bj = 0; bj < 2; ++bj)
#pragma unroll
            for (int n = 0; n < 2; ++n) { const u32x4 cm = *(const u32x4*)(cmax + u.pn * 256 + bj * 128 + ct + 4 * n);
                sb[bj][n] = (f32x4){__uint_as_float(cm.x), __uint_as_float(cm.y), __uint_as_float(cm.z), __uint_as_float(cm.w)} * k127; }
        float sr8[2][4];
        { unsigned tk[2][4];
#pragma unroll
          for (int ai = 0; ai < 2; ++ai)
#pragma unroll
            for (int m = 0; m < 4; ++m) { const int rt = ai * 128 + wr * 64 + m * 16 + fr; tk[ai][m] = list[u.x + ((rt < u.y) ? rt : 0)]; }
#pragma unroll
          for (int ai = 0; ai < 2; ++ai)
#pragma unroll
            for (int m = 0; m < 4; ++m) sr8[ai][m] = sa[tk[ai][m] >> 1]; }
        __builtin_amdgcn_sched_barrier(0);
#pragma unroll
        for (int ai = 0; ai < 2; ++ai)
#pragma unroll
            for (int m = 0; m < 4; ++m) { const int rt = ai * 128 + wr * 64 + m * 16 + fr; const size_t row = (size_t)u.pm * 256 + rt;
                const float sr = sr8[ai][m];
                f32x4 h0, h1;
#pragma unroll
                for (int i = 0; i < 4; ++i) { const float g0 = (float)acc[ai][0][m][0][i] * (sr * sb[0][0][i]), g1 = (float)acc[ai][0][m][1][i] * (sr * sb[0][1][i]);
                    h0[i] = g0 * sigmoidf_(g0) * ((float)acc[ai][1][m][0][i] * (sr * sb[1][0][i])); h1[i] = g1 * sigmoidf_(g1) * ((float)acc[ai][1][m][1][i] * (sr * sb[1][1][i])); }
                u32x2 w; w.x = pack_f8x4(h0[0] * 8.0f, h0[1] * 8.0f, h0[2] * 8.0f, h0[3] * 8.0f); w.y = pack_f8x4(h1[0] * 8.0f, h1[1] * 8.0f, h1[2] * 8.0f, h1[3] * 8.0f);
                __builtin_amdgcn_raw_buffer_store_b64(w, rsrc, (int)(row * DEXP + c0), 0, 16); }
    }
};
struct EpiDown {
    static constexpr bool PERM = true, MIDHOOK = false;
    bf16_t* O; const unsigned* list; const float* wl; const float* invs;
    __device__ __forceinline__ void operator()(const f32x4 (&acc)[2][2][4][2], const Unit& u, int wr, int wc, int fr, int fq) const {
        const int c0 = (u.pn & 7) * 256 + wc * 32 + 8 * fq; const int ce = u.pn * 256 + wc * 32 + 8 * fq;
        f32x4 sb[2][2];
#pragma unroll
        for (int bj = 0; bj < 2; ++bj)
#pragma unroll
            for (int n = 0; n < 2; ++n) sb[bj][n] = *(const f32x4*)(invs + ce + bj * 128 + 4 * n) * (1.0f / 8.0f);
        unsigned dst8[2][4]; float w8[2][4];
#pragma unroll
        for (int ai = 0; ai < 2; ++ai)
#pragma unroll
            for (int m = 0; m < 4; ++m) { const int r = ai * 128 + wr * 64 + m * 16 + fr; const int e = u.x + ((r < u.y) ? r : 0); dst8[ai][m] = list[e]; w8[ai][m] = wl[e]; }
        __builtin_amdgcn_sched_barrier(0);
#pragma unroll
        for (int ai = 0; ai < 2; ++ai)
#pragma unroll
            for (int m = 0; m < 4; ++m) { const int r = ai * 128 + wr * 64 + m * 16 + fr;
                if (r < u.y) { const size_t dst = dst8[ai][m]; const float s = w8[ai][m]; bf16_t* rowp = O + dst * DM + c0;
#pragma unroll
                    for (int bj = 0; bj < 2; ++bj) { const f32x4 v0 = acc[ai][bj][m][0] * sb[bj][0] * s, v1 = acc[ai][bj][m][1] * sb[bj][1] * s;
                        u32x4 w; w.x = cvt_pk_bf16(v0[0], v0[1]); w.y = cvt_pk_bf16(v0[2], v0[3]); w.z = cvt_pk_bf16(v1[0], v1[1]); w.w = cvt_pk_bf16(v1[2], v1[3]);
                        *(u32x4*)(rowp + bj * 128) = w; } } }
    }
};

enum { PH_P0, PH_P1, PH_HX, PH_IN, PH_POST, PH_KVUP, PH_ATT, PH_RQ1, PH_MERGE, PH_RQ2, PH_OUT, PH_ROUTE, PH_GU, PH_DOWN, PH_FINAL, NPH };
#ifndef MK_ONE_LAUNCH
#define MK_ONE_LAUNCH 1
#endif
struct Args { Ptrs p; int ph_lo, ph_hi, use_bar, pad; };
__global__ void __launch_bounds__(NWAVES * 64, 2) fwd_kernel(Args args) {
    extern __shared__ __attribute__((aligned(16))) unsigned char lds_raw[];
    LAS unsigned char* lds = (LAS unsigned char*)lds_raw;
    const int G = gridDim.x, blk = blockIdx.x, NGW = G * NWAVES;
#if defined(__HIP_DEVICE_COMPILE__)
#define PDECL() const __attribute__((address_space(4))) Ptrs* pp_ = (const __attribute__((address_space(4))) Ptrs*)__builtin_amdgcn_kernarg_segment_ptr(); asm volatile("" : "+s"(pp_)); \
    const Ptrs P = *pp_; unsigned char* const ws = P.ws; unsigned* const ctl = (unsigned*)(ws + WS_CTL); (void)ctl
#else
#define PDECL() const Ptrs P = args.p; unsigned char* const ws = P.ws; unsigned* const ctl = (unsigned*)(ws + WS_CTL); (void)ctl
#endif
#define TIDS() const int tid = opaque_v(my_tid()), lane = tid & 63, wave = __builtin_amdgcn_readfirstlane(tid >> 6), gw = blk * NWAVES + wave; (void)lane; (void)gw
    for (int u = threadIdx.x; u < (LDS_BYTES - CTL_OFF) / 4; u += NWAVES * 64) ((LAS unsigned*)(lds + CTL_OFF))[u] = 0u;
    __syncthreads();
    static_assert(WTAB_OFF_ == CTL_OFF + 1792 && WTAB_OFF_ + 256 <= LDS_BYTES, "wave table inside the LDS control region");
    if ((threadIdx.x & 63) == 0) ((LAS int*)(lds + WTAB_OFF_))[(unsigned)__builtin_amdgcn_s_getreg((5 << 11) | 4) & 63u] = (int)(threadIdx.x >> 6);
    __syncthreads();
    volatile LAS unsigned* MISC = (volatile LAS unsigned*)(lds + MISC_OFF);
    XcdBarrier bar; { PDECL(); bar.bar = ctl + CW_BAR; bar.x = 0; bar.st = nullptr;
    if (args.use_bar) bar = xcd_barrier_post(ctl + CW_BAR, MISC + 8); }
    const int lo = args.ph_lo, hi = args.ph_hi;
#ifndef PHASE_MASK
#define PHASE_MASK 0xFFFFF
#endif
#define IN(k) (((PHASE_MASK >> (k)) & 1) && lo <= (k) && (k) < hi)
#ifndef PROBE_DUP
#define PROBE_DUP -1
#endif
#define REP(k) for (int rep_ = 0; rep_ < ((PROBE_DUP == (k)) ? 2 : 1); ++rep_)
#define SEAM(k) do { if (IN(k) && IN((k) + 1)) xcd_barrier(bar); } while (0)

    if (IN(PH_P0)) REP(PH_P0) { PDECL(); TIDS(); p0_prologue(P, lds, G, blk, gw, NGW, wave, lane); } SEAM(PH_P0);
    if (IN(PH_P1)) { PDECL(); TIDS(); p1_modreduce(P, blk * NWAVES * 64 + tid, G * NWAVES * 64); p1_win_i8(P, lds, gw, NGW, wave, lane); } SEAM(PH_P1);
    if (IN(PH_HX)) REP(PH_HX) { PDECL(); TIDS(); p2_hx(P, gw, NGW, lane); } SEAM(PH_HX);
    if (IN(PH_IN)) REP(PH_IN) { PDECL();
        pg8::Gemm g{(const bf16_t*)(ws + WS_R1), (const bf16_t*)(ws + WS_WIN), DM}; InOrder S{G, blk};
        unsigned char* r2 = ws + WS_R2;
        EpiIn E{(bf16_t*)(r2 + R2_QA), (bf16_t*)(r2 + R2_KA), (bf16_t*)(r2 + R2_VA), (bf16_t*)(r2 + R2_QB), (bf16_t*)(r2 + R2_CKV), (bf16_t*)(r2 + R2_KR), (bf16_t*)(ws + WS_R3), (const float*)(ws + WS_SAHX), (const unsigned*)(ws + WS_CTL) + CW_CMAX_IN, (float*)(ws + WS_SSC)};
        if ((blk & 1) == 0) { TIDS(); p3_expert_gateup(P, lds, G, blk, wave, lane); }
        pg8::gemm_phase<EpiIn, InOrder, false, true>(lds, g, S, E);
        if ((blk & 1) == 1) { TIDS(); p3_expert_gateup(P, lds, G, blk, wave, lane); }
    } SEAM(PH_IN);
    if (IN(PH_KVUP)) REP(PH_KVUP) { PDECL();
        pg8::Gemm g{(const bf16_t*)(ws + WS_R2 + R2_CKV), (const bf16_t*)(ws + WS_WUKV), 512}; pg8::TileOrder S{NKEY / 256, 8, G, blk};
        EpiKvUp E{(bf16_t*)(ws + WS_R1), (const float*)(ws + WS_SSC)};
        pg8::gemm_phase<EpiKvUp, pg8::TileOrder, false>(lds, g, S, E);
        {
            TIDS(); const int nu3 = (NKEY / 256) * 8 - 2 * G;
            const bool w3 = (G == 256) && blk < nu3; const int shares = (G == 256) ? nu3 + 2 * (G - nu3) : G;
            const int s0 = (G == 256) ? (w3 ? blk : nu3 + 2 * (blk - nu3)) : blk, s1 = s0 + ((G == 256 && !w3) ? 2 : 1);
            p4_post(P, (int)((long)NKEY * s0 / shares), (int)((long)NKEY * s1 / shares), wave, lane); }
    } SEAM(PH_KVUP);
    if (IN(PH_ATT)) { PDECL();
        const bf16_t* QA = (const bf16_t*)(ws + WS_R2 + R2_QA); const bf16_t* KA = (const bf16_t*)(ws + WS_R2 + R2_KA); const bf16_t* VA = (const bf16_t*)(ws + WS_R2 + R2_VA);
        const bf16_t* QB = (const bf16_t*)(ws + WS_R2 + R2_QB); const bf16_t* KR = (const bf16_t*)(ws + WS_R2 + R2_KR); const bf16_t* KVB = (const bf16_t*)(ws + WS_R1);
        unsigned char* OA = ws + WS_R4; unsigned char* OB = OA + (size_t)NTOK * 1024;
#ifndef ATT_SKIP_A
        const int cslot = blk % 5; int ucnt = 0;
#define P6_COPIES() do { TIDS(); for (int q_ = 0; q_ < ((PROBE_DUP == 200 + PH_ATT) ? 2 : 1); ++q_) p6_expert_copies(P, lds, G, blk, wave, lane); __syncthreads(); } while (0)
        for (int L_ = blk; L_ < ((PROBE_DUP == PH_ATT) ? 1024 : 512); L_ += G) { const int L = L_ & 511;
            if (ucnt++ == cslot) P6_COPIES();
            const int i2 = L >> 8, cc = L & 255, xcd = cc & 7, j = cc >> 3;
            const int b = 2 * i2 + (xcd >> 2), kvh = (xcd >> 1) & 1, h = kvh * 4 + (xcd & 1) * 2 + (j >> 4), qb = j & 15;
            const size_t qrow = (size_t)b * SEQ + qb * 256, krow = (size_t)b * KEYS;
            if (att::attn_body<0, -1, 2, 1024, 256, 256, 1024, true, true>(QA + qrow * 1024 + h * 128, KA + krow * 256 + kvh * 128, VA + krow * 256 + kvh * 128, nullptr, (bf16_t*)(OA + qrow * 1024 + h * 128), KEYS, (char*)lds_raw))
                att::attn_body<0, -1, 2, 1024, 256, 256, 1024, true, false>(QA + qrow * 1024 + h * 128, KA + krow * 256 + kvh * 128, VA + krow * 256 + kvh * 128, nullptr, (bf16_t*)(OA + qrow * 1024 + h * 128), KEYS, (char*)lds_raw);
        }
#endif
#ifndef ATT_SKIP_B
        for (int L_ = blk; L_ < ((PROBE_DUP == 100 + PH_ATT) ? 1024 : 512); L_ += G) { const int L = L_ & 511;
            if (ucnt++ == cslot) P6_COPIES();
            const int i2 = L >> 8, cc = L & 255, xcd = cc & 7, j = cc >> 3;
            const int b = 2 * i2 + (xcd >> 2), h = (xcd & 3) * 2 + (j >> 4), qb = j & 15;
            const size_t qrow = (size_t)b * SEQ + qb * 256, krow = (size_t)b * KEYS;
            if (att::attn_body<64, ATT_B_QPARK, ATT_B_SDEPTH, 1536, 2048, 2048, 1024, true, true>(QB + qrow * 1536 + h * 192, KVB + krow * 2048 + h * 256, KVB + krow * 2048 + h * 256 + 128, KR + krow * 64, (bf16_t*)(OB + qrow * 1024 + h * 128), KEYS, (char*)lds_raw))
                att::attn_body<64, ATT_B_QPARK, ATT_B_SDEPTH, 1536, 2048, 2048, 1024, true, false>(QB + qrow * 1536 + h * 192, KVB + krow * 2048 + h * 256, KVB + krow * 2048 + h * 256 + 128, KR + krow * 64, (bf16_t*)(OB + qrow * 1024 + h * 128), KEYS, (char*)lds_raw);
        }
#endif
        if (ucnt <= cslot) P6_COPIES();
#undef P6_COPIES
    } SEAM(PH_ATT);
    if (IN(PH_MERGE)) REP(PH_MERGE) { PDECL();
        pg8::Gemm g{(const bf16_t*)(ws + WS_R4), (const bf16_t*)(ws + WS_WBRA), DM, 1024, (long)NTOK * 1024 - 8 * 128}; pg8::TileOrder S{NTOK / 256, 8, G, blk};
        EpiMergeF E{(const signed char*)(ws + WS_R3), (bf16_t*)(ws + WS_R1), (const float*)(ws + WS_SAO)};
        pg8::gemm_phase<EpiMergeF, pg8::TileOrder, false, 2>(lds, g, S, E);
    } SEAM(PH_MERGE);
    if (IN(PH_OUT)) REP(PH_OUT) { PDECL();
        pg8::Gemm g{(const bf16_t*)(ws + WS_R1), (const bf16_t*)(ws + WS_WOUT), DM}; pg8::TileOrder S{NTOK / 256, 8, G, blk};
        EpiOut E{P.x, (const float*)(ws + WS_MOD), (float*)(ws + WS_R3), (const float*)(ws + WS_SAO) + 2048};
        pg8::gemm_phase<EpiOut, pg8::TileOrder, false, 2>(lds, g, S, E);
    } SEAM(PH_OUT);
    if (IN(PH_ROUTE)) REP(PH_ROUTE) { PDECL(); TIDS(); p9_route(P, lds, G, blk, tid, wave, lane, !(PROBE_DUP == PH_ROUTE && rep_ == 0)); } SEAM(PH_ROUTE);
    if (IN(PH_GU) || IN(PH_DOWN)) { PDECL();
        LAS int* tab = (LAS int*)(lds + MOETAB_OFF);
        if (my_tid() == 0) { int pre = 0;
            for (int e = 0; e < 16; ++e) { const int n = (int)__hip_atomic_load(ctl + CW_ECNT + 64 * e, RLX_AGENT); tab[e] = pre; tab[32 + e] = n; pre += (n + 255) >> 8; }
            tab[16] = pre; }
        __syncthreads();
    }
    if (IN(PH_GU)) REP(PH_GU) { PDECL();
        const LAS int* tab = (const LAS int*)(lds + MOETAB_OFF);
        pg8::Gemm g{(const bf16_t*)(ws + WS_R4), (const bf16_t*)(ws + WS_WG), DM}; MoeOrder S{tab, (const unsigned*)(ws + WS_LIST), G, blk, ctl + CW_QCNT};
        EpiGateUp E{(bf16_t*)(ws + WS_R1), (const unsigned*)(ws + WS_LIST), (const float*)(ws + WS_SAH2), (const unsigned*)(ws + WS_CTL) + CW_CMAX_WG};
        pg8::gemm_phase<EpiGateUp, MoeOrder, true, true>(lds, g, S, E);
    }
    if (IN(PH_DOWN)) REP(PH_DOWN) { PDECL();
        const LAS int* tab = (const LAS int*)(lds + MOETAB_OFF);
        pg8::Gemm g{(const bf16_t*)(ws + WS_R1), (const bf16_t*)(ws + WS_WD), DEXP}; MoeQueue S{tab, (volatile LAS int*)(lds + QSLOT_OFF), ctl + CW_QHEAD, ctl + CW_QCNT, (const unsigned*)(ws + WS_LIST), G, blk};
        EpiDown E{(bf16_t*)(ws + WS_R2), (const unsigned*)(ws + WS_LIST), (const float*)(ws + WS_WLIST), (const float*)(ws + WS_INVD)};
        pg8::gemm_phase<EpiDown, MoeQueue, false, 2>(lds, g, S, E);
    } SEAM(PH_DOWN);
    if (IN(PH_FINAL)) REP(PH_FINAL) { PDECL(); TIDS(); p12_final(P, gw, NGW, lane); }
#undef IN
#undef SEAM
}

extern "C" void kernel_launch(void* const* d_in, const int* in_sizes, int n_in, void* d_out, int out_size, void* d_ws, size_t ws_size, hipStream_t stream) {
    static int grid = 0;
    if (grid == 0) {
        if (n_in != 24 || in_sizes[0] != NTOK * DM || out_size != NTOK * DM || ws_size < WS_END) {
            fprintf(stderr, "kernel_launch: shape mismatch (n_in %d, in0 %d, out %d, ws %zu; need ws >= %zu); nothing launched\n", n_in, n_in > 0 ? in_sizes[0] : -1, out_size, ws_size, (size_t)WS_END); grid = -1; return; }
        int dev = 0, cus = 0, per_cu = 0;
        if (hipGetDevice(&dev) != hipSuccess || hipDeviceGetAttribute(&cus, hipDeviceAttributeMultiprocessorCount, dev) != hipSuccess) { fprintf(stderr, "kernel_launch: device query failed\n"); grid = -1; return; }
        if (hipFuncSetAttribute((const void*)fwd_kernel, hipFuncAttributeMaxDynamicSharedMemorySize, LDS_BYTES) != hipSuccess) { fprintf(stderr, "kernel_launch: hipFuncSetAttribute failed\n"); grid = -1; return; }
        if (hipOccupancyMaxActiveBlocksPerMultiprocessor(&per_cu, (const void*)fwd_kernel, NWAVES * 64, LDS_BYTES) != hipSuccess || per_cu < 1) {
            fprintf(stderr, "kernel_launch: occupancy query reports %d workgroups per CU\n", per_cu); }
        (void)hipGetLastError();
        grid = cus;
    }
    if (grid < 0) return;
    if (hipMemsetAsync((char*)d_ws + WS_CTL, 0, CTL_ZERO_BYTES, stream) != hipSuccess) { fprintf(stderr, "kernel_launch: memset failed\n"); return; }
    Args a{};
    const float** pp = (const float**)&a.p;
    for (int i = 0; i < 24; ++i) pp[i] = (const float*)d_in[i];
    a.p.out = (float*)d_out; a.p.ws = (unsigned char*)d_ws;
#if MK_ONE_LAUNCH
    a.ph_lo = 0; a.ph_hi = NPH; a.use_bar = 1; a.pad = 0;
    hipLaunchKernelGGL(fwd_kernel, dim3(grid), dim3(NWAVES * 64), LDS_BYTES, stream, a);
#else
    for (int k = 0; k < NPH; ++k) { a.ph_lo = k; a.ph_hi = k + 1; a.use_bar = 0; a.pad = 0;
        hipLaunchKernelGGL(fwd_kernel, dim3(grid), dim3(NWAVES * 64), LDS_BYTES, stream, a); }
#endif
    const hipError_t le = hipPeekAtLastError();
    if (le != hipSuccess) fprintf(stderr, "kernel_launch: launch failed: %s\n", hipGetErrorName(le));
}
```

```cpp
#include <hip/hip_runtime.h>
#include <cstdio>
#include <cstdint>
#include <type_traits>

#define LAS __attribute__((address_space(3)))
#define GAS __attribute__((address_space(1)))
typedef unsigned short bf16_t;
typedef short bf16x8 __attribute__((ext_vector_type(8)));
typedef short s16x4 __attribute__((ext_vector_type(4)));
typedef float f32x2 __attribute__((ext_vector_type(2)));
typedef float f32x4 __attribute__((ext_vector_type(4)));
typedef float f32x16 __attribute__((ext_vector_type(16)));
typedef unsigned u32x2 __attribute__((ext_vector_type(2)));
typedef unsigned u32x4 __attribute__((ext_vector_type(4)));
typedef int i32x4 __attribute__((ext_vector_type(4)));
typedef int i32x8 __attribute__((ext_vector_type(8)));
typedef GAS unsigned gu32;

constexpr int DM = 2048, NB = 4, SEQ = 4096, CTXL = 256, KEYS = SEQ + CTXL, NTOK = NB * SEQ, NKEY = NB * KEYS;
constexpr int NMOD = 6 * DM;
constexpr int DIN = 7744, NINP = 7936;
constexpr int C_QA = 0, C_KA = 1024, C_VA = 1280, C_QB = 1536, C_CKV = 3072, C_KR = 3584, C_GL = 3840;
constexpr int NEXP = 16, DEXP = 1024;
constexpr float EPS = 1e-6f;
constexpr int NWAVES = 8;

constexpr size_t MiB = 1u << 20;
constexpr size_t WS_CTL = 0, CTL_ZERO_BYTES = 1 * MiB;
constexpr size_t WS_MOD = 1 * MiB;
constexpr size_t WS_ROPEA = WS_MOD + 256 * 1024;
constexpr size_t WS_ROPEB = WS_ROPEA + 16 * 1024;
constexpr size_t WS_RSTD = WS_ROPEB + 16 * 1024;
constexpr size_t WS_SAHX = WS_RSTD + 96 * 1024;
constexpr size_t WS_BIASR = WS_RSTD + 192 * 1024;
constexpr size_t WS_SAH2 = WS_RSTD + 256 * 1024;
constexpr size_t WS_SAO = WS_RSTD + 384 * 1024;
constexpr size_t WS_SAM = WS_RSTD + 512 * 1024;
constexpr size_t WS_LIST = 2 * MiB;
constexpr size_t WS_WLIST = 3 * MiB;
constexpr size_t WS_MODP = 4 * MiB;
constexpr size_t WS_WIN = 12 * MiB;
constexpr size_t WS_WUKV = 43 * MiB;
constexpr size_t WS_WBRA = 45 * MiB;
constexpr size_t WS_WBRB = 49 * MiB;
constexpr size_t WS_WOUT = 53 * MiB;
constexpr size_t WS_R1 = 61 * MiB;
constexpr size_t WS_R2 = 133 * MiB;
constexpr size_t WS_R3 = 261 * MiB;
constexpr size_t WS_R4 = 389 * MiB;
constexpr size_t WS_WG = 453 * MiB;
constexpr size_t WS_WD = 581 * MiB;
constexpr size_t WS_END = 645 * MiB;
constexpr size_t WS_INVD = WS_MODP + 3 * MiB;
constexpr size_t WS_SSC = WS_MODP + 2 * MiB;
constexpr size_t R2_QA = 0, R2_KA = 32 * MiB, R2_VA = R2_KA + (size_t)NKEY * 256 * 2, R2_QB = 49 * MiB, R2_CKV = 97 * MiB, R2_KR = 114 * MiB;
static_assert(R2_VA + (size_t)NKEY * 256 * 2 <= R2_QB && R2_CKV + (size_t)NKEY * 512 * 2 <= R2_KR && R2_KR + (size_t)NKEY * 64 * 2 <= 128 * MiB, "R2 map");
constexpr int CW_BAR = 4096;
constexpr int CW_ECNT = 16384;
constexpr int CW_CMAX_IN = 32768;
constexpr int CW_CMAX_BR = 98304, CW_CMAX_OUT = 98304 + 4096;
constexpr int CW_QHEAD = 131072, CW_QCNT = 131072 + 64;
constexpr int CW_CMAX_WG = 65536;
constexpr int RING_BYTES = 131072;
constexpr int CTL_OFF = 159744;
constexpr int MISC_OFF = CTL_OFF + 320;
constexpr int MOETAB_OFF = CTL_OFF + 1024;
constexpr int QSLOT_OFF = CTL_OFF + 1536;
constexpr int LDS_BYTES = 161792;
static_assert(83968 + 8 * 9216 <= CTL_OFF && LDS_BYTES <= 163840, "attention scratch below the control region");

#define RLX_AGENT __ATOMIC_RELAXED, __HIP_MEMORY_SCOPE_AGENT
#define LDS_WAIT() asm volatile("s_waitcnt lgkmcnt(0)" ::: "memory")
#define VM_WAIT() asm volatile("s_waitcnt vmcnt(0)" ::: "memory")
__device__ __forceinline__ unsigned cvt_pk_bf16(float lo, float hi) { unsigned r; asm volatile("v_cvt_pk_bf16_f32 %0, %1, %2" : "=v"(r) : "v"(lo), "v"(hi)); return r; }
__device__ __forceinline__ float bflo(unsigned w) { return __uint_as_float(w << 16); }
__device__ __forceinline__ float bfhi(unsigned w) { return __uint_as_float(w & 0xffff0000u); }
__device__ __forceinline__ float sigmoidf_(float v) { return __builtin_amdgcn_rcpf(1.0f + __builtin_amdgcn_exp2f(-1.4426950408889634f * v)); }
__device__ __forceinline__ float wave_sum(float v) {
#pragma unroll
    for (int o = 1; o < 64; o <<= 1) v += __shfl_xor(v, o);
    return v;
}

constexpr int WTAB_OFF_ = 159744 + 1792;
__device__ __forceinline__ int my_lane() { return (int)__builtin_amdgcn_mbcnt_hi(~0u, __builtin_amdgcn_mbcnt_lo(~0u, 0u)); }
__device__ __forceinline__ int my_wave() { const unsigned key = (unsigned)__builtin_amdgcn_s_getreg((5 << 11) | 4) & 63u;
    return __builtin_amdgcn_readfirstlane(((const LAS int*)(unsigned long)WTAB_OFF_)[key]); }
__device__ __forceinline__ int my_tid() { return my_wave() * 64 + my_lane(); }
__device__ __forceinline__ int opaque_v(int v) { asm volatile("" : "+v"(v)); return v; }

namespace pg8 {
constexpr int BM = 256, BK = 64, HALF = 128, HTB = HALF * BK * 2, STAGE_BYTES = 8 * HTB, NXCD = 8, WGM = 8;
__host__ __device__ __forceinline__ int lds_byte(int r, int c) { const int st = (r >> 4) * 2 + (c >> 5), rr = r & 15, cc = c & 31, ob = rr * 64 + cc * 2; return st * 1024 + (ob ^ (((ob >> 9) & 1) << 5)); }
__host__ __device__ __forceinline__ void stage_rc(int b, int& R, int& C) { const int st = b / 1024, sb = b % 1024, swz = sb ^ (((sb >> 9) & 1) << 5); R = (st >> 1) * 16 + swz / 64; C = (st & 1) * 32 + (swz % 64) / 2; }
__host__ __device__ __forceinline__ int perm32(int rho) { const int n = rho >> 4, i = rho & 15; return 8 * (i >> 2) + 4 * n + (i & 3); }

struct Unit { int pm, pn, x, y; };
struct Gemm { const bf16_t* A; const bf16_t* Bt; int K; int lda = 0; long asplit = 0; };

__device__ __forceinline__ void tile_map(int L, int nM, int nN, int& pm, int& pn) {
    const int nwg = nM * nN; int wgid = L;
    { const int q = nwg / NXCD, r = nwg % NXCD, xcd = wgid % NXCD, off = wgid / NXCD; wgid = (xcd < r ? xcd * (q + 1) : r * (q + 1) + (xcd - r) * q) + off; }
    const int nig = WGM * nN, gid = wgid / nig, fm = gid * WGM, gsz = (nM - fm) < WGM ? (nM - fm) : WGM;
    pm = fm + ((wgid % nig) % gsz); pn = (wgid % nig) / gsz;
}
struct TileOrder {
    int nM, nN, G, c;
    __device__ __forceinline__ bool next(int i, Unit& u) const {
        const long L = (long)i * G + c; if (L >= (long)nM * nN) return false;
        tile_map((int)L, nM, nN, u.pm, u.pn); u.x = 0; u.y = 0; return true;
    }
    __device__ __forceinline__ int src_row(const Unit&, int) const { return 0; }
    __device__ __forceinline__ void done(const Unit&) const {}
};

template <class Epi, class Sched, bool GATHER, int PR = 0, bool ALIGN_EPI = true, bool SP2 = true>
__device__ __forceinline__ void gemm_phase(LAS unsigned char* lds, const Gemm g, const Sched& S, const Epi& E) {
    constexpr bool I8 = (PR == 1), BYTES = (PR != 0);
    typedef typename std::conditional<I8, i32x4, f32x4>::type acc_t;
    const int tid = opaque_v(my_tid()), wid = __builtin_amdgcn_readfirstlane(tid >> 6), lane = tid & 63, wr = wid >> 2, wc = wid & 3, fr = lane & 15, fq = lane >> 4;
    const int K = BYTES ? g.K / 2 : g.K, nt = K / BK;
    const int LA = g.lda ? (BYTES ? g.lda / 2 : g.lda) : K;
    unsigned voffA[2], voffB[2];
#pragma unroll
    for (int i = 0; i < 2; ++i) { int R, C; stage_rc(tid * 16 + i * 8192, R, C); const int Rb = Epi::PERM ? ((R & ~31) + perm32(R & 31)) : R;
        voffA[i] = (unsigned)(R * LA + C) * 2u; voffB[i] = (unsigned)(Rb * K + C) * 2u; }
    const size_t kstep = (size_t)(BK * 2);
    const size_t hstep = (size_t)HALF * K * 2;
    const size_t tstep = 2 * hstep;
    const size_t hstepA = (size_t)HALF * LA * 2, tstepA = 2 * hstepA; const long asplit = g.asplit;
    const __amdgpu_buffer_rsrc_t rsA = __builtin_amdgcn_make_buffer_rsrc((void*)g.A, 0, 0x7ffffff0, 0x00020000), rsB = __builtin_amdgcn_make_buffer_rsrc((void*)g.Bt, 0, 0x7ffffff0, 0x00020000);
#define PG8_KOFFA(t_) ((size_t)(t_) * kstep + ((t_) >= nt / 2 ? asplit : 0L))
    const unsigned ldsw = (unsigned)wid * 1024u;
    const int aoff = lds_byte(wr * 64 + fr, fq * 8), boff = lds_byte(wc * 32 + fr, fq * 8);
#define PG8_SA(b, h) (((b) * 2 + (h)) * HTB)
#define PG8_SB(b, h) ((4 + (b) * 2 + (h)) * HTB)
#define PG8_STAGE_R(bufoff, gbase, voff, RS, BP) do { const unsigned so_ = (unsigned)((const char*)(gbase) - (const char*)(BP)); _Pragma("unroll") for (int _i = 0; _i < 2; ++_i) \
        __builtin_amdgcn_raw_ptr_buffer_load_lds(RS, (LAS unsigned*)(lds + (bufoff) + ldsw + _i * 8192), 16, (int)(voff)[_i], (int)so_, 0, 0); } while (0)
#define PG8_STAGE(bufoff, gbase, voff) PG8_STAGE_R(bufoff, gbase, voff, rsB, g.Bt)
#define PG8_STAGE_A(bufoff, h, dptr, koff, vg) do { if constexpr (GATHER) PG8_STAGE_R(bufoff, (const char*)g.A + (koff), (vg)[h], rsA, g.A); else PG8_STAGE_R(bufoff, (dptr) + (h) * hstepA, voffA, rsA, g.A); } while (0)
#define PG8_LDA(dst, b, h) do { _Pragma("unroll") for (int m = 0; m < 4; ++m) { dst[m].lo = __builtin_bit_cast(i32x4, *(const LAS bf16x8*)(lds + PG8_SA(b, h) + aoff + m * 2048)); dst[m].hi = __builtin_bit_cast(i32x4, *(const LAS bf16x8*)(lds + PG8_SA(b, h) + aoff + m * 2048 + 1024)); } } while (0)
#define PG8_LDB(dst, b, h) do { _Pragma("unroll") for (int n = 0; n < 2; ++n) { dst[n].lo = __builtin_bit_cast(i32x4, *(const LAS bf16x8*)(lds + PG8_SB(b, h) + boff + n * 2048)); dst[n].hi = __builtin_bit_cast(i32x4, *(const LAS bf16x8*)(lds + PG8_SB(b, h) + boff + n * 2048 + 1024)); } } while (0)
#define PG8_FR(v, k) ((k) ? (v).hi : (v).lo)
#define PG8_MMA(ai, bj, At, Bt) do { __builtin_amdgcn_s_setprio(1); _Pragma("unroll") for (int m = 0; m < 4; ++m) _Pragma("unroll") for (int n = 0; n < 2; ++n) { \
        if constexpr (PR == 2) { acc[ai][bj][m][n] = __builtin_amdgcn_mfma_scale_f32_16x16x128_f8f6f4(Bt[n], At[m], acc[ai][bj][m][n], 0, 0, 0, 0x7F7F7F7F, 0, 0x7F7F7F7F); } \
        else { _Pragma("unroll") for (int k = 0; k < 2; ++k) { \
        if constexpr (I8) acc[ai][bj][m][n] = __builtin_amdgcn_mfma_i32_16x16x64_i8(PG8_FR(Bt[n], k), PG8_FR(At[m], k), acc[ai][bj][m][n], 0, 0, 0); \
        else acc[ai][bj][m][n] = __builtin_amdgcn_mfma_f32_16x16x32_bf16(__builtin_bit_cast(bf16x8, PG8_FR(Bt[n], k)), __builtin_bit_cast(bf16x8, PG8_FR(At[m], k)), acc[ai][bj][m][n], 0, 0, 0); } } } __builtin_amdgcn_s_setprio(0); } while (0)
#define PG8_WAIT_V(n) asm volatile("s_waitcnt vmcnt(" #n ")" ::: "memory")
#define PG8_WAIT_L(n) asm volatile("s_waitcnt lgkmcnt(" #n ")" ::: "memory")
#define PG8_BAR __builtin_amdgcn_s_barrier()
#define PG8_SCHED __builtin_amdgcn_sched_barrier(0)
#define PG8_GOFF(dst, u) do { const int t_ = opaque_v(tid); _Pragma("unroll") for (int _i = 0; _i < 2; ++_i) { int R_, C_; stage_rc(t_ * 16 + _i * 8192, R_, C_); \
        _Pragma("unroll") for (int _h = 0; _h < 2; ++_h) dst[_h][_i] = (unsigned)(S.src_row(u, _h * HALF + R_) * K + C_) * 2u; } } while (0)
    Unit cur, nxt, prv; int ui = 0;
    if (!S.next(0, cur)) return;
    prv = cur;
    unsigned vgC[2][2] = {{0u, 0u}, {0u, 0u}}, vgN[2][2] = {{0u, 0u}, {0u, 0u}};
    if constexpr (GATHER) PG8_GOFF(vgC, cur);
    acc_t acc[2][2][4][2];
#pragma unroll
    for (int a = 0; a < 2; ++a)
#pragma unroll
        for (int b = 0; b < 2; ++b)
#pragma unroll
            for (int m = 0; m < 4; ++m)
#pragma unroll
                for (int n = 0; n < 2; ++n) { int z0_, z1_, z2_, z3_; asm volatile("v_mov_b32 %0, 0\n\tv_mov_b32 %1, 0\n\tv_mov_b32 %2, 0\n\tv_mov_b32 %3, 0" : "=v"(z0_), "=v"(z1_), "=v"(z2_), "=v"(z3_)); acc[a][b][m][n] = __builtin_bit_cast(acc_t, (i32x4){z0_, z1_, z2_, z3_}); }
    i32x8 At[4], B0[2], B1[2];
    const char* cA = (const char*)g.A + (GATHER ? (size_t)0 : (size_t)cur.pm * tstepA); const char* cB = (const char*)g.Bt + (size_t)cur.pn * tstep;
    static_assert(SP2, "only the two-super-phase loop is kept");
    PG8_STAGE(PG8_SB(0, 0), cB, voffB); PG8_STAGE(PG8_SB(0, 1), cB + hstep, voffB); PG8_STAGE_A(PG8_SA(0, 0), 0, cA, 0, vgC); PG8_STAGE_A(PG8_SA(0, 1), 1, cA, 0, vgC);
    if (wr == 1) PG8_BAR;
    PG8_WAIT_V(2); PG8_BAR;
    PG8_STAGE(PG8_SB(1, 0), cB + kstep, voffB); PG8_STAGE_A(PG8_SA(1, 0), 0, cA + kstep, kstep, vgC); PG8_STAGE(PG8_SB(1, 1), cB + hstep + kstep, voffB);
    PG8_WAIT_V(6); PG8_BAR;
    for (;;) {
        const bool has_next = S.next(ui + 1, nxt);
        if constexpr (GATHER) { if (has_next) PG8_GOFF(vgN, nxt); else {
#pragma unroll
            for (int h_ = 0; h_ < 2; ++h_)
#pragma unroll
                for (int i_ = 0; i_ < 2; ++i_) vgN[h_][i_] = vgC[h_][i_]; } }
        const char* nA = (has_next && !GATHER) ? (const char*)g.A + (size_t)nxt.pm * tstepA : cA; const char* nB = has_next ? (const char*)g.Bt + (size_t)nxt.pn * tstep : cB;
#pragma unroll 1
        for (int t = 0; t < nt; t += 2) {
            const bool last = (t == nt - 2);
            if constexpr (Epi::MIDHOOK) { if (t == nt / 2) E.mid(acc, cur, wr, wc, opaque_v(fr), fq); }
            const char* a1 = cA + PG8_KOFFA(t + 1); const size_t k1 = (size_t)(t + 1) * kstep;
            const char* a2 = last ? nA : cA + PG8_KOFFA(t + 2); const char* b2 = last ? nB : cB + (size_t)(t + 2) * kstep;
            const size_t k2 = last ? (size_t)0 : (size_t)(t + 2) * kstep, k3 = k2 + kstep;
            const char* a3 = a2 + kstep; const char* b3 = b2 + kstep;
            PG8_LDB(B0, 0, 0); PG8_LDB(B1, 0, 1); PG8_SCHED; PG8_LDA(At, 0, 0); PG8_STAGE_A(PG8_SA(1, 1), 1, a1, k1, vgC);
            if constexpr (GATHER) { if (last) {
#pragma unroll
                for (int h_ = 0; h_ < 2; ++h_)
#pragma unroll
                    for (int i_ = 0; i_ < 2; ++i_) vgC[h_][i_] = vgN[h_][i_]; } }
            PG8_WAIT_V(8); PG8_WAIT_L(0); PG8_BAR; PG8_MMA(0, 0, At, B0); PG8_MMA(0, 1, At, B1); PG8_BAR; PG8_SCHED;
            PG8_LDA(At, 0, 1); PG8_STAGE(PG8_SB(0, 0), b2, voffB); PG8_STAGE(PG8_SB(0, 1), b2 + hstep, voffB); PG8_STAGE_A(PG8_SA(0, 0), 0, a2, k2, vgC);
            PG8_WAIT_V(8); PG8_WAIT_L(0); PG8_BAR; PG8_MMA(1, 0, At, B0); PG8_MMA(1, 1, At, B1); PG8_BAR; PG8_SCHED;
            PG8_LDB(B0, 1, 0); PG8_LDB(B1, 1, 1); PG8_SCHED; PG8_LDA(At, 1, 0); PG8_STAGE_A(PG8_SA(0, 1), 1, a2, k2, vgC);
            PG8_WAIT_V(8); PG8_WAIT_L(0); PG8_BAR; PG8_MMA(0, 0, At, B0); PG8_MMA(0, 1, At, B1); PG8_BAR; PG8_SCHED;
            PG8_LDA(At, 1, 1); PG8_STAGE(PG8_SB(1, 0), b3, voffB); PG8_STAGE(PG8_SB(1, 1), b3 + hstep, voffB); PG8_STAGE_A(PG8_SA(1, 0), 0, a3, k3, vgC);
            PG8_WAIT_V(8); PG8_WAIT_L(0); PG8_BAR; PG8_MMA(1, 0, At, B0); PG8_MMA(1, 1, At, B1); PG8_BAR; PG8_SCHED;
        }
        if constexpr (ALIGN_EPI) { if (wr == 0) PG8_BAR; }
        if (ui > 0) S.done(prv);
        E(acc, cur, wr, wc, opaque_v(fr), fq);
        prv = cur;
        if (!has_next) break;
#pragma unroll
        for (int a = 0; a < 2; ++a)
#pragma unroll
            for (int b = 0; b < 2; ++b)
#pragma unroll
                for (int m = 0; m < 4; ++m)
#pragma unroll
                    for (int n = 0; n < 2; ++n) { int z0_, z1_, z2_, z3_; asm volatile("v_mov_b32 %0, 0\n\tv_mov_b32 %1, 0\n\tv_mov_b32 %2, 0\n\tv_mov_b32 %3, 0" : "=v"(z0_), "=v"(z1_), "=v"(z2_), "=v"(z3_)); acc[a][b][m][n] = __builtin_bit_cast(acc_t, (i32x4){z0_, z1_, z2_, z3_}); }
        cur = nxt; cA = nA; cB = nB; ++ui;
        if constexpr (ALIGN_EPI) { if (wr == 1) PG8_BAR; }
    }
    PG8_WAIT_V(0);
    S.done(prv);
    if constexpr (!ALIGN_EPI) { if (wr == 0) PG8_BAR; }
    PG8_BAR;
#undef PG8_SA
#undef PG8_SB
#undef PG8_STAGE
#undef PG8_STAGE_R
#undef PG8_STAGE_A
#undef PG8_LDA
#undef PG8_LDB
#undef PG8_MMA
#undef PG8_WAIT_V
#undef PG8_WAIT_L
#undef PG8_BAR
#undef PG8_SCHED
#undef PG8_GOFF
#undef PG8_FR
#undef PG8_KOFFA
}
}

#define XB_TMO      128
#define XB_XCNT(j)  (256  + 64 * (j))
#define XB_XSUB(j)  (1280 + 64 * (j))
#define XB_XGEN(j)  (2304 + 64 * (j))
#define XB_TOP      3328
#define XB_TOPGEN   3392
#define XCD_BAR_WORDS 3456
#define XB_SPIN_CAP (1u << 18)

__device__ __forceinline__ unsigned xb_ld(unsigned* p)              { return __hip_atomic_load(p, __ATOMIC_RELAXED, __HIP_MEMORY_SCOPE_AGENT); }
__device__ __forceinline__ unsigned xb_add(unsigned* p, unsigned v) { return __hip_atomic_fetch_add(p, v, __ATOMIC_RELAXED, __HIP_MEMORY_SCOPE_AGENT); }
__device__ __forceinline__ unsigned xb_xcc_id() { return (unsigned)__builtin_amdgcn_s_getreg((3 << 11) | 20) & 0xFu; }
#define XB_SPIN(cond, bar) do { unsigned _sp = 0; while (cond) { __builtin_amdgcn_s_sleep(1); \
    if ((++_sp & 255u) == 0u) { if (xb_ld(&(bar)[XB_TMO])) break; if (_sp > XB_SPIN_CAP) { atomicAdd(&(bar)[XB_TMO], 1u); break; } } } } while (0)

struct XcdBarrier {
    unsigned* bar; unsigned x;
    volatile LAS unsigned* st;
};

__device__ __forceinline__ XcdBarrier xcd_barrier_post(unsigned* bar, volatile LAS unsigned* st) {
    XcdBarrier b; b.bar = bar; b.x = xb_xcc_id(); b.st = st;
    if (threadIdx.x == 0) (void)xb_add(&bar[XB_XCNT(b.x)], 1u);
    return b;
}
__device__ __forceinline__ void xcd_barrier_complete(unsigned* bar, unsigned x, unsigned& nloc, unsigned& nx) {
    const unsigned G = gridDim.x * gridDim.y * gridDim.z;
    unsigned sum, cnt, mine, sp = 0u;
    for (;;) {
        sum = 0u; cnt = 0u; mine = 0u;
#pragma unroll
        for (unsigned j = 0; j < 16; ++j) { const unsigned c = xb_ld(&bar[XB_XCNT(j)]); sum += c; cnt += (c > 0u) ? 1u : 0u; mine = (j == x) ? c : mine; }
        if (sum == G) break;
        __builtin_amdgcn_s_sleep(1);
        if ((++sp & 255u) == 0u) { if (xb_ld(&bar[XB_TMO])) break; if (sp > XB_SPIN_CAP) { atomicAdd(&bar[XB_TMO], 1u); break; } }
    }
    nloc = mine > 0u ? mine : 1u; nx = cnt > 0u ? cnt : 1u;
}

__device__ __forceinline__ void xcd_barrier(const XcdBarrier& b) {
    asm volatile("s_waitcnt vmcnt(0)" ::: "memory");
    __syncthreads();
    if (my_tid() == 0) {
        unsigned* bar = b.bar;
        __builtin_amdgcn_s_waitcnt(0);
        unsigned nloc = b.st[0], nx = b.st[1];
        if (nloc == 0u) { xcd_barrier_complete(bar, b.x, nloc, nx); b.st[0] = nloc; b.st[1] = nx; }
        const unsigned old = xb_add(&bar[XB_XSUB(b.x)], 1u);
        const unsigned gen = old / nloc;
        if (old + 1u == (gen + 1u) * nloc) {
            __builtin_amdgcn_fence(__ATOMIC_RELEASE, "agent");
            asm volatile("s_waitcnt vmcnt(0)" ::: "memory");
            const unsigned og = xb_add(&bar[XB_TOP], 1u);
            const unsigned tg = og / nx;
            if (og + 1u == (tg + 1u) * nx) xb_add(&bar[XB_TOPGEN], 1u);
            else XB_SPIN(xb_ld(&bar[XB_TOPGEN]) == tg, bar);
            __builtin_amdgcn_fence(__ATOMIC_ACQUIRE, "agent");
            xb_add(&bar[XB_XGEN(b.x)], 1u);
            asm volatile("s_waitcnt vmcnt(0)" ::: "memory");
        } else {
            XB_SPIN(xb_ld(&bar[XB_XGEN(b.x)]) == gen, bar);
            __builtin_amdgcn_fence(__ATOMIC_ACQUIRE, "agent");
            asm volatile("s_waitcnt vmcnt(0)" ::: "memory");
        }
    }
    __syncthreads();
}

#ifndef ATT_B_SDEPTH
#define ATT_B_SDEPTH 2
#endif
#ifndef ATT_B_QPARK
#define ATT_B_QPARK 5
#endif

namespace att {
constexpr int D = 128, NW = 8, QBLK = 32, KVBLK = 64;
constexpr float THR = 8.f;
constexpr size_t SHM_V = KVBLK * D * 2, SHM_K = KVBLK * D * 2, SHM_KR = KVBLK * 64 * 2;
constexpr size_t OFF_V = 0, OFF_K = 2 * SHM_V, OFF_KR = OFF_K + 2 * SHM_K, OFF_WS = OFF_KR + 2 * SHM_KR, OFF_QR = OFF_WS + NW * 64 * 4, SHM_ATTN = OFF_QR + NW * 9216;
#define KSWZ(row, colB) ((row) * 256 + ((colB) ^ ((((row) & 7) | (((row) >> 1) & 8)) << 4)))
#define KRSWZ(row, colB) ((row) * 128 + ((colB) ^ ((((row) >> 1) & 7) << 4)))
#define SBAR() __builtin_amdgcn_sched_barrier(0)
__device__ __forceinline__ int crow(int r, int hi) { return (r & 3) + 8 * (r >> 2) + 4 * hi; }
typedef __bf16 bf16x2_t __attribute__((ext_vector_type(2)));
__device__ __forceinline__ unsigned cvtpk(float lo, float hi) { const f32x2 v = {lo, hi}; return __builtin_bit_cast(unsigned, __builtin_convertvector(v, bf16x2_t)); }
template <int DR> __device__ __forceinline__ void seg1_sched() {
  __builtin_amdgcn_sched_group_barrier(0x100, DR ? 4 : 3, 0);
#pragma unroll
  for (int i = 0; i < 8; ++i) {
    __builtin_amdgcn_sched_group_barrier(0x008, 1, 0); __builtin_amdgcn_sched_group_barrier(0x100, 1, 0); __builtin_amdgcn_sched_group_barrier(0x400, 1, 0); __builtin_amdgcn_sched_group_barrier(0x002, DR ? 3 : 4, 0);
    __builtin_amdgcn_sched_group_barrier(0x008, 1, 0); __builtin_amdgcn_sched_group_barrier(0x100, DR ? 2 : 1, 0); __builtin_amdgcn_sched_group_barrier(0x400, 1, 0); __builtin_amdgcn_sched_group_barrier(0x002, DR ? 3 : 4, 0); }
  if constexpr (DR > 0) {
#pragma unroll
    for (int i = 0; i < 4; ++i) {
      __builtin_amdgcn_sched_group_barrier(0x008, 1, 0); __builtin_amdgcn_sched_group_barrier(0x100, 1, 0); __builtin_amdgcn_sched_group_barrier(0x002, 2, 0);
      __builtin_amdgcn_sched_group_barrier(0x008, 1, 0); __builtin_amdgcn_sched_group_barrier(0x100, 2, 0); __builtin_amdgcn_sched_group_barrier(0x002, 2, 0); }
  }
}
__device__ __forceinline__ bf16x8 ld8(const bf16_t* p) { return *reinterpret_cast<const bf16x8*>(p); }

template <int DR> struct Cfg { static constexpr float SCALE = 0.6931471805599453f; };

template <int DR>
__device__ __forceinline__ void partialSM(f32x16& p0, f32x16& p1, float& m_reg, float& mn, float& alpha) {
  constexpr float SCALE = Cfg<DR>::SCALE; constexpr float C = SCALE * 1.4426950408889634f;
  float pmax = p0[0];
#pragma unroll
  for (int r = 1; r < 16; ++r) pmax = fmaxf(pmax, p0[r]);
#pragma unroll
  for (int r = 0; r < 16; ++r) pmax = fmaxf(pmax, p1[r]);
  { auto rr = __builtin_amdgcn_permlane32_swap(__float_as_uint(pmax), __float_as_uint(pmax), false, false);
    pmax = fmaxf(__uint_as_float(rr[0]), __uint_as_float(rr[1])); }
  if (__builtin_expect(__all(pmax - m_reg <= THR / SCALE), 1)) { mn = m_reg; alpha = 1.f; }
  else { mn = fmaxf(m_reg, pmax); alpha = __builtin_amdgcn_exp2f((m_reg - mn) * C); m_reg = mn; }
  float mnC = -mn * C;
#pragma unroll
  for (int r = 0; r < 16; ++r) p0[r] = fmaf(p0[r], C, mnC);
#pragma unroll
  for (int r = 0; r < 16; ++r) p1[r] = fmaf(p1[r], C, mnC);
#pragma unroll
  for (int r = 0; r < 16; ++r) p0[r] = __builtin_amdgcn_exp2f(p0[r]);
}
__device__ __forceinline__ void finishSM(f32x16& p0, f32x16& p1, float alpha, float& l_reg, bf16x8& pa0, bf16x8& pa1, bf16x8& pa2, bf16x8& pa3) {
#pragma unroll
  for (int r = 0; r < 16; ++r) p1[r] = __builtin_amdgcn_exp2f(p1[r]);
  float ps = 0;
#pragma unroll
  for (int r = 0; r < 16; ++r) ps += p0[r];
#pragma unroll
  for (int r = 0; r < 16; ++r) ps += p1[r];
  { auto rr = __builtin_amdgcn_permlane32_swap(__float_as_uint(ps), __float_as_uint(ps), false, false);
    ps = __uint_as_float(rr[0]) + __uint_as_float(rr[1]); }
  l_reg = l_reg * alpha + ps;
#define PK4(P, BASE, OUT) do { u32x4 w = {cvtpk(P[BASE + 0], P[BASE + 1]), cvtpk(P[BASE + 2], P[BASE + 3]), cvtpk(P[BASE + 4], P[BASE + 5]), cvtpk(P[BASE + 6], P[BASE + 7])}; \
    OUT = __builtin_bit_cast(bf16x8, w); } while (0)
  PK4(p0, 0, pa0); PK4(p0, 8, pa1); PK4(p1, 0, pa2); PK4(p1, 8, pa3);
#undef PK4
}
__device__ __forceinline__ void finishSM_fast(f32x16& p0, f32x16& p1, float& l_reg, bf16x8& pa0, bf16x8& pa1, bf16x8& pa2, bf16x8& pa3) {
#pragma unroll
  for (int r = 0; r < 16; ++r) p1[r] = __builtin_amdgcn_exp2f(p1[r]);
  float ps = 0;
#pragma unroll
  for (int r = 0; r < 16; ++r) ps += p0[r];
#pragma unroll
  for (int r = 0; r < 16; ++r) ps += p1[r];
  { auto rr = __builtin_amdgcn_permlane32_swap(__float_as_uint(ps), __float_as_uint(ps), false, false);
    ps = __uint_as_float(rr[0]) + __uint_as_float(rr[1]); }
  l_reg += ps;
#define PK4(P, BASE, OUT) do { u32x4 w = {cvtpk(P[BASE + 0], P[BASE + 1]), cvtpk(P[BASE + 2], P[BASE + 3]), cvtpk(P[BASE + 4], P[BASE + 5]), cvtpk(P[BASE + 6], P[BASE + 7])}; \
    OUT = __builtin_bit_cast(bf16x8, w); } while (0)
  PK4(p0, 0, pa0); PK4(p0, 8, pa1); PK4(p1, 0, pa2); PK4(p1, 8, pa3);
#undef PK4
}
__device__ __forceinline__ void exp16(f32x16& p) {
#pragma unroll
  for (int r = 0; r < 16; ++r) p[r] = __builtin_amdgcn_exp2f(p[r]);
}
template <int DR, int QPARK>
__device__ __forceinline__ void qkt(f32x16& p0, f32x16& p1, const char* Ks, const char* KRs, const bf16x8* qr, const char* QRs, int r32, int hi) {
  p0 = f32x16{}; p1 = f32x16{};
#pragma unroll
  for (int d0 = 0; d0 < 8; ++d0) { int cb = (d0 * 16 + hi * 8) * 2;
    bf16x8 b0 = *reinterpret_cast<const bf16x8*>(Ks + KSWZ(r32, cb));
    bf16x8 b1 = *reinterpret_cast<const bf16x8*>(Ks + KSWZ(32 + r32, cb));
    bf16x8 q; if (d0 >= 8 - QPARK) q = *reinterpret_cast<const bf16x8*>(QRs + (4 + d0 - (8 - QPARK)) * 1024); else q = qr[d0];
    p0 = __builtin_amdgcn_mfma_f32_32x32x16_bf16(b0, q, p0, 0, 0, 0);
    p1 = __builtin_amdgcn_mfma_f32_32x32x16_bf16(b1, q, p1, 0, 0, 0); }
  if constexpr (DR > 0) {
#pragma unroll
    for (int d0 = 0; d0 < DR / 16; ++d0) { int cb = (d0 * 16 + hi * 8) * 2;
      bf16x8 b0 = *reinterpret_cast<const bf16x8*>(KRs + KRSWZ(r32, cb));
      bf16x8 b1 = *reinterpret_cast<const bf16x8*>(KRs + KRSWZ(32 + r32, cb));
      bf16x8 q; if constexpr (QPARK >= 0) q = *reinterpret_cast<const bf16x8*>(QRs + d0 * 1024); else q = qr[8 + d0];
      p0 = __builtin_amdgcn_mfma_f32_32x32x16_bf16(b0, q, p0, 0, 0, 0);
      p1 = __builtin_amdgcn_mfma_f32_32x32x16_bf16(b1, q, p1, 0, 0, 0); }
  }
}
__device__ __forceinline__ int v_st(int k, int c) { const int kk = k; return ((kk >> 3) * 4 + (c >> 5)) * 512 + ((kk & 7) * 32 + (c & 31)) * 2; }
__device__ __forceinline__ int v_rd_base(int lane) { return ((lane & 3) << 3) | (((lane >> 2) & 3) << 6) | (((lane >> 4) & 1) << 5) | (((lane >> 5) & 1) << 8); }
constexpr int v_rd_off(int d0, int ks, int half) { return d0 * 512 + ks * 4096 + half * 2048; }
template <int OFF> __device__ __forceinline__ s16x4 tr_read(int vb) {
  s16x4 r; asm volatile("ds_read_b64_tr_b16 %0, %1 offset:%2" : "=&v"(r) : "v"(vb), "i"(OFF) : "memory"); return r;
}
template <int D0> __device__ __forceinline__ void pv_one(f32x16& od, int vb, bf16x8 pa0, bf16x8 pa1, bf16x8 pa2, bf16x8 pa3) {
  const s16x4 l0 = tr_read<v_rd_off(D0, 0, 0)>(vb), h0 = tr_read<v_rd_off(D0, 0, 1)>(vb), l1 = tr_read<v_rd_off(D0, 1, 0)>(vb), h1 = tr_read<v_rd_off(D0, 1, 1)>(vb);
  const s16x4 l2 = tr_read<v_rd_off(D0, 2, 0)>(vb), h2 = tr_read<v_rd_off(D0, 2, 1)>(vb), l3 = tr_read<v_rd_off(D0, 3, 0)>(vb), h3 = tr_read<v_rd_off(D0, 3, 1)>(vb);
  asm volatile("s_waitcnt lgkmcnt(0)" ::: "memory"); SBAR();
#define PK(L, H) (bf16x8){L[0], L[1], L[2], L[3], H[0], H[1], H[2], H[3]}
  od = __builtin_amdgcn_mfma_f32_32x32x16_bf16(pa0, PK(l0, h0), od, 0, 0, 0);
  od = __builtin_amdgcn_mfma_f32_32x32x16_bf16(pa1, PK(l1, h1), od, 0, 0, 0);
  od = __builtin_amdgcn_mfma_f32_32x32x16_bf16(pa2, PK(l2, h2), od, 0, 0, 0);
  od = __builtin_amdgcn_mfma_f32_32x32x16_bf16(pa3, PK(l3, h3), od, 0, 0, 0);
#undef PK
}
template <int DR>
__device__ __forceinline__ void pv_partialSM(f32x16* o, int vb, bf16x8 pa0, bf16x8 pa1, bf16x8 pa2, bf16x8 pa3, f32x16& p0, f32x16& p1, float& m_reg, float& mnC, float& alpha) {
  constexpr float SCALE = Cfg<DR>::SCALE; constexpr float C = SCALE * 1.4426950408889634f;
  pv_one<0>(o[0], vb, pa0, pa1, pa2, pa3);
  float pmax = p0[0];
#pragma unroll
  for (int r = 1; r < 16; ++r) pmax = fmaxf(pmax, p0[r]);
#pragma unroll
  for (int r = 0; r < 16; ++r) pmax = fmaxf(pmax, p1[r]);
  { auto rr = __builtin_amdgcn_permlane32_swap(__float_as_uint(pmax), __float_as_uint(pmax), false, false);
    pmax = fmaxf(__uint_as_float(rr[0]), __uint_as_float(rr[1])); }
  alpha = 1.f;
  if (__builtin_expect(!__all(pmax - m_reg <= THR / SCALE), 0)) {
    asm volatile("" ::: "memory");
    const float mn = fmaxf(m_reg, pmax); alpha = __builtin_amdgcn_exp2f((m_reg - mn) * C); m_reg = mn; mnC = -mn * C; }
  pv_one<1>(o[1], vb, pa0, pa1, pa2, pa3);
#pragma unroll
  for (int r = 0; r < 16; ++r) p0[r] = fmaf(p0[r], C, mnC);
#pragma unroll
  for (int r = 0; r < 8; ++r) p0[r] = __builtin_amdgcn_exp2f(p0[r]);
  pv_one<2>(o[2], vb, pa0, pa1, pa2, pa3);
#pragma unroll
  for (int r = 8; r < 16; ++r) p0[r] = __builtin_amdgcn_exp2f(p0[r]);
#pragma unroll
  for (int r = 0; r < 8; ++r) p1[r] = fmaf(p1[r], C, mnC);
  pv_one<3>(o[3], vb, pa0, pa1, pa2, pa3);
#pragma unroll
  for (int r = 8; r < 16; ++r) p1[r] = fmaf(p1[r], C, mnC);
  asm volatile("" : "+v"(p0), "+v"(p1));
}
__device__ __forceinline__ void pv_fast(f32x16* o, int vb, bf16x8 pa0, bf16x8 pa1, bf16x8 pa2, bf16x8 pa3, f32x16& p0) {
  pv_one<0>(o[0], vb, pa0, pa1, pa2, pa3);
#pragma unroll
  for (int r = 0; r < 4; ++r) p0[r] = __builtin_amdgcn_exp2f(p0[r]);
  pv_one<1>(o[1], vb, pa0, pa1, pa2, pa3);
#pragma unroll
  for (int r = 4; r < 8; ++r) p0[r] = __builtin_amdgcn_exp2f(p0[r]);
  pv_one<2>(o[2], vb, pa0, pa1, pa2, pa3);
#pragma unroll
  for (int r = 8; r < 12; ++r) p0[r] = __builtin_amdgcn_exp2f(p0[r]);
  pv_one<3>(o[3], vb, pa0, pa1, pa2, pa3);
#pragma unroll
  for (int r = 12; r < 16; ++r) p0[r] = __builtin_amdgcn_exp2f(p0[r]);
  asm volatile("" : "+v"(p0));
}
__device__ __forceinline__ void pv_d0(f32x16* o, int vb, bf16x8 pa0, bf16x8 pa1, bf16x8 pa2, bf16x8 pa3) {
  pv_one<0>(o[0], vb, pa0, pa1, pa2, pa3); pv_one<1>(o[1], vb, pa0, pa1, pa2, pa3); pv_one<2>(o[2], vb, pa0, pa1, pa2, pa3); pv_one<3>(o[3], vb, pa0, pa1, pa2, pa3);
}

constexpr int ATT_FLAG_OFF = 159744 + 768;
#ifndef ATT_FORCE_SLOW
#define ATT_FORCE_SLOW 0
#endif
template <int DR, int QPARK, int SDEPTH, int LDQ, int LDK, int LDV, int LDO, bool O8 = false, bool FAST = false>
__device__ __forceinline__ bool attn_body(const bf16_t* __restrict__ Qb, const bf16_t* __restrict__ Kh, const bf16_t* __restrict__ Vh, const bf16_t* __restrict__ KRh,
                                          bf16_t* __restrict__ Ob, int seq, char* lds) {
  constexpr int NQ = (QPARK < 0) ? 8 + DR / 16 : (QPARK == 8 ? 1 : 8 - QPARK);
  constexpr int QPB = (QPARK < 0) ? 0 : (DR / 16 + QPARK) * 1024;
  static_assert(LDK == LDV, "K and V share the staging offsets");
  const int tid = opaque_v(my_tid()), wid = tid >> 6, lane = tid & 63, r32 = lane & 31, hi = lane >> 5;
  char* V_lds = lds + OFF_V; char* K_lds = lds + OFF_K; char* KR_lds = lds + OFF_KR;
  float* ws = (float*)(lds + OFF_WS) + wid * 64; float* li_l = ws; float* al_l = ws + 32;
  float m_reg = -1e30f, l_reg = 0; f32x16 o[4] = {}; bf16x8 qr[NQ];
  if constexpr (FAST) { if (tid == 0) *(volatile LAS unsigned*)(unsigned long)ATT_FLAG_OFF = 0u; }
  const bf16_t* Qw = Qb + (long)(wid * QBLK + r32) * LDQ + hi * 8;
#pragma unroll
  for (int d0 = 0; d0 < NQ; ++d0) { if constexpr (QPARK == 8) qr[d0] = bf16x8{}; else qr[d0] = ld8(Qw + d0 * 16); }
  char* QRs = lds + OFF_QR + wid * QPB + lane * 16;
  if constexpr (QPARK >= 0) {
#pragma unroll
    for (int d0 = 0; d0 < DR / 16; ++d0) *(bf16x8*)(QRs + d0 * 1024) = ld8(Qw + 128 + d0 * 16);
#pragma unroll
    for (int d0 = 8 - QPARK; d0 < 8; ++d0) *(bf16x8*)(QRs + (4 + d0 - (8 - QPARK)) * 1024) = ld8(Qw + d0 * 16);
  }
  const int sr = tid >> 4, sc = (tid & 15) * 8, vst0 = v_st(sr, sc), vst1 = v_st(32 + sr, sc);
  const int krr = tid >> 3, krc = (tid & 7) * 8;
  const int vb0 = (int)(uintptr_t)V_lds + v_rd_base(lane);
  struct { bf16x8 vs0, vs1, ks0, ks1, kr; } sr_[SDEPTH];
  const unsigned soff0 = (unsigned)(sr * LDK + sc) * 2u, soff1 = soff0 + (unsigned)(32 * LDK * 2), sofr = (unsigned)(krr * 64 + krc) * 2u;
  const __amdgpu_buffer_rsrc_t rsV = __builtin_amdgcn_make_buffer_rsrc((void*)Vh, 0, 0x7ffffff0, 0x00020000), rsK = __builtin_amdgcn_make_buffer_rsrc((void*)Kh, 0, 0x7ffffff0, 0x00020000);
  const __amdgpu_buffer_rsrc_t rsR = __builtin_amdgcn_make_buffer_rsrc((void*)(DR > 0 ? KRh : Kh), 0, 0x7ffffff0, 0x00020000);
#define BL128(rs, vo, so) __builtin_bit_cast(bf16x8, __builtin_amdgcn_raw_buffer_load_b128(rs, (int)(vo), (int)(so), 0))
#define SLOAD(i, k0) do { const unsigned so_ = (unsigned)(k0) * (unsigned)(LDV * 2); \
    sr_[i].vs0 = BL128(rsV, soff0, so_); sr_[i].vs1 = BL128(rsV, soff1, so_); \
    sr_[i].ks0 = BL128(rsK, soff0, so_); sr_[i].ks1 = BL128(rsK, soff1, so_); \
    if constexpr (DR > 0) sr_[i].kr = BL128(rsR, sofr, (unsigned)(k0) * 128u); } while (0)
#define SWRITE(b, i) do { *(bf16x8*)(V_lds + (b) * SHM_V + vst0) = sr_[i].vs0;          \
    *(bf16x8*)(V_lds + (b) * SHM_V + vst1) = sr_[i].vs1; int kc = sc * 2;               \
    *(bf16x8*)(K_lds + (b) * SHM_K + KSWZ(sr, kc)) = sr_[i].ks0;                       \
    *(bf16x8*)(K_lds + (b) * SHM_K + KSWZ(32 + sr, kc)) = sr_[i].ks1;                  \
    if constexpr (DR > 0) *(bf16x8*)(KR_lds + (b) * SHM_KR + KRSWZ(krr, krc * 2)) = sr_[i].kr; } while (0)
#define SWAIT() do { if constexpr (SDEPTH == 2) { if constexpr (DR > 0) asm volatile("s_waitcnt vmcnt(5)" ::: "memory"); else asm volatile("s_waitcnt vmcnt(4)" ::: "memory"); } \
    else asm volatile("s_waitcnt vmcnt(0)" ::: "memory"); } while (0)
#define RESC(a) do { if (__any((a) < 1.f)) { if (hi == 0) al_l[r32] = (a); asm volatile("s_waitcnt lgkmcnt(0)" ::: "memory"); \
    _Pragma("unroll") for (int d = 0; d < 4; ++d) _Pragma("unroll") for (int r = 0; r < 16; ++r) o[d][r] *= al_l[crow(r, hi)]; } } while (0)
  f32x16 pA0, pA1, pB0, pB1; float mnA, mnB, alA, alB; bf16x8 pa0, pa1, pa2, pa3; const int NT = seq / KVBLK;
  constexpr int SE = 0, SO = SDEPTH - 1;
  SLOAD(SE, 0); asm volatile("s_waitcnt vmcnt(0)" ::: "memory"); SWRITE(0, SE); __syncthreads();
  qkt<DR, QPARK>(pA0, pA1, K_lds, KR_lds, qr, QRs, r32, hi);
  if constexpr (FAST) exp16(pA0); else partialSM<DR>(pA0, pA1, m_reg, mnA, alA);
  float mnC_ = -m_reg * (Cfg<DR>::SCALE * 1.4426950408889634f);
  SLOAD(SO, KVBLK); if constexpr (SDEPTH == 2) { if (2 < NT) SLOAD(SE, 2 * KVBLK); }
  SWAIT(); SWRITE(1, SO); __syncthreads();
  for (int j = 1; j + 1 < NT; j += 2) {
    SBAR(); qkt<DR, QPARK>(pB0, pB1, K_lds + SHM_K, KR_lds + SHM_KR, qr, QRs, r32, hi);
    if constexpr (FAST) finishSM_fast(pA0, pA1, l_reg, pa0, pa1, pa2, pa3); else finishSM(pA0, pA1, alA, l_reg, pa0, pa1, pa2, pa3);
    seg1_sched<DR>(); SBAR();
    SLOAD(SO, (j + SDEPTH) * KVBLK); SBAR();
    if constexpr (FAST) pv_fast(o, vb0, pa0, pa1, pa2, pa3, pB0); else pv_partialSM<DR>(o, vb0, pa0, pa1, pa2, pa3, pB0, pB1, m_reg, mnC_, alB);
    __syncthreads(); SWAIT(); SWRITE(0, SE);
    if constexpr (!FAST) RESC(alB);
    __syncthreads();
    SBAR(); qkt<DR, QPARK>(pA0, pA1, K_lds, KR_lds, qr, QRs, r32, hi);
    if constexpr (FAST) finishSM_fast(pB0, pB1, l_reg, pa0, pa1, pa2, pa3); else finishSM(pB0, pB1, alB, l_reg, pa0, pa1, pa2, pa3);
    seg1_sched<DR>(); SBAR();
    if (SDEPTH == 1 || j + 3 < NT) SLOAD(SE, (j + 1 + SDEPTH) * KVBLK); SBAR();
    if constexpr (FAST) pv_fast(o, vb0 + (int)SHM_V, pa0, pa1, pa2, pa3, pA0); else pv_partialSM<DR>(o, vb0 + (int)SHM_V, pa0, pa1, pa2, pa3, pA0, pA1, m_reg, mnC_, alA);
    __syncthreads(); SWAIT(); SWRITE(1, SO);
    if constexpr (!FAST) RESC(alA);
    __syncthreads();
  }
  SBAR(); qkt<DR, QPARK>(pB0, pB1, K_lds + SHM_K, KR_lds + SHM_KR, qr, QRs, r32, hi);
  if constexpr (FAST) { finishSM_fast(pA0, pA1, l_reg, pa0, pa1, pa2, pa3); SBAR(); pv_fast(o, vb0, pa0, pa1, pa2, pa3, pB0); __syncthreads();
    finishSM_fast(pB0, pB1, l_reg, pa0, pa1, pa2, pa3); SBAR(); }
  else {
  finishSM(pA0, pA1, alA, l_reg, pa0, pa1, pa2, pa3); SBAR();
  pv_d0(o, vb0, pa0, pa1, pa2, pa3); partialSM<DR>(pB0, pB1, m_reg, mnB, alB);
  __syncthreads(); RESC(alB);
  finishSM(pB0, pB1, alB, l_reg, pa0, pa1, pa2, pa3); SBAR(); }
  pv_d0(o, vb0 + (int)SHM_V, pa0, pa1, pa2, pa3);
  if constexpr (FAST) {
    const bool bad = ATT_FORCE_SLOW || !(l_reg > 1e-30f && l_reg < 1e30f);
    if (__any(bad) && lane == 0) *(volatile LAS unsigned*)(unsigned long)ATT_FLAG_OFF = 1u;
    __syncthreads();
    const unsigned wgbad = *(volatile LAS unsigned*)(unsigned long)ATT_FLAG_OFF;
    if (wgbad) { __syncthreads(); return true; }
  }
  if (hi == 0) li_l[r32] = l_reg; asm volatile("s_waitcnt lgkmcnt(0)" ::: "memory");
  float rli[16];
#pragma unroll
  for (int r = 0; r < 16; ++r) rli[r] = __builtin_amdgcn_rcpf(li_l[crow(r, hi)]);
  bf16_t* Ow = Ob + (long)(wid * QBLK) * LDO;
#pragma unroll
  for (int r = 0; r < 16; ++r) { int orow = crow(r, hi);
#pragma unroll
    for (int d0 = 0; d0 < 4; ++d0) {
      if constexpr (O8) { const float v = fminf(fmaxf(o[d0][r] * rli[r] * 64.0f, -448.f), 448.f);
        ((unsigned char*)Ob)[(long)(wid * QBLK + orow) * LDO + d0 * 32 + r32] = (unsigned char)(__builtin_amdgcn_cvt_pk_fp8_f32(v, 0.f, 0u, false) & 0xffu); }
      else { const unsigned w = cvtpk(o[d0][r] * rli[r], 0.f); Ow[(long)orow * LDO + d0 * 32 + r32] = (bf16_t)(w & 0xffffu); } } }
  __syncthreads();
  return false;
#undef SLOAD
#undef SWRITE
#undef SWAIT
#undef RESC
}
}

__device__ __forceinline__ int rope_perm128(int j) { return j < 64 ? 2 * j : 2 * (j - 64) + 1; }
__device__ __forceinline__ int rope_perm64(int r) { return r < 32 ? 2 * r : 2 * (r - 32) + 1; }
template <int MODE> __device__ __forceinline__ int rowmap(int n) {
    if constexpr (MODE == 0) return n;
    else if constexpr (MODE == 1) {
        if (n < 1280) return (n & ~127) + rope_perm128(n & 127);
        if (n < 1536) return n;
        if (n < 3072) { const int q = n - 1536, h = q / 192, j = q % 192; return 1536 + h * 192 + (j < 128 ? j : 128 + rope_perm64(j - 128)); }
        if (n < 3584) return n;
        if (n < 3648) return C_KR + rope_perm64(n - 3584);
        return n + 192;
    } else if constexpr (MODE == 2) return (n >> 7) * 256 + (n & 127);
    else return (n >> 7) * 256 + 128 + (n & 127);
}
template <int MODE>
__device__ __forceinline__ void tr_item(const float* __restrict__ W, int N, int K, bf16_t* __restrict__ WT, int row_off, const float* __restrict__ kscale, LAS float* scr, int item, int lane) {
    const int nblk = N / 32, kb = item / nblk, nb = item % nblk, k0 = 64 * kb, n0 = 32 * nb;
    f32x4 v[8];
#pragma unroll
    for (int i = 0; i < 8; ++i) { const int kk = 8 * i + (lane >> 3); v[i] = *(const f32x4*)(W + (size_t)(k0 + kk) * N + n0 + (lane & 7) * 4); }
    if (kscale) {
#pragma unroll
        for (int i = 0; i < 8; ++i) { const int kk = 8 * i + (lane >> 3); v[i] = v[i] * kscale[k0 + kk]; }
    }
#pragma unroll
    for (int i = 0; i < 8; ++i) { const int kk = 8 * i + (lane >> 3); LAS float* d = scr + kk * 33 + (lane & 7) * 4; d[0] = v[i].x; d[1] = v[i].y; d[2] = v[i].z; d[3] = v[i].w; }
    LDS_WAIT(); asm volatile("" ::: "memory");
    const int c = lane & 7;
#pragma unroll
    for (int j = 0; j < 4; ++j) { const int n = (lane >> 3) + 8 * j; const LAS float* s = scr + (8 * c) * 33 + n;
        u32x4 o; o.x = cvt_pk_bf16(s[0 * 33], s[1 * 33]); o.y = cvt_pk_bf16(s[2 * 33], s[3 * 33]); o.z = cvt_pk_bf16(s[4 * 33], s[5 * 33]); o.w = cvt_pk_bf16(s[6 * 33], s[7 * 33]);
        *(u32x4*)(WT + (size_t)(row_off + rowmap<MODE>(n0 + n)) * K + k0 + 8 * c) = o; }
    LDS_WAIT(); asm volatile("" ::: "memory");
}
template <int MODE>
__device__ __forceinline__ void absmax_item(const float* __restrict__ W, int N, unsigned* cmax, int item, int lane) {
    const int nblk = N / 32, kb = item / nblk, nb = item % nblk, k0 = 256 * kb, n0 = 32 * nb;
    f32x4 m = {0.f, 0.f, 0.f, 0.f};
#pragma unroll 16
    for (int i = 0; i < 32; ++i) { const int kk = 8 * i + (lane >> 3); const f32x4 v = *(const f32x4*)(W + (size_t)(k0 + kk) * N + n0 + (lane & 7) * 4);
        m.x = fmaxf(m.x, fabsf(v.x)); m.y = fmaxf(m.y, fabsf(v.y)); m.z = fmaxf(m.z, fabsf(v.z)); m.w = fmaxf(m.w, fabsf(v.w)); }
#pragma unroll
    for (int o = 8; o < 64; o <<= 1) { m.x = fmaxf(m.x, __shfl_xor(m.x, o)); m.y = fmaxf(m.y, __shfl_xor(m.y, o)); m.z = fmaxf(m.z, __shfl_xor(m.z, o)); m.w = fmaxf(m.w, __shfl_xor(m.w, o)); }
    if (lane < 8) {
#pragma unroll
        for (int i = 0; i < 4; ++i) __hip_atomic_fetch_max(cmax + rowmap<MODE>(n0 + lane * 4 + i), __float_as_uint(m[i]), RLX_AGENT); }
}
__device__ __forceinline__ float inv127() { float k = 1.0f / 127.0f; asm volatile("" : "+v"(k)); return k; }
__device__ __forceinline__ float clamp127(float v) { return fminf(fmaxf(v, -127.0f), 127.0f); }
__device__ __forceinline__ unsigned pack_u8x4(float a, float b, float c, float d) {
    const unsigned ia = (unsigned)rintf(a), ib = (unsigned)rintf(b), ic = (unsigned)rintf(c), id = (unsigned)rintf(d);
    return ia | (ib << 8) | (ic << 16) | (id << 24);
}
__device__ __forceinline__ unsigned pack_i8x4(float a, float b, float c, float d) {
    const int ia = (int)rintf(clamp127(a)), ib = (int)rintf(clamp127(b)), ic = (int)rintf(clamp127(c)), id = (int)rintf(clamp127(d));
    return (unsigned)(ia & 255) | ((unsigned)(ib & 255) << 8) | ((unsigned)(ic & 255) << 16) | ((unsigned)(id & 255) << 24);
}
template <int MODE>
__device__ __forceinline__ void tr_item_i8(const float* __restrict__ W, int N, int K, signed char* __restrict__ WT, int row_off, const unsigned* cmax, LAS float* scr, int item, int lane) {
    const int nblk = N / 32, kb = item / nblk, nb = item % nblk, k0 = 64 * kb, n0 = 32 * nb;
    f32x4 v[8];
#pragma unroll
    for (int i = 0; i < 8; ++i) { const int kk = 8 * i + (lane >> 3); v[i] = *(const f32x4*)(W + (size_t)(k0 + kk) * N + n0 + (lane & 7) * 4); }
#pragma unroll
    for (int i = 0; i < 8; ++i) { const int kk = 8 * i + (lane >> 3); LAS float* d = scr + kk * 33 + (lane & 7) * 4; d[0] = v[i].x; d[1] = v[i].y; d[2] = v[i].z; d[3] = v[i].w; }
    LDS_WAIT(); asm volatile("" ::: "memory");
    const int c = lane & 3;
#pragma unroll
    for (int j = 0; j < 2; ++j) { const int n = (lane >> 2) + 16 * j; const int row = row_off + rowmap<MODE>(n0 + n);
        const float cm = __uint_as_float(cmax[row]); const float inv = cm > 0.f ? 127.0f / cm : 0.f; const LAS float* sp = scr + (16 * c) * 33 + n;
        u32x4 o;
#pragma unroll
        for (int q = 0; q < 4; ++q) o[q] = pack_i8x4(sp[(4 * q) * 33] * inv, sp[(4 * q + 1) * 33] * inv, sp[(4 * q + 2) * 33] * inv, sp[(4 * q + 3) * 33] * inv);
        *(u32x4*)(WT + (size_t)row * K + k0 + 16 * c) = o; }
    LDS_WAIT(); asm volatile("" ::: "memory");
}
__device__ __forceinline__ void tr_load(const float* __restrict__ W, int N, int item, int lane, f32x4 (&v)[8]) {
    const int nblk = N / 32, kb = item / nblk, nb = item % nblk, k0 = 64 * kb, n0 = 32 * nb;
#pragma unroll
    for (int i = 0; i < 8; ++i) { const int kk = 8 * i + (lane >> 3); v[i] = *(const f32x4*)(W + (size_t)(k0 + kk) * N + n0 + (lane & 7) * 4); }
}
template <int MODE>
__device__ __forceinline__ void tr_store_bf16(const f32x4 (&v)[8], int N, int K, bf16_t* __restrict__ WT, int row_off, LAS float* scr, int item, int lane) {
    const int nblk = N / 32, kb = item / nblk, nb = item % nblk, k0 = 64 * kb, n0 = 32 * nb;
#pragma unroll
    for (int i = 0; i < 8; ++i) { const int kk = 8 * i + (lane >> 3); LAS float* d = scr + kk * 33 + (lane & 7) * 4; d[0] = v[i].x; d[1] = v[i].y; d[2] = v[i].z; d[3] = v[i].w; }
    LDS_WAIT(); asm volatile("" ::: "memory");
    const int c = lane & 7;
#pragma unroll
    for (int j = 0; j < 4; ++j) { const int n = (lane >> 3) + 8 * j; const LAS float* s = scr + (8 * c) * 33 + n;
        u32x4 o; o.x = cvt_pk_bf16(s[0 * 33], s[1 * 33]); o.y = cvt_pk_bf16(s[2 * 33], s[3 * 33]); o.z = cvt_pk_bf16(s[4 * 33], s[5 * 33]); o.w = cvt_pk_bf16(s[6 * 33], s[7 * 33]);
        *(u32x4*)(WT + (size_t)(row_off + rowmap<MODE>(n0 + n)) * K + k0 + 8 * c) = o; }
    LDS_WAIT(); asm volatile("" ::: "memory");
}
template <int MODE>
__device__ __forceinline__ void tr_store_i8(const f32x4 (&v)[8], int N, int K, signed char* __restrict__ WT, int row_off, const unsigned* cmax, LAS float* scr, int item, int lane) {
    const int nblk = N / 32, kb = item / nblk, nb = item % nblk, k0 = 64 * kb, n0 = 32 * nb;
#pragma unroll
    for (int i = 0; i < 8; ++i) { const int kk = 8 * i + (lane >> 3); LAS float* d = scr + kk * 33 + (lane & 7) * 4; d[0] = v[i].x; d[1] = v[i].y; d[2] = v[i].z; d[3] = v[i].w; }
    LDS_WAIT(); asm volatile("" ::: "memory");
    const int c = lane & 3;
#pragma unroll
    for (int j = 0; j < 2; ++j) { const int n = (lane >> 2) + 16 * j; const int row = row_off + rowmap<MODE>(n0 + n);
        const float cm = __uint_as_float(cmax[row]); const float inv = cm > 0.f ? 127.0f / cm : 0.f; const LAS float* sp = scr + (16 * c) * 33 + n;
        u32x4 o;
#pragma unroll
        for (int q = 0; q < 4; ++q) o[q] = pack_i8x4(sp[(4 * q) * 33] * inv, sp[(4 * q + 1) * 33] * inv, sp[(4 * q + 2) * 33] * inv, sp[(4 * q + 3) * 33] * inv);
        *(u32x4*)(WT + (size_t)row * K + k0 + 16 * c) = o; }
    LDS_WAIT(); asm volatile("" ::: "memory");
}
__device__ __forceinline__ void sincos_d(double a, float& s, float& c) {
    const double twopi = 6.283185307179586476925286766559;
    const double r = a - twopi * rint(a / twopi), r2 = r * r;
    double ts = 1.0, tc = 1.0;
#pragma unroll
    for (int k = 16; k >= 1; --k) { ts = 1.0 - ts * r2 / (double)((2 * k) * (2 * k + 1)); tc = 1.0 - tc * r2 / (double)((2 * k - 1) * (2 * k)); }
    s = (float)(r * ts); c = (float)tc;
}

__device__ __forceinline__ float clamp448(float v) {
    float t; asm("v_min_f32 %0, |%1|, %2" : "=v"(t) : "v"(v), "s"(448.0f)); float r; asm("v_bfi_b32 %0, %1, %2, %3" : "=v"(r) : "s"(0x7fffffff), "v"(t), "v"(v)); return r; }
__device__ __forceinline__ unsigned pack_f8x4(float a, float b, float c, float d) {
    a = clamp448(a); b = clamp448(b); c = clamp448(c); d = clamp448(d);
    unsigned w = 0; w = __builtin_amdgcn_cvt_pk_fp8_f32(a, b, w, false); w = __builtin_amdgcn_cvt_pk_fp8_f32(c, d, w, true); return w;
}
template <int KROWS>
__device__ __forceinline__ void w_block_f8(const float* __restrict__ W, const float* __restrict__ W2, int N, int n0, unsigned char* __restrict__ WT8, int dstride, int koff, float* invs, LAS unsigned char* lds, int wave, int lane) {
    constexpr int TSB = 4104, RPW = KROWS / 8;
    LAS float* wm = (LAS float*)(lds + 32 * TSB);
    const int c4 = (lane & 7) * 4;
    float m0 = 0.f, m1 = 0.f, m2 = 0.f, m3 = 0.f;
#pragma unroll 1
    for (int bt = 0; bt < RPW / 64; ++bt) {
        f32x4 v[8];
#pragma unroll
        for (int i = 0; i < 8; ++i) { const int kk = wave * RPW + bt * 64 + i * 8 + (lane >> 3); v[i] = *(const f32x4*)((kk < KROWS / 2 ? W : W2 - (size_t)(KROWS / 2) * N) + (size_t)kk * N + n0 + c4); }
#pragma unroll
        for (int i = 0; i < 8; ++i) { const int kk = wave * RPW + bt * 64 + i * 8 + (lane >> 3);
            m0 = fmaxf(m0, fabsf(v[i].x)); m1 = fmaxf(m1, fabsf(v[i].y)); m2 = fmaxf(m2, fabsf(v[i].z)); m3 = fmaxf(m3, fabsf(v[i].w));
            const unsigned p01 = cvt_pk_bf16(v[i].x, v[i].y), p23 = cvt_pk_bf16(v[i].z, v[i].w);
            *(LAS bf16_t*)(lds + (c4 + 0) * TSB + kk * 2) = (bf16_t)(p01 & 0xffffu); *(LAS bf16_t*)(lds + (c4 + 1) * TSB + kk * 2) = (bf16_t)(p01 >> 16);
            *(LAS bf16_t*)(lds + (c4 + 2) * TSB + kk * 2) = (bf16_t)(p23 & 0xffffu); *(LAS bf16_t*)(lds + (c4 + 3) * TSB + kk * 2) = (bf16_t)(p23 >> 16); }
    }
#pragma unroll
    for (int o = 8; o < 64; o <<= 1) { m0 = fmaxf(m0, __shfl_xor(m0, o)); m1 = fmaxf(m1, __shfl_xor(m1, o)); m2 = fmaxf(m2, __shfl_xor(m2, o)); m3 = fmaxf(m3, __shfl_xor(m3, o)); }
    if (lane < 8) { wm[wave * 32 + c4] = m0; wm[wave * 32 + c4 + 1] = m1; wm[wave * 32 + c4 + 2] = m2; wm[wave * 32 + c4 + 3] = m3; }
    __syncthreads();
#pragma unroll 1
    for (int r = 0; r < 4; ++r) { const int n = wave * 4 + r; float cm = wm[n];
#pragma unroll
        for (int w = 1; w < 8; ++w) cm = fmaxf(cm, wm[w * 32 + n]);
        const float sc = cm > 0.f ? exp2f(floorf(log2f(224.0f / cm))) : 1.0f;
        if (lane == 0) invs[n0 + n] = 1.0f / sc;
#pragma unroll
        for (int j = 0; j < KROWS / 256; ++j) { const int ch = j * 64 + lane; const u32x2 w = *(const LAS u32x2*)(lds + n * TSB + ch * 8);
            *(unsigned*)(WT8 + (size_t)(n0 + n) * dstride + koff + ch * 4) = pack_f8x4(bflo(w.x) * sc, bfhi(w.x) * sc, bflo(w.y) * sc, bfhi(w.y) * sc); } }
    __syncthreads();
}
struct Ptrs {
    const float *x, *c, *ctx, *c_ctx, *w_mod, *b_mod, *norm_mix, *norm_ffn, *w_in, *a_q_norm, *a_k_norm, *b_kv_norm, *w_ukv, *w_br_a, *w_br_b, *w_out,
                *w_group, *b_group, *w_router, *b_router, *w_e_gate, *w_e_up, *w_e_down, *norm_final;
    float* out; unsigned char* ws;
};

__device__ __forceinline__ void p0_prologue(const Ptrs& P, LAS unsigned char* lds, int G, int blk, int gw, int NGW, int wave, int lane) {
    LAS float* scr = (LAS float*)(lds + wave * 16384);
    unsigned char* ws = P.ws;
    bf16_t* WIN = (bf16_t*)(ws + WS_WIN); bf16_t* WUKV = (bf16_t*)(ws + WS_WUKV);
    constexpr int I_GEMV = 48 * 32, I_ROPE = 64, I_ZERO = 192;
    constexpr int I_IN = (DM / 256) * (DIN / 32), I_UKV = (512 / 64) * (2048 / 32), I_BR = (1024 / 64) * (2048 / 32), I_OUT = (2048 / 256) * (2048 / 32);
    constexpr int NITEMS = I_GEMV + I_ROPE + I_ZERO + I_IN + I_UKV;
    for (int it = blk; it < 128; it += G) {
        if (it < 64) w_block_f8<2048>(P.w_br_a, P.w_br_b, 2048, it * 32, ws + WS_WBRA, 2048, 0, (float*)(ws + WS_SAO), lds, wave, lane);
        else w_block_f8<2048>(P.w_out, P.w_out + (size_t)1024 * 2048, 2048, (it - 64) * 32, ws + WS_WOUT, 2048, 0, (float*)(ws + WS_SAO) + 2048, lds, wave, lane); }
    for (int it = gw; it < NITEMS; it += NGW) {
        int r = it;
        if (r < I_GEMV) {
            const int nc = r % 48, kc = r / 48, n = nc * 256 + lane * 4, k0 = kc * 64;
            float sv[5];
#pragma unroll
            for (int q = 0; q < 5; ++q) { const float cv = (q < 4) ? P.c[q * DM + k0 + lane] : P.c_ctx[k0 + lane]; sv[q] = cv * sigmoidf_(cv); }
            f32x4 a[5];
#pragma unroll
            for (int q = 0; q < 5; ++q) a[q] = (f32x4){0.f, 0.f, 0.f, 0.f};
#pragma unroll 16
            for (int kk = 0; kk < 64; ++kk) { const f32x4 w = *(const f32x4*)(P.w_mod + (size_t)(k0 + kk) * NMOD + n);
#pragma unroll
                for (int q = 0; q < 5; ++q) { const float s = __uint_as_float(__builtin_amdgcn_readlane(__float_as_uint(sv[q]), kk)); a[q] += w * s; } }
            float* MP = (float*)(ws + WS_MODP);
#pragma unroll
            for (int q = 0; q < 5; ++q) *(f32x4*)(MP + (size_t)(kc * 5 + q) * NMOD + n) = a[q];
            continue;
        } r -= I_GEMV;
        if (r < I_ROPE) {
            if (lane < 32) { const float fr = powf(10000.0f, -(float)lane / 32.0f); const float ang = (float)r * fr; float s, c; sincos_d((double)ang, s, c);
                ((f32x2*)(ws + WS_ROPEA))[r * 32 + lane] = (f32x2){c, s}; }
            if (lane < 16) { const float fr = powf(10000.0f, -(float)lane / 16.0f); const float ang = (float)r * fr; float s, c; sincos_d((double)ang, s, c);
                ((f32x2*)(ws + WS_ROPEB))[r * 16 + lane] = (f32x2){c, s}; }
            continue;
        } r -= I_ROPE;
        if (r < I_ZERO) {
            u32x4* p = (u32x4*)((signed char*)WIN + (size_t)(3648 + r) * DM);
#pragma unroll
            for (int j = 0; j < 2; ++j) p[j * 64 + lane] = (u32x4){0u, 0u, 0u, 0u};
            continue;
        } r -= I_ZERO;
        if (r < I_IN) { absmax_item<1>(P.w_in, DIN, (unsigned*)(ws + WS_CTL) + CW_CMAX_IN, r, lane); continue; } r -= I_IN;
        if (r < I_UKV) { tr_item<0>(P.w_ukv, 2048, 512, WUKV, 0, P.b_kv_norm, scr, r, lane); continue; } r -= I_UKV;

        absmax_item<0>(P.w_out, 2048, (unsigned*)(ws + WS_CTL) + CW_CMAX_OUT, r, lane);
    }
}
template <int MODE>
__device__ __forceinline__ void gu_block_i8(const float* __restrict__ W, int n0, signed char* __restrict__ WT8, int row_off, unsigned* cmax, LAS unsigned char* lds, int wave, int lane) {
    constexpr int TSB = 4104;
    LAS float* wm = (LAS float*)(lds + 32 * TSB);
    const int c4 = (lane & 7) * 4;
    float m0 = 0.f, m1 = 0.f, m2 = 0.f, m3 = 0.f;
#pragma unroll 1
    for (int bt = 0; bt < 4; ++bt) {
        f32x4 v[8];
#pragma unroll
        for (int i = 0; i < 8; ++i) { const int kk = wave * 256 + bt * 64 + i * 8 + (lane >> 3); v[i] = *(const f32x4*)(W + (size_t)kk * 1024 + n0 + c4); }
#pragma unroll
        for (int i = 0; i < 8; ++i) { const int kk = wave * 256 + bt * 64 + i * 8 + (lane >> 3);
            m0 = fmaxf(m0, fabsf(v[i].x)); m1 = fmaxf(m1, fabsf(v[i].y)); m2 = fmaxf(m2, fabsf(v[i].z)); m3 = fmaxf(m3, fabsf(v[i].w));
            const unsigned p01 = cvt_pk_bf16(v[i].x, v[i].y), p23 = cvt_pk_bf16(v[i].z, v[i].w);
            *(LAS bf16_t*)(lds + (c4 + 0) * TSB + kk * 2) = (bf16_t)(p01 & 0xffffu); *(LAS bf16_t*)(lds + (c4 + 1) * TSB + kk * 2) = (bf16_t)(p01 >> 16);
            *(LAS bf16_t*)(lds + (c4 + 2) * TSB + kk * 2) = (bf16_t)(p23 & 0xffffu); *(LAS bf16_t*)(lds + (c4 + 3) * TSB + kk * 2) = (bf16_t)(p23 >> 16); }
    }
#pragma unroll
    for (int o = 8; o < 64; o <<= 1) { m0 = fmaxf(m0, __shfl_xor(m0, o)); m1 = fmaxf(m1, __shfl_xor(m1, o)); m2 = fmaxf(m2, __shfl_xor(m2, o)); m3 = fmaxf(m3, __shfl_xor(m3, o)); }
    if (lane < 8) { wm[wave * 32 + c4] = m0; wm[wave * 32 + c4 + 1] = m1; wm[wave * 32 + c4 + 2] = m2; wm[wave * 32 + c4 + 3] = m3; }
    __syncthreads();
#pragma unroll 1
    for (int r = 0; r < 4; ++r) { const int n = wave * 4 + r; float cm = wm[n];
#pragma unroll
        for (int w = 1; w < 8; ++w) cm = fmaxf(cm, wm[w * 32 + n]);
        const int row = row_off + rowmap<MODE>(n0 + n); if (lane == 0) cmax[row] = __float_as_uint(cm);
        const float inv = cm > 0.f ? 127.0f / cm : 0.f;
#pragma unroll
        for (int j = 0; j < 8; ++j) { const int ch = j * 64 + lane; const u32x2 w = *(const LAS u32x2*)(lds + n * TSB + ch * 8);
            *(unsigned*)(WT8 + (size_t)row * 2048 + ch * 4) = pack_i8x4(bflo(w.x) * inv, bfhi(w.x) * inv, bflo(w.y) * inv, bfhi(w.y) * inv); } }
    __syncthreads();
}
__device__ __forceinline__ void p6_expert_copies(const Ptrs& P, LAS unsigned char* lds, int G, int blk, int wave, int lane) {
    for (int it = blk; it < NEXP * 64; it += G) { const int e = it >> 6, nb = it & 63; const float* W = P.w_e_down + (size_t)e * 1024 * 2048;
        w_block_f8<1024>(W, W + (size_t)512 * 2048, 2048, nb * 32, P.ws + WS_WD + (size_t)e * 2048 * 1024, 1024, 0, (float*)(P.ws + WS_INVD) + e * 2048, lds, wave, lane); }
}
__device__ __forceinline__ void p3_expert_gateup(const Ptrs& P, LAS unsigned char* lds, int G, int blk, int wave, int lane) {
    signed char* WG8 = (signed char*)(P.ws + WS_WG); unsigned* cm = (unsigned*)(P.ws + WS_CTL) + CW_CMAX_WG;
    for (int it = blk; it < NEXP * 2 * 32; it += G) { const int e = it >> 6, up = (it >> 5) & 1, nb = it & 31;
        if (!up) gu_block_i8<2>(P.w_e_gate + (size_t)e * 2048 * 1024, nb * 32, WG8, e * 2048, cm, lds, wave, lane);
        else     gu_block_i8<3>(P.w_e_up + (size_t)e * 2048 * 1024, nb * 32, WG8, e * 2048, cm, lds, wave, lane); }
}
__device__ __forceinline__ void p1_win_i8(const Ptrs& P, LAS unsigned char* lds, int gw, int NGW, int wave, int lane) {
    LAS float* scr = (LAS float*)(lds + wave * 16384);
    constexpr int J_IN = (DM / 64) * (DIN / 32), TOT = J_IN;
    const unsigned* ctl = (const unsigned*)(P.ws + WS_CTL);
#define P1_DECODE(it_, kind_, W_, N_, r_) do { int r0_ = (it_); \
        if (r0_ < J_IN) { kind_ = 0; W_ = P.w_in; N_ = DIN; r_ = r0_; } \
        else { kind_ = 0; W_ = P.w_in; N_ = DIN; r_ = 0; } } while (0)
    f32x4 vn[8]; int kind, N, r; const float* W;
    if (gw < TOT) { P1_DECODE(gw, kind, W, N, r); tr_load(W, N, r, lane, vn); }
#pragma unroll 1
    for (int it = gw; it < TOT; it += NGW) {
        f32x4 vc[8];
#pragma unroll
        for (int i = 0; i < 8; ++i) vc[i] = vn[i];
        const int ckind = kind, cr = r;
        if (it + NGW < TOT) { P1_DECODE(it + NGW, kind, W, N, r); tr_load(W, N, r, lane, vn); }
        if (ckind == 0) tr_store_i8<1>(vc, DIN, DM, (signed char*)(P.ws + WS_WIN), 0, ctl + CW_CMAX_IN, scr, cr, lane);
    }
#undef P1_DECODE
}
template <int C>
__device__ __forceinline__ void requant_rows(const bf16_t* __restrict__ src, signed char* __restrict__ dst, float* __restrict__ sc, int R, int gw, int NGW, int lane) {
    constexpr int NV = C / 512;
    for (int row = gw; row < R; row += NGW) {
        u32x4 w[NV]; float am = 0.f;
#pragma unroll
        for (int j = 0; j < NV; ++j) { w[j] = *(const u32x4*)(src + (size_t)row * C + (j * 64 + lane) * 8);
#pragma unroll
            for (int i = 0; i < 4; ++i) am = fmaxf(am, fmaxf(fabsf(bflo(w[j][i])), fabsf(bfhi(w[j][i])))); }
#pragma unroll
        for (int o = 1; o < 64; o <<= 1) am = fmaxf(am, __shfl_xor(am, o));
        const float inv = am > 0.f ? 127.0f / am : 0.f;
        if (lane == 0) sc[row] = am * (1.0f / 127.0f);
#pragma unroll
        for (int j = 0; j < NV; ++j) { u32x2 o;
            o.x = pack_i8x4(bflo(w[j].x) * inv, bfhi(w[j].x) * inv, bflo(w[j].y) * inv, bfhi(w[j].y) * inv);
            o.y = pack_i8x4(bflo(w[j].z) * inv, bfhi(w[j].z) * inv, bflo(w[j].w) * inv, bfhi(w[j].w) * inv);
            *(u32x2*)(dst + (size_t)row * C + (j * 64 + lane) * 8) = o; }
    }
}
__device__ __forceinline__ void p1_modreduce(const Ptrs& P, int gtid, int NGT) {
    const float* MP = (const float*)(P.ws + WS_MODP); float* MOD = (float*)(P.ws + WS_MOD);
    for (int idx = gtid; idx < 5 * NMOD; idx += NGT) { const int q = idx / NMOD, n = idx % NMOD; float s = P.b_mod[n];
#pragma unroll 8
        for (int kc = 0; kc < 32; ++kc) s += MP[(size_t)(kc * 5 + q) * NMOD + n];
        MOD[idx] = s; }
}
__device__ __forceinline__ void p2_hx(const Ptrs& P, int gw, int NGW, int lane) {
    const float* MOD = (const float*)(P.ws + WS_MOD); signed char* HX8 = (signed char*)(P.ws + WS_R1);
    for (int t = gw; t < 80; t += NGW) {
        const int b = t / 20, j = t % 20; const float* sh2 = MOD + (size_t)b * NMOD + 3 * DM; float a = 0.f;
        for (int i = 0; i < 32; ++i) { const int k = i * 64 + lane; const float w = (j < 4) ? P.w_group[(size_t)k * 4 + j] : P.w_router[((size_t)((j - 4) >> 2) * DM + k) * 4 + ((j - 4) & 3)]; a += sh2[k] * w; }
        a = wave_sum(a);
        if (lane == 0) ((float*)(P.ws + WS_BIASR))[t] = a + ((j < 4) ? P.b_group[j] : P.b_router[j - 4]);
    }
#define P2_SRC(kr_) (((kr_) % KEYS) < CTXL ? P.ctx + ((size_t)((kr_) / KEYS) * CTXL + ((kr_) % KEYS)) * DM : P.x + ((size_t)((kr_) / KEYS) * SEQ + (((kr_) % KEYS) - CTXL)) * DM)
    f32x4 vn[8];
    if (gw < NKEY) { const float* s0 = P2_SRC(gw);
#pragma unroll
        for (int j = 0; j < 8; ++j) vn[j] = *(const f32x4*)(s0 + j * 256 + lane * 4); }
#pragma unroll 1
    for (int kr = gw; kr < NKEY; kr += NGW) {
        const int b = kr / KEYS, t = kr % KEYS; const bool isctx = t < CTXL;
        const float* md = MOD + (size_t)(isctx ? 4 : b) * NMOD;
        f32x4 v[8]; float ss = 0.f;
#pragma unroll
        for (int j = 0; j < 8; ++j) v[j] = vn[j];
        if (kr + NGW < NKEY) { const float* s1 = P2_SRC(kr + NGW);
#pragma unroll
            for (int j = 0; j < 8; ++j) vn[j] = *(const f32x4*)(s1 + j * 256 + lane * 4); }
#pragma unroll
        for (int j = 0; j < 8; ++j) ss += (v[j].x * v[j].x + v[j].y * v[j].y) + (v[j].z * v[j].z + v[j].w * v[j].w);
        const float rstd = rsqrtf(wave_sum(ss) * (1.0f / DM) + EPS);
        float am = 0.f;
#pragma unroll
        for (int j = 0; j < 8; ++j) { const int col = j * 256 + lane * 4;
            const f32x4 g = *(const f32x4*)(P.norm_mix + col), sh = *(const f32x4*)(md + col), sc = *(const f32x4*)(md + DM + col);
            v[j] = (v[j] * rstd) * g * (sc + 1.0f) + sh;
            am = fmaxf(fmaxf(am, fmaxf(fabsf(v[j].x), fabsf(v[j].y))), fmaxf(fabsf(v[j].z), fabsf(v[j].w))); }
#pragma unroll
        for (int o = 1; o < 64; o <<= 1) am = fmaxf(am, __shfl_xor(am, o));
        const float inv = am > 0.f ? 127.0f / am : 0.f;
        if (lane == 0) ((float*)(P.ws + WS_SAHX))[kr] = am * (1.0f / 127.0f);
#pragma unroll
        for (int j = 0; j < 8; ++j) *(unsigned*)(HX8 + (size_t)kr * DM + j * 256 + lane * 4) = pack_i8x4(v[j].x * inv, v[j].y * inv, v[j].z * inv, v[j].w * inv);
    }
}
__device__ __forceinline__ unsigned rope_pair(float x1, float x2, f32x2 cs) { return cvt_pk_bf16(x1 * cs.x - x2 * cs.y, x1 * cs.y + x2 * cs.x); }
struct PostRow { u32x2 wk; unsigned wr; u32x4 q0, q1, qb; };
__device__ __forceinline__ void p4_load(const Ptrs& P, int kr, int lane, PostRow& R) {
    unsigned char* r2 = P.ws + WS_R2;
    const bf16_t* QA = (const bf16_t*)(r2 + R2_QA); const bf16_t* KA = (const bf16_t*)(r2 + R2_KA); const bf16_t* QB = (const bf16_t*)(r2 + R2_QB); const bf16_t* KR = (const bf16_t*)(r2 + R2_KR);
    const int b = kr / KEYS, t = kr % KEYS; const bool lat = t >= CTXL; const int s = t - CTXL; const size_t lr = (size_t)b * SEQ + s;
    R.wk = *(const u32x2*)(KA + (size_t)kr * 256 + lane * 4);
    if (lat) {
        R.wr = *(const unsigned*)(KR + (size_t)kr * 64 + (lane & 31) * 2);
        const bf16_t* q = QA + lr * 1024 + lane * 16; R.q0 = *(const u32x4*)q; R.q1 = *(const u32x4*)(q + 8);
        R.qb = *(const u32x4*)(QB + lr * 1536 + (lane >> 3) * 192 + 128 + (lane & 7) * 8);
    }
}
__device__ __forceinline__ void p4_post(const Ptrs& P, int row_lo, int row_hi, int wave, int lane) {
    unsigned char* r2 = P.ws + WS_R2;
    bf16_t* QA = (bf16_t*)(r2 + R2_QA); bf16_t* KA = (bf16_t*)(r2 + R2_KA); bf16_t* QB = (bf16_t*)(r2 + R2_QB); bf16_t* KR = (bf16_t*)(r2 + R2_KR);
    const f32x2* TA = (const f32x2*)(P.ws + WS_ROPEA); const f32x2* TB = (const f32x2*)(P.ws + WS_ROPEB);
    PostRow cur, nxt;
    if (row_lo + wave < row_hi) p4_load(P, row_lo + wave, lane, cur);
#pragma unroll 1
    for (int kr = row_lo + wave; kr < row_hi; kr += NWAVES) {
        if (kr + NWAVES < row_hi) p4_load(P, kr + NWAVES, lane, nxt);
        __builtin_amdgcn_sched_barrier(0);
        const int b = kr / KEYS, t = kr % KEYS; const bool lat = t >= CTXL; const int s = t - CTXL, prow = s >> 6, pcol = s & 63; const size_t lr = (size_t)b * SEQ + s;
        {
            u32x2 w = cur.wk;
            float e0 = bflo(w.x), e1 = bfhi(w.x), e2 = bflo(w.y), e3 = bfhi(w.y);
            float ss = (e0 * e0 + e1 * e1) + (e2 * e2 + e3 * e3);
#pragma unroll
            for (int o = 1; o < 32; o <<= 1) ss += __shfl_xor(ss, o);
            const float rstd = rsqrtf(ss * (1.0f / 128.0f) + EPS);
            const int p0 = ((lane * 4) & 127) >> 1;
            e0 *= rstd * P.a_k_norm[p0]; e1 *= rstd * P.a_k_norm[64 + p0]; e2 *= rstd * P.a_k_norm[p0 + 1]; e3 *= rstd * P.a_k_norm[65 + p0];
            if (lat) { const f32x2 c0 = (p0 < 32) ? TA[prow * 32 + p0] : TA[pcol * 32 + p0 - 32], c1 = (p0 + 1 < 32) ? TA[prow * 32 + p0 + 1] : TA[pcol * 32 + p0 + 1 - 32];
                w.x = rope_pair(e0, e1, c0); w.y = rope_pair(e2, e3, c1); }
            else { w.x = cvt_pk_bf16(e0, e1); w.y = cvt_pk_bf16(e2, e3); }
            *(u32x2*)(KA + (size_t)kr * 256 + lane * 4) = w;
        }
        if (lat) {
            if (lane < 32) {
                const unsigned w = cur.wr;
                const f32x2 cs = (lane < 16) ? TB[prow * 16 + lane] : TB[pcol * 16 + lane - 16];
                *(unsigned*)(KR + (size_t)kr * 64 + lane * 2) = rope_pair(bflo(w), bfhi(w), cs);
            }
            {
                bf16_t* q = QA + lr * 1024 + lane * 16;
                const u32x4 w0 = cur.q0, w1 = cur.q1;
                float x1[8], x2[8]; float ss = 0.f;
#pragma unroll
                for (int i = 0; i < 4; ++i) { x1[i] = bflo(w0[i]); x2[i] = bfhi(w0[i]); x1[4 + i] = bflo(w1[i]); x2[4 + i] = bfhi(w1[i]); }
#pragma unroll
                for (int i = 0; i < 8; ++i) ss += x1[i] * x1[i] + x2[i] * x2[i];
                ss += __shfl_xor(ss, 1); ss += __shfl_xor(ss, 2); ss += __shfl_xor(ss, 4);
                const float rstd = rsqrtf(ss * (1.0f / 128.0f) + EPS) * (0.08838834764831845f * 1.4426950408889634f);
                const int p0 = ((lane * 16) & 127) >> 1;
                const f32x2* tb = (p0 < 32) ? TA + prow * 32 + p0 : TA + pcol * 32 + p0 - 32;
                unsigned o[8];
#pragma unroll
                for (int i = 0; i < 8; ++i) o[i] = rope_pair(x1[i] * rstd * P.a_q_norm[p0 + i], x2[i] * rstd * P.a_q_norm[64 + p0 + i], tb[i]);
                *(u32x4*)q = (u32x4){o[0], o[1], o[2], o[3]}; *(u32x4*)(q + 8) = (u32x4){o[4], o[5], o[6], o[7]};
            }
            {
                bf16_t* q = QB + lr * 1536 + (lane >> 3) * 192 + 128 + (lane & 7) * 8;
                const u32x4 w = cur.qb; const int p0 = (lane & 7) * 4;
                const f32x2* tb = (p0 < 16) ? TB + prow * 16 + p0 : TB + pcol * 16 + p0 - 16;
                u32x4 o;
#pragma unroll
                for (int i = 0; i < 4; ++i) o[i] = rope_pair(bflo(w[i]), bfhi(w[i]), tb[i]);
                *(u32x4*)q = o;
            }
        }
        cur = nxt;
    }
}
__device__ __forceinline__ void p9_route(const Ptrs& P, LAS unsigned char* lds, int G, int blk, int tid, int wave, int lane, bool do_append) {
    const float* XN = (const float*)(P.ws + WS_R3); signed char* H28 = (signed char*)(P.ws + WS_R4); const float* MOD = (const float*)(P.ws + WS_MOD); const float* BIASR = (const float*)(P.ws + WS_BIASR);
    unsigned* LIST = (unsigned*)(P.ws + WS_LIST); float* WL = (float*)(P.ws + WS_WLIST); unsigned* ctl = (unsigned*)(P.ws + WS_CTL);
    LAS f32x4* W4 = (LAS f32x4*)lds;
    LAS unsigned char* ex = lds + RING_BYTES;
    LAS int* ent_e = (LAS int*)ex; LAS float* ent_w = (LAS float*)(ex + 512); LAS int* ent_p = (LAS int*)(ex + 1024); LAS int* lcnt = (LAS int*)(ex + 1536); LAS int* lbase = (LAS int*)(ex + 1600);
    LAS float* rinfo = (LAS float*)(ex + 2048) + wave * 32;
    for (int chunk = blk; chunk < NTOK / 64; chunk += G) {
        const int b = chunk / (SEQ / 64); const float* md = MOD + (size_t)b * NMOD; const float* br = BIASR + b * 20;
        unsigned lo = (unsigned)opaque_v(lane * 16);
        f32x4 gs[8];
#pragma unroll
        for (int j = 0; j < 8; ++j) gs[j] = *(const f32x4*)((const char*)P.norm_ffn + j * 1024 + lo) * (*(const f32x4*)((const char*)(md + 4 * DM) + j * 1024 + lo) + 1.0f);
        if (tid < 16) lcnt[tid] = 0;
        for (int k = tid; k < DM; k += NWAVES * 64) W4[(((k >> 8) * 4 + (k & 3)) << 6) + ((k >> 2) & 63)] = *(const f32x4*)(P.w_group + (size_t)k * 4);
        __syncthreads();
        f32x4 vn[8];
        { const char* s0 = (const char*)(XN + (size_t)(chunk * 64 + wave * 8) * DM);
#pragma unroll
          for (int j = 0; j < 8; ++j) vn[j] = *(const f32x4*)(s0 + j * 1024 + lo); }
#pragma unroll 1
        for (int rr = 0; rr < 8; ++rr) {
            const int tok = chunk * 64 + wave * 8 + rr; const char* src = (const char*)(XN + (size_t)(tok + (rr < 7 ? 1 : 0)) * DM); lo = (unsigned)opaque_v((int)lo);
            f32x4 acc = {0.f, 0.f, 0.f, 0.f}; float ss = 0.f; f32x4 vc[8];
#pragma unroll
            for (int j = 0; j < 8; ++j) vc[j] = vn[j];
#pragma unroll
            for (int j = 0; j < 8; ++j) vn[j] = *(const f32x4*)(src + j * 1024 + lo);
#pragma unroll
            for (int j = 0; j < 8; ++j) { const f32x4 v = vc[j]; ss += (v.x * v.x + v.y * v.y) + (v.z * v.z + v.w * v.w); const f32x4 u = v * gs[j];
#pragma unroll
                for (int i = 0; i < 4; ++i) acc += W4[((j * 4 + i) << 6) + lane] * u[i]; }
            ss = wave_sum(ss);
#pragma unroll
            for (int q = 0; q < 4; ++q) acc[q] = wave_sum(acc[q]);
            const float rstd = rsqrtf(ss * (1.0f / DM) + EPS);
            const f32x4 glv = acc * rstd + *(const f32x4*)br;
            int gi = 0; float gm = glv[0];
            if (glv[1] > gm) { gm = glv[1]; gi = 1; }
            if (glv[2] > gm) { gm = glv[2]; gi = 2; }
            if (glv[3] > gm) { gm = glv[3]; gi = 3; }
            const float gsum = (expf(glv[0] - gm) + expf(glv[1] - gm)) + (expf(glv[2] - gm) + expf(glv[3] - gm));
            if (lane == 0) { rinfo[rr * 4 + 0] = rstd; rinfo[rr * 4 + 1] = 1.0f / gsum; rinfo[rr * 4 + 2] = __int_as_float(gi); }
        }
        __syncthreads();
        for (int idx = tid; idx < 4 * DM; idx += NWAVES * 64) { const int k = idx & (DM - 1); W4[(idx & ~(DM - 1)) + (((k >> 8) * 4 + (k & 3)) << 6) + ((k >> 2) & 63)] = *(const f32x4*)(P.w_router + (size_t)idx * 4); }
        LAS f32x4* SHL = (LAS f32x4*)(lds + RING_BYTES + 4096);
        LAS f32x4* GSL = SHL + 512;
        SHL[tid] = *(const f32x4*)(md + 3 * DM + tid * 4);
        GSL[tid] = *(const f32x4*)(P.norm_ffn + tid * 4) * (*(const f32x4*)(md + 4 * DM + tid * 4) + 1.0f);
        __syncthreads();
        { const char* s0 = (const char*)(XN + (size_t)(chunk * 64 + wave * 8) * DM);
#pragma unroll
          for (int j = 0; j < 8; ++j) vn[j] = *(const f32x4*)(s0 + j * 1024 + lo); }
#pragma unroll 1
        for (int rr = 0; rr < 8; ++rr) {
            const int lrow = wave * 8 + rr, tok = chunk * 64 + lrow; const char* src = (const char*)(XN + (size_t)(tok + (rr < 7 ? 1 : 0)) * DM); lo = (unsigned)opaque_v((int)lo);
            const float rstd = rinfo[rr * 4 + 0], gval = rinfo[rr * 4 + 1]; const int gi = __builtin_amdgcn_readfirstlane(__float_as_int(rinfo[rr * 4 + 2]));
            const LAS f32x4* Wg = W4 + gi * DM;
            f32x4 acc = {0.f, 0.f, 0.f, 0.f}; u32x2 hv[8]; float am = 0.f;
            const LAS f32x4* shl = (const LAS f32x4*)(unsigned long)(unsigned)opaque_v(RING_BYTES + 4096 + lane * 16);
#pragma unroll
            for (int j = 0; j < 8; ++j) { const f32x4 v = vn[j]; const f32x4 u = v * shl[512 + j * 64];
                const f32x4 h = u * rstd + shl[j * 64]; hv[j].x = cvt_pk_bf16(h.x, h.y); hv[j].y = cvt_pk_bf16(h.z, h.w);
                am = fmaxf(fmaxf(am, fmaxf(fabsf(h.x), fabsf(h.y))), fmaxf(fabsf(h.z), fabsf(h.w)));
#pragma unroll
                for (int i = 0; i < 4; ++i) acc += Wg[((j * 4 + i) << 6) + lane] * u[i];
                __builtin_amdgcn_sched_barrier(0); }
#pragma unroll
            for (int j = 0; j < 8; ++j) vn[j] = *(const f32x4*)(src + j * 1024 + lo);
            __builtin_amdgcn_sched_barrier(0);
#pragma unroll
            for (int o = 1; o < 64; o <<= 1) am = fmaxf(am, __shfl_xor(am, o));
            { const float inv = am > 0.f ? 127.0f / am : 0.f;
              if (lane == 0) ((float*)(P.ws + WS_SAH2))[tok] = am * (1.0f / 127.0f);
#pragma unroll
              for (int j = 0; j < 8; ++j) *(unsigned*)((char*)(H28 + (size_t)tok * DM) + j * 256 + (lo >> 2)) = pack_i8x4(bflo(hv[j].x) * inv, bfhi(hv[j].x) * inv, bflo(hv[j].y) * inv, bfhi(hv[j].y) * inv); }
#pragma unroll
            for (int q = 0; q < 4; ++q) acc[q] = wave_sum(acc[q]);
            const f32x4 elv = acc * rstd + *(const f32x4*)(br + 4 + gi * 4);
            int e1 = 0; float m1 = elv[0];
            if (elv[1] > m1) { m1 = elv[1]; e1 = 1; }
            if (elv[2] > m1) { m1 = elv[2]; e1 = 2; }
            if (elv[3] > m1) { m1 = elv[3]; e1 = 3; }
            int e2 = (e1 + 1) & 3; float m2 = -3.0e38f;
            if (e1 != 0 && elv[0] > m2) { m2 = elv[0]; e2 = 0; }
            if (e1 != 1 && elv[1] > m2) { m2 = elv[1]; e2 = 1; }
            if (e1 != 2 && elv[2] > m2) { m2 = elv[2]; e2 = 2; }
            if (e1 != 3 && elv[3] > m2) { m2 = elv[3]; e2 = 3; }
            const float x2 = expf(m2 - m1), w1 = gval / (1.0f + x2), w2 = gval * x2 / (1.0f + x2);
            if (lane == 0) { ent_e[lrow * 2] = gi * 4 + e1; ent_w[lrow * 2] = w1; ent_e[lrow * 2 + 1] = gi * 4 + e2; ent_w[lrow * 2 + 1] = w2; }
        }
        __syncthreads();
        if (tid < 128) ent_p[tid] = __hip_atomic_fetch_add(lcnt + ent_e[tid], 1, __ATOMIC_RELAXED, __HIP_MEMORY_SCOPE_WORKGROUP);
        __syncthreads();
        if (tid < 16 && do_append) lbase[tid] = (int)__hip_atomic_fetch_add(ctl + CW_ECNT + 64 * tid, (unsigned)lcnt[tid], RLX_AGENT);
        __syncthreads();
        if (tid < 128 && do_append) { const int e = ent_e[tid], pos = lbase[e] + ent_p[tid]; const int tok = chunk * 64 + (tid >> 1);
            LIST[(size_t)e * NTOK + pos] = (unsigned)(tok * 2 + (tid & 1)); WL[(size_t)e * NTOK + pos] = ent_w[tid]; }
        __syncthreads();
    }
}
__device__ __forceinline__ void p12_final(const Ptrs& P, int gw, int NGW, int lane) {
    const float* XN = (const float*)(P.ws + WS_R3); const bf16_t* SL = (const bf16_t*)(P.ws + WS_R2); const float* MOD = (const float*)(P.ws + WS_MOD);
    for (int tok = gw; tok < NTOK; tok += NGW) {
        const int b = tok / SEQ; const float* md = MOD + (size_t)b * NMOD + 5 * DM;
        f32x4 v[8]; float ss = 0.f;
#pragma unroll
        for (int j = 0; j < 8; ++j) { const int col = j * 256 + lane * 4;
            const f32x4 xv = *(const f32x4*)(XN + (size_t)tok * DM + col), g2 = *(const f32x4*)(md + col);
            const u32x2 s0 = *(const u32x2*)(SL + (size_t)(2 * tok) * DM + col), s1 = *(const u32x2*)(SL + (size_t)(2 * tok + 1) * DM + col);
            f32x4 y; y.x = bflo(s0.x) + bflo(s1.x); y.y = bfhi(s0.x) + bfhi(s1.x); y.z = bflo(s0.y) + bflo(s1.y); y.w = bfhi(s0.y) + bfhi(s1.y);
            v[j] = xv + g2 * y; ss += (v[j].x * v[j].x + v[j].y * v[j].y) + (v[j].z * v[j].z + v[j].w * v[j].w); }
        const float rstd = rsqrtf(wave_sum(ss) * (1.0f / DM) + EPS);
#pragma unroll
        for (int j = 0; j < 8; ++j) { const int col = j * 256 + lane * 4; const f32x4 g = *(const f32x4*)(P.norm_final + col);
            *(f32x4*)(P.out + (size_t)tok * DM + col) = (v[j] * rstd) * g; }
    }
}

using pg8::Unit;
struct InOrder {
    int G, c;
    __device__ __forceinline__ bool next(int i, Unit& u) const {
        long L = (long)i * G + c;
        if (L < 64 * 31) { int pm, pn; pg8::tile_map((int)L, 64, 31, pm, pn); u.pm = (pm >> 4) * 17 + 1 + (pm & 15); u.pn = pn; u.x = pm * 256; u.y = 0; return true; }
        L -= 64 * 31; if (L >= 20) return false;
        const int b = (int)L / 5, t = (int)L % 5; u.pm = b * 17; u.pn = (t < 2) ? 4 + t : 10 + t; u.x = -1; u.y = 0; return true;
    }
    __device__ __forceinline__ int src_row(const Unit&, int) const { return 0; }
    __device__ __forceinline__ void done(const Unit&) const {}
};
struct EpiIn {
    static constexpr bool PERM = true, MIDHOOK = false;
    bf16_t *QA, *KA, *VA, *QB, *CKV, *KR, *GL; const float* sa; const unsigned* cmax; float* ssc;
    __device__ __forceinline__ void operator()(const i32x4 (&acc)[2][2][4][2], const Unit& u, int wr, int wc, int fr, int fq) const {
        const int pn = u.pn; bf16_t* base; int ldc, colt; long row0; bool sig = false; int ncv = 256;
        const long krow0 = (long)u.pm * 256, lrow0 = u.x;
        if (pn < 4) { base = QA; ldc = 1024; colt = pn * 256; row0 = lrow0; }
        else if (pn == 4) { base = KA; ldc = 256; colt = 0; row0 = krow0; }
        else if (pn == 5) { base = VA; ldc = 256; colt = 0; row0 = krow0; }
        else if (pn < 12) { base = QB; ldc = 1536; colt = (pn - 6) * 256; row0 = lrow0; }
        else if (pn < 14) { base = CKV; ldc = 512; colt = (pn - 12) * 256; row0 = krow0; }
        else if (pn == 14) { base = KR; ldc = 64; colt = 0; row0 = krow0; ncv = 64; }
        else { base = GL; ldc = 4096; colt = (pn - 15) * 256; row0 = lrow0; sig = true; }
        const int c0 = wc * 32 + 8 * fq; const float k127 = inv127() * ((pn >= 6 && pn < 12) ? (0.07216878364870322f * 1.4426950408889634f) : 1.0f);
        float sr[2][4], ssq[2][4];
#pragma unroll
        for (int ai = 0; ai < 2; ++ai)
#pragma unroll
            for (int m = 0; m < 4; ++m) { sr[ai][m] = sa[krow0 + ai * 128 + wr * 64 + m * 16 + fr]; ssq[ai][m] = 0.f; }
#pragma unroll
        for (int bj = 0; bj < 2; ++bj) {
            const u32x4 cm0 = *(const u32x4*)(cmax + pn * 256 + bj * 128 + c0), cm1 = *(const u32x4*)(cmax + pn * 256 + bj * 128 + c0 + 4);
            const f32x4 sb0 = (f32x4){__uint_as_float(cm0.x), __uint_as_float(cm0.y), __uint_as_float(cm0.z), __uint_as_float(cm0.w)} * k127;
            const f32x4 sb1 = (f32x4){__uint_as_float(cm1.x), __uint_as_float(cm1.y), __uint_as_float(cm1.z), __uint_as_float(cm1.w)} * k127;
            if (bj * 128 + c0 < ncv) {
#pragma unroll
                for (int ai = 0; ai < 2; ++ai)
#pragma unroll
                    for (int m = 0; m < 4; ++m) { const int rt = ai * 128 + wr * 64 + m * 16 + fr; bf16_t* rowp = base + (size_t)(row0 + rt) * ldc + colt + c0 + bj * 128;
                        f32x4 v0, v1;
#pragma unroll
                        for (int i = 0; i < 4; ++i) { v0[i] = (float)acc[ai][bj][m][0][i] * (sr[ai][m] * sb0[i]); v1[i] = (float)acc[ai][bj][m][1][i] * (sr[ai][m] * sb1[i]); }
                        if (sig) {
                            u32x2 w; w.x = pack_i8x4(v0[0] * 16.0f, v0[1] * 16.0f, v0[2] * 16.0f, v0[3] * 16.0f); w.y = pack_i8x4(v1[0] * 16.0f, v1[1] * 16.0f, v1[2] * 16.0f, v1[3] * 16.0f);
                            *(u32x2*)((unsigned char*)GL + (size_t)(row0 + rt) * 4096 + colt + c0 + bj * 128) = w;
                        } else {
                        u32x4 w; w.x = cvt_pk_bf16(v0[0], v0[1]); w.y = cvt_pk_bf16(v0[2], v0[3]); w.z = cvt_pk_bf16(v1[0], v1[1]); w.w = cvt_pk_bf16(v1[2], v1[3]);
                        *(u32x4*)rowp = w;
                        if (pn == 12 || pn == 13) ssq[ai][m] += (v0[0] * v0[0] + v0[1] * v0[1]) + (v0[2] * v0[2] + v0[3] * v0[3]) + (v1[0] * v1[0] + v1[1] * v1[1]) + (v1[2] * v1[2] + v1[3] * v1[3]); } } }
        }
        if (pn == 12 || pn == 13) {
#pragma unroll
            for (int ai = 0; ai < 2; ++ai)
#pragma unroll
                for (int m = 0; m < 4; ++m) { float q = ssq[ai][m]; q += __shfl_xor(q, 16); q += __shfl_xor(q, 32);
                    if (fq == 0) ssc[(size_t)(krow0 + ai * 128 + wr * 64 + m * 16 + fr) * 8 + (pn - 12) * 4 + wc] = q; } }
    }
};
struct EpiKvUp {
    static constexpr bool PERM = true, MIDHOOK = false;
    bf16_t* O; const float* ssc;
    __device__ __forceinline__ void operator()(const f32x4 (&acc)[2][2][4][2], const Unit& u, int wr, int wc, int fr, int fq) const {
        const int c0 = u.pn * 256 + wc * 32 + 8 * fq;
        float sc8[2][4];
#pragma unroll
        for (int ai = 0; ai < 2; ++ai)
#pragma unroll
            for (int m = 0; m < 4; ++m) { const size_t row = (size_t)u.pm * 256 + ai * 128 + wr * 64 + m * 16 + fr; const f32x4 p0 = *(const f32x4*)(ssc + row * 8), p1 = *(const f32x4*)(ssc + row * 8 + 4);
                sc8[ai][m] = rsqrtf(((p0.x + p0.y) + (p0.z + p0.w) + (p1.x + p1.y) + (p1.z + p1.w)) * (1.0f / 512.0f) + EPS); }
        __builtin_amdgcn_sched_barrier(0);
#pragma unroll
        for (int ai = 0; ai < 2; ++ai)
#pragma unroll
            for (int m = 0; m < 4; ++m) { const size_t row = (size_t)u.pm * 256 + ai * 128 + wr * 64 + m * 16 + fr; const float s = sc8[ai][m]; bf16_t* rowp = O + row * 2048 + c0;
#pragma unroll
                for (int bj = 0; bj < 2; ++bj) { const f32x4 v0 = acc[ai][bj][m][0] * s, v1 = acc[ai][bj][m][1] * s;
                    u32x4 w; w.x = cvt_pk_bf16(v0[0], v0[1]); w.y = cvt_pk_bf16(v0[2], v0[3]); w.z = cvt_pk_bf16(v1[0], v1[1]); w.w = cvt_pk_bf16(v1[2], v1[3]);
                    *(u32x4*)(rowp + bj * 128) = w; } }
    }
};
template <bool SECOND> struct EpiMerge {
    static constexpr bool PERM = true, MIDHOOK = false;
    const bf16_t* GL; const bf16_t* Tin; bf16_t* O; const float* sa; const unsigned* cmax;
    __device__ __forceinline__ void operator()(const i32x4 (&acc)[2][2][4][2], const Unit& u, int wr, int wc, int fr, int fq) const {
        const int c0 = u.pn * 256 + wc * 32 + 8 * fq;
        const float k127 = inv127(); f32x4 sb[2][2];
#pragma unroll
        for (int bj = 0; bj < 2; ++bj)
#pragma unroll
            for (int n = 0; n < 2; ++n) { const u32x4 cm = *(const u32x4*)(cmax + c0 + bj * 128 + 4 * n);
                sb[bj][n] = (f32x4){__uint_as_float(cm.x), __uint_as_float(cm.y), __uint_as_float(cm.z), __uint_as_float(cm.w)} * k127; }
#pragma unroll
        for (int ai = 0; ai < 2; ++ai)
#pragma unroll
            for (int m = 0; m < 4; ++m) { const size_t row = (size_t)u.pm * 256 + ai * 128 + wr * 64 + m * 16 + fr; const float sr = sa[row];
#pragma unroll
                for (int bj = 0; bj < 2; ++bj) { const int col = c0 + bj * 128;
                    const u32x2 gw = *(const u32x2*)((const unsigned char*)GL + row * 4096 + (SECOND ? 2048 : 0) + col);
                    f32x4 v0, v1;
#pragma unroll
                    for (int i = 0; i < 4; ++i) { v0[i] = (float)acc[ai][bj][m][0][i] * (sr * sb[bj][0][i]); v1[i] = (float)acc[ai][bj][m][1][i] * (sr * sb[bj][1][i]); }
#pragma unroll
                    for (int i = 0; i < 4; ++i) { v0[i] *= sigmoidf_((float)((int)(gw.x << (24 - 8 * i)) >> 24) * (1.0f / 16.0f)); v1[i] *= sigmoidf_((float)((int)(gw.y << (24 - 8 * i)) >> 24) * (1.0f / 16.0f)); }
                    if constexpr (SECOND) { const u32x4 tw = *(const u32x4*)(Tin + row * 2048 + col);
                        v0[0] += bflo(tw.x); v0[1] += bfhi(tw.x); v0[2] += bflo(tw.y); v0[3] += bfhi(tw.y); v1[0] += bflo(tw.z); v1[1] += bfhi(tw.z); v1[2] += bflo(tw.w); v1[3] += bfhi(tw.w); }
                    u32x4 w; w.x = cvt_pk_bf16(v0[0], v0[1]); w.y = cvt_pk_bf16(v0[2], v0[3]); w.z = cvt_pk_bf16(v1[0], v1[1]); w.w = cvt_pk_bf16(v1[2], v1[3]);
                    *(u32x4*)(O + row * 2048 + col) = w; } }
    }
};
struct EpiMergeF {
    static constexpr bool PERM = true, MIDHOOK = true;
    const signed char* GL; bf16_t* M; const float* invs;
    __device__ __forceinline__ void mid(f32x4 (&acc)[2][2][4][2], const Unit& u, int wr, int wc, int fr, int fq) const {
        const int c0 = u.pn * 256 + wc * 32 + 8 * fq;
        const signed char* gp = GL + ((size_t)u.pm * 256 + wr * 64 + fr) * 4096 + c0;
        u32x2 ga_n = *(const u32x2*)gp, gb_n = *(const u32x2*)(gp + 2048);
#pragma unroll
        for (int ai = 0; ai < 2; ++ai)
#pragma unroll
            for (int m = 0; m < 4; ++m) {
#pragma unroll
                for (int bj = 0; bj < 2; ++bj) {
                    const u32x2 ga = ga_n, gb = gb_n;
                    { const int g1 = ai * 8 + m * 2 + bj + 1; if (g1 < 16) { const signed char* q = gp + (size_t)((g1 >> 3) * 128 + ((g1 >> 1) & 3) * 16) * 4096 + (g1 & 1) * 128;
                        ga_n = *(const u32x2*)q; gb_n = *(const u32x2*)(q + 2048); } }
#pragma unroll
                    for (int i = 0; i < 4; ++i) {
                        const float a0 = (float)((int)(ga.x << (24 - 8 * i)) >> 24), b0 = (float)((int)(gb.x << (24 - 8 * i)) >> 24);
                        const float a1 = (float)((int)(ga.y << (24 - 8 * i)) >> 24), b1 = (float)((int)(gb.y << (24 - 8 * i)) >> 24);
                        constexpr float C = -1.4426950408889634f / 16.0f;
                        acc[ai][bj][m][0][i] *= (1.0f + __builtin_amdgcn_exp2f(C * b0)) * __builtin_amdgcn_rcpf(1.0f + __builtin_amdgcn_exp2f(C * a0));
                        acc[ai][bj][m][1][i] *= (1.0f + __builtin_amdgcn_exp2f(C * b1)) * __builtin_amdgcn_rcpf(1.0f + __builtin_amdgcn_exp2f(C * a1)); }
                    __builtin_amdgcn_sched_barrier(0); } }
    }
    __device__ __forceinline__ void operator()(const f32x4 (&acc)[2][2][4][2], const Unit& u, int wr, int wc, int fr, int fq) const {
        const int c0 = u.pn * 256 + wc * 32 + 8 * fq;
        const signed char* gp = GL + ((size_t)u.pm * 256 + wr * 64 + fr) * 4096 + 2048 + c0;
        u32x2 gb_n = *(const u32x2*)gp;
#pragma unroll
        for (int ai = 0; ai < 2; ++ai)
#pragma unroll
            for (int m = 0; m < 4; ++m) { const size_t row = (size_t)u.pm * 256 + ai * 128 + wr * 64 + m * 16 + fr;
#pragma unroll
                for (int bj = 0; bj < 2; ++bj) { const int col = c0 + bj * 128;
                    const u32x2 gb = gb_n;
                    { const int g1 = ai * 8 + m * 2 + bj + 1; if (g1 < 16) gb_n = *(const u32x2*)(gp + (size_t)((g1 >> 3) * 128 + ((g1 >> 1) & 3) * 16) * 4096 + (g1 & 1) * 128); }
                    const f32x4 rb0 = *(const f32x4*)(invs + col), rb1 = *(const f32x4*)(invs + col + 4);
                    f32x4 v0, v1;
#pragma unroll
                    for (int i = 0; i < 4; ++i) { v0[i] = acc[ai][bj][m][0][i] * rb0[i] * sigmoidf_((float)((int)(gb.x << (24 - 8 * i)) >> 24) * (1.0f / 16.0f));
                                                  v1[i] = acc[ai][bj][m][1][i] * rb1[i] * sigmoidf_((float)((int)(gb.y << (24 - 8 * i)) >> 24) * (1.0f / 16.0f)); }
                    u32x2 w; w.x = pack_f8x4(v0[0], v0[1], v0[2], v0[3]); w.y = pack_f8x4(v1[0], v1[1], v1[2], v1[3]);
                    *(u32x2*)((unsigned char*)M + row * 2048 + col) = w; } }
    }
};
struct EpiOut {
    static constexpr bool PERM = false, MIDHOOK = false;
    const float* x; const float* mod; float* O; const float* invs;
    __device__ __forceinline__ void operator()(const f32x4 (&acc)[2][2][4][2], const Unit& u, int wr, int wc, int fr, int fq) const {
        const int c0 = u.pn * 256 + wc * 32 + 4 * fq; const int b = (u.pm * 256) / SEQ; const float* g1 = mod + (size_t)b * NMOD + 2 * DM;
        f32x4 gsb[2][2];
#pragma unroll
        for (int bj = 0; bj < 2; ++bj)
#pragma unroll
            for (int n = 0; n < 2; ++n) { const int col = c0 + bj * 128 + n * 16; gsb[bj][n] = *(const f32x4*)(invs + col) * (1.0f / 64.0f) * *(const f32x4*)(g1 + col); }
        const float* xp = x + ((size_t)u.pm * 256 + wr * 64 + fr) * DM + c0; float* op = O + ((size_t)u.pm * 256 + wr * 64 + fr) * DM + c0;
        f32x4 xa[8], xb[8];
#define EO_OFF(b, k) ((size_t)(((b) >> 1) * 128 + (((b) & 1) * 2 + ((k) >> 2)) * 16) * DM + (((k) >> 1) & 1) * 128 + ((k) & 1) * 16)
#define EO_LD(b, xx) do { _Pragma("unroll") for (int k = 0; k < 8; ++k) xx[k] = *(const f32x4*)(xp + EO_OFF(b, k)); __builtin_amdgcn_sched_barrier(0); } while (0)
#define EO_ST(b, xx) do { _Pragma("unroll") for (int k = 0; k < 8; ++k) *(f32x4*)(op + EO_OFF(b, k)) = xx[k] + gsb[(k >> 1) & 1][k & 1] * acc[(b) >> 1][(k >> 1) & 1][((b) & 1) * 2 + (k >> 2)][k & 1]; __builtin_amdgcn_sched_barrier(0); } while (0)
        EO_LD(0, xa); EO_LD(1, xb); EO_ST(0, xa); EO_LD(2, xa); EO_ST(1, xb); EO_LD(3, xb); EO_ST(2, xa); EO_ST(3, xb);
#undef EO_OFF
#undef EO_LD
#undef EO_ST
    }
};
struct MoeOrder {
    const LAS int* tab; const unsigned* list; int G, c;
    __device__ __forceinline__ bool next(int i, Unit& u) const {
        int rt, j;
        if ((G & 15) == 0) { const int x = c & 7, q = c >> 3; j = 2 * (x & 3) + (q & 1); rt = i * (G >> 3) + (x >> 2) * (G >> 4) + (q >> 1); }
        else { const long L = (long)i * G + c; rt = (int)(L >> 3); j = (int)(L & 7); }
        if (rt >= tab[16]) return false;
        int e = 0;
#pragma unroll
        for (int k = 1; k < 16; ++k) e += (rt >= tab[k]) ? 1 : 0;
        const int m = rt - tab[e]; int rows = tab[32 + e] - m * 256; rows = rows > 256 ? 256 : rows;
        u.pm = rt; u.pn = e * 8 + j; u.x = e * NTOK + m * 256; u.y = rows; return true;
    }
    __device__ __forceinline__ int src_row(const Unit& u, int r) const { return (r < u.y) ? (int)(list[u.x + r] >> 1) : 0; }
    unsigned* qcnt;
    __device__ __forceinline__ void done(const Unit& u) const {
        if (my_lane() == 0) __hip_atomic_fetch_add(qcnt + 64 * u.pm, 1u, RLX_AGENT);
    }
};
struct MoeQueue {
    const LAS int* tab; volatile LAS int* slot; unsigned* qhead; unsigned* qcnt; const unsigned* list; int G, c;
    __device__ __forceinline__ bool next(int i, Unit& u) const {
        const int tid_ = my_tid();
        if (__builtin_amdgcn_readfirstlane(tid_ >> 6) == 0) {
            int L = 0;
            if ((tid_ & 63) == 0) {
                L = (i == 0) ? c : G + (int)__hip_atomic_fetch_add(qhead, 1u, RLX_AGENT);
                if (L < tab[16] * 8) { unsigned* c = qcnt + 64 * (L >> 3); unsigned sp = 0;
                    while (__hip_atomic_load(c, RLX_AGENT) < 64u) { __builtin_amdgcn_s_sleep(2); if (++sp > (1u << 22)) break; } }
            }
            L = __builtin_amdgcn_readfirstlane(L);
            __builtin_amdgcn_fence(__ATOMIC_ACQUIRE, "agent");
            asm volatile("s_waitcnt vmcnt(0)" ::: "memory");
            if ((tid_ & 63) == 0) slot[i & 1] = L;
        }
        asm volatile("s_waitcnt lgkmcnt(0)" ::: "memory"); __builtin_amdgcn_s_barrier(); asm volatile("" ::: "memory");
        const int L = slot[i & 1];
        if (L >= tab[16] * 8) return false;
        const int rt = L >> 3, j = L & 7; int e = 0;
#pragma unroll
        for (int k = 1; k < 16; ++k) e += (rt >= tab[k]) ? 1 : 0;
        const int m = rt - tab[e]; int rows = tab[32 + e] - m * 256; rows = rows > 256 ? 256 : rows;
        u.pm = rt; u.pn = e * 8 + j; u.x = e * NTOK + m * 256; u.y = rows; return true;
    }
    __device__ __forceinline__ int src_row(const Unit&, int) const { return 0; }
    __device__ __forceinline__ void done(const Unit&) const {}
};
struct EpiGateUp {
    static constexpr bool PERM = true, MIDHOOK = false;
    bf16_t* O; const unsigned* list; const float* sa; const unsigned* cmax;
    __device__ __forceinline__ void operator()(const i32x4 (&acc)[2][2][4][2], const Unit& u, int wr, int wc, int fr, int fq) const {
        const int c0 = (u.pn & 7) * 128 + wc * 32 + 8 * fq, ct = wc * 32 + 8 * fq;
        const __amdgpu_buffer_rsrc_t rsrc = __builtin_amdgcn_make_buffer_rsrc((void*)O, 0, 0x7ffffff0, 0x00020000);
        const float k127 = inv127(); f32x4 sb[2][2];
#pragma unroll
        for (int bj = 0; bj < 2; ++bj)
#pragma unroll
            for (int n = 0; n < 2; ++n) { const u32x4 cm = *(const u32x4*)(cmax + u.pn * 256 + bj * 128 + ct + 4 * n);
                sb[bj][n] = (f32x4){__uint_as_float(cm.x), __uint_as_float(cm.y), __uint_as_float(cm.z), __uint_as_float(cm.w)} * k127; }
        float sr8[2][4];
        { unsigned tk[2][4];
#pragma unroll
          for (int ai = 0; ai < 2; ++ai)
#pragma unroll
            for (int m = 0; m < 4; ++m) { const int rt = ai * 128 + wr * 64 + m * 16 + fr; tk[ai][m] = list[u.x + ((rt < u.y) ? rt : 0)]; }
#pragma unroll
          for (int ai = 0; ai < 2; ++ai)
#pragma unroll
            for (int m = 0; m < 4; ++m) sr8[ai][m] = sa[tk[ai][m] >> 1]; }
        __builtin_amdgcn_sched_barrier(0);
#pragma unroll
        for (int ai = 0; ai < 2; ++ai)
#pragma unroll
            for (int m = 0; m < 4; ++m) { const int rt = ai * 128 + wr * 64 + m * 16 + fr; const size_t row = (size_t)u.pm * 256 + rt;
                const float sr = sr8[ai][m];
                f32x4 h0, h1;
#pragma unroll
                for (int i = 0; i < 4; ++i) { const float g0 = (float)acc[ai][0][m][0][i] * (sr * sb[0][0][i]), g1 = (float)acc[ai][0][m][1][i] * (sr * sb[0][1][i]);
                    h0[i] = g0 * sigmoidf_(g0) * ((float)acc[ai][1][m][0][i] * (sr * sb[1][0][i])); h1[i] = g1 * sigmoidf_(g1) * ((float)acc[ai][1][m][1][i] * (sr * sb[1][1][i])); }
                u32x2 w; w.x = pack_f8x4(h0[0] * 8.0f, h0[1] * 8.0f, h0[2] * 8.0f, h0[3] * 8.0f); w.y = pack_f8x4(h1[0] * 8.0f, h1[1] * 8.0f, h1[2] * 8.0f, h1[3] * 8.0f);
                __builtin_amdgcn_raw_buffer_store_b64(w, rsrc, (int)(row * DEXP + c0), 0, 16); }
    }
};
struct EpiDown {
    static constexpr bool PERM = true, MIDHOOK = false;
    bf16_t* O; const unsigned* list; const float* wl; const float* invs;
    __device__ __forceinline__ void operator()(const f32x4 (&acc)[2][2][4][2], const Unit& u, int wr, int wc, int fr, int fq) const {
        const int c0 = (u.pn & 7) * 256 + wc * 32 + 8 * fq; const int ce = u.pn * 256 + wc * 32 + 8 * fq;
        f32x4 sb[2][2];
#pragma unroll
        for (int bj = 0; bj < 2; ++bj)
#pragma unroll
            for (int n = 0; n < 2; ++n) sb[bj][n] = *(const f32x4*)(invs + ce + bj * 128 + 4 * n) * (1.0f / 8.0f);
        unsigned dst8[2][4]; float w8[2][4];
#pragma unroll
        for (int ai = 0; ai < 2; ++ai)
#pragma unroll
            for (int m = 0; m < 4; ++m) { const int r = ai * 128 + wr * 64 + m * 16 + fr; const int e = u.x + ((r < u.y) ? r : 0); dst8[ai][m] = list[e]; w8[ai][m] = wl[e]; }
        __builtin_amdgcn_sched_barrier(0);
#pragma unroll
        for (int ai = 0; ai < 2; ++ai)
#pragma unroll
            for (int m = 0; m < 4; ++m) { const int r = ai * 128 + wr * 64 + m * 16 + fr;
                if (r < u.y) { const size_t dst = dst8[ai][m]; const float s = w8[ai][m]; bf16_t* rowp = O + dst * DM + c0;
#pragma unroll
                    for (int bj = 0; bj < 2; ++bj) { const f32x4 v0 = acc[ai][bj][m][0] * sb[bj][0] * s, v1 = acc[ai][bj][m][1] * sb[bj][1] * s;
                        u32x4 w; w.x = cvt_pk_bf16(v0[0], v0[1]); w.y = cvt_pk_bf16(v0[2], v0[3]); w.z = cvt_pk_bf16(v1[0], v1[1]); w.w = cvt_pk_bf16(v1[2], v1[3]);
                        *(u32x4*)(rowp + bj * 128) = w; } } }
    }
};

enum { PH_P0, PH_P1, PH_HX, PH_IN, PH_POST, PH_KVUP, PH_ATT, PH_RQ1, PH_MERGE, PH_RQ2, PH_OUT, PH_ROUTE, PH_GU, PH_DOWN, PH_FINAL, NPH };
#ifndef MK_ONE_LAUNCH
#define MK_ONE_LAUNCH 1
#endif
struct Args { Ptrs p; int ph_lo, ph_hi, use_bar, pad; };
__global__ void __launch_bounds__(NWAVES * 64, 2) fwd_kernel(Args args) {
    extern __shared__ __attribute__((aligned(16))) unsigned char lds_raw[];
    LAS unsigned char* lds = (LAS unsigned char*)lds_raw;
    const int G = gridDim.x, blk = blockIdx.x, NGW = G * NWAVES;
#if defined(__HIP_DEVICE_COMPILE__)
#define PDECL() const __attribute__((address_space(4))) Ptrs* pp_ = (const __attribute__((address_space(4))) Ptrs*)__builtin_amdgcn_kernarg_segment_ptr(); asm volatile("" : "+s"(pp_)); \
    const Ptrs P = *pp_; unsigned char* const ws = P.ws; unsigned* const ctl = (unsigned*)(ws + WS_CTL); (void)ctl
#else
#define PDECL() const Ptrs P = args.p; unsigned char* const ws = P.ws; unsigned* const ctl = (unsigned*)(ws + WS_CTL); (void)ctl
#endif
#define TIDS() const int tid = opaque_v(my_tid()), lane = tid & 63, wave = __builtin_amdgcn_readfirstlane(tid >> 6), gw = blk * NWAVES + wave; (void)lane; (void)gw
    for (int u = threadIdx.x; u < (LDS_BYTES - CTL_OFF) / 4; u += NWAVES * 64) ((LAS unsigned*)(lds + CTL_OFF))[u] = 0u;
    __syncthreads();
    static_assert(WTAB_OFF_ == CTL_OFF + 1792 && WTAB_OFF_ + 256 <= LDS_BYTES, "wave table inside the LDS control region");
    if ((threadIdx.x & 63) == 0) ((LAS int*)(lds + WTAB_OFF_))[(unsigned)__builtin_amdgcn_s_getreg((5 << 11) | 4) & 63u] = (int)(threadIdx.x >> 6);
    __syncthreads();
    volatile LAS unsigned* MISC = (volatile LAS unsigned*)(lds + MISC_OFF);
    XcdBarrier bar; { PDECL(); bar.bar = ctl + CW_BAR; bar.x = 0; bar.st = nullptr;
    if (args.use_bar) bar = xcd_barrier_post(ctl + CW_BAR, MISC + 8); }
    const int lo = args.ph_lo, hi = args.ph_hi;
#ifndef PHASE_MASK
#define PHASE_MASK 0xFFFFF
#endif
#define IN(k) (((PHASE_MASK >> (k)) & 1) && lo <= (k) && (k) < hi)
#ifndef PROBE_DUP
#define PROBE_DUP -1
#endif
#define REP(k) for (int rep_ = 0; rep_ < ((PROBE_DUP == (k)) ? 2 : 1); ++rep_)
#define SEAM(k) do { if (IN(k) && IN((k) + 1)) xcd_barrier(bar); } while (0)

    if (IN(PH_P0)) REP(PH_P0) { PDECL(); TIDS(); p0_prologue(P, lds, G, blk, gw, NGW, wave, lane); } SEAM(PH_P0);
    if (IN(PH_P1)) { PDECL(); TIDS(); p1_modreduce(P, blk * NWAVES * 64 + tid, G * NWAVES * 64); p1_win_i8(P, lds, gw, NGW, wave, lane); } SEAM(PH_P1);
    if (IN(PH_HX)) REP(PH_HX) { PDECL(); TIDS(); p2_hx(P, gw, NGW, lane); } SEAM(PH_HX);
    if (IN(PH_IN)) REP(PH_IN) { PDECL();
        pg8::Gemm g{(const bf16_t*)(ws + WS_R1), (const bf16_t*)(ws + WS_WIN), DM}; InOrder S{G, blk};
        unsigned char* r2 = ws + WS_R2;
        EpiIn E{(bf16_t*)(r2 + R2_QA), (bf16_t*)(r2 + R2_KA), (bf16_t*)(r2 + R2_VA), (bf16_t*)(r2 + R2_QB), (bf16_t*)(r2 + R2_CKV), (bf16_t*)(r2 + R2_KR), (bf16_t*)(ws + WS_R3), (const float*)(ws + WS_SAHX), (const unsigned*)(ws + WS_CTL) + CW_CMAX_IN, (float*)(ws + WS_SSC)};
        if ((blk & 1) == 0) { TIDS(); p3_expert_gateup(P, lds, G, blk, wave, lane); }
        pg8::gemm_phase<EpiIn, InOrder, false, true>(lds, g, S, E);
        if ((blk & 1) == 1) { TIDS(); p3_expert_gateup(P, lds, G, blk, wave, lane); }
    } SEAM(PH_IN);
    if (IN(PH_KVUP)) REP(PH_KVUP) { PDECL();
        pg8::Gemm g{(const bf16_t*)(ws + WS_R2 + R2_CKV), (const bf16_t*)(ws + WS_WUKV), 512}; pg8::TileOrder S{NKEY / 256, 8, G, blk};
        EpiKvUp E{(bf16_t*)(ws + WS_R1), (const float*)(ws + WS_SSC)};
        pg8::gemm_phase<EpiKvUp, pg8::TileOrder, false>(lds, g, S, E);
        {
            TIDS(); const int nu3 = (NKEY / 256) * 8 - 2 * G;
            const bool w3 = (G == 256) && blk < nu3; const int shares = (G == 256) ? nu3 + 2 * (G - nu3) : G;
            const int s0 = (G == 256) ? (w3 ? blk : nu3 + 2 * (blk - nu3)) : blk, s1 = s0 + ((G == 256 && !w3) ? 2 : 1);
            p4_post(P, (int)((long)NKEY * s0 / shares), (int)((long)NKEY * s1 / shares), wave, lane); }
    } SEAM(PH_KVUP);
    if (IN(PH_ATT)) { PDECL();
        const bf16_t* QA = (const bf16_t*)(ws + WS_R2 + R2_QA); const bf16_t* KA = (const bf16_t*)(ws + WS_R2 + R2_KA); const bf16_t* VA = (const bf16_t*)(ws + WS_R2 + R2_VA);
        const bf16_t* QB = (const bf16_t*)(ws + WS_R2 + R2_QB); const bf16_t* KR = (const bf16_t*)(ws + WS_R2 + R2_KR); const bf16_t* KVB = (const bf16_t*)(ws + WS_R1);
        unsigned char* OA = ws + WS_R4; unsigned char* OB = OA + (size_t)NTOK * 1024;
#ifndef ATT_SKIP_A
        const int cslot = blk % 5; int ucnt = 0;
#define P6_COPIES() do { TIDS(); for (int q_ = 0; q_ < ((PROBE_DUP == 200 + PH_ATT) ? 2 : 1); ++q_) p6_expert_copies(P, lds, G, blk, wave, lane); __syncthreads(); } while (0)
        for (int L_ = blk; L_ < ((PROBE_DUP == PH_ATT) ? 1024 : 512); L_ += G) { const int L = L_ & 511;
            if (ucnt++ == cslot) P6_COPIES();
            const int i2 = L >> 8, cc = L & 255, xcd = cc & 7, j = cc >> 3;
            const int b = 2 * i2 + (xcd >> 2), kvh = (xcd >> 1) & 1, h = kvh * 4 + (xcd & 1) * 2 + (j >> 4), qb = j & 15;
            const size_t qrow = (size_t)b * SEQ + qb * 256, krow = (size_t)b * KEYS;
            if (att::attn_body<0, -1, 2, 1024, 256, 256, 1024, true, true>(QA + qrow * 1024 + h * 128, KA + krow * 256 + kvh * 128, VA + krow * 256 + kvh * 128, nullptr, (bf16_t*)(OA + qrow * 1024 + h * 128), KEYS, (char*)lds_raw))
                att::attn_body<0, -1, 2, 1024, 256, 256, 1024, true, false>(QA + qrow * 1024 + h * 128, KA + krow * 256 + kvh * 128, VA + krow * 256 + kvh * 128, nullptr, (bf16_t*)(OA + qrow * 1024 + h * 128), KEYS, (char*)lds_raw);
        }
#endif
#ifndef ATT_SKIP_B
        for (int L_ = blk; L_ < ((PROBE_DUP == 100 + PH_ATT) ? 1024 : 512); L_ += G) { const int L = L_ & 511;
            if (ucnt++ == cslot) P6_COPIES();
            const int i2 = L >> 8, cc = L & 255, xcd = cc & 7, j = cc >> 3;
            const int b = 2 * i2 + (xcd >> 2), h = (xcd & 3) * 2 + (j >> 4), qb = j & 15;
            const size_t qrow = (size_t)b * SEQ + qb * 256, krow = (size_t)b * KEYS;
            if (att::attn_body<64, ATT_B_QPARK, ATT_B_SDEPTH, 1536, 2048, 2048, 1024, true, true>(QB + qrow * 1536 + h * 192, KVB + krow * 2048 + h * 256, KVB + krow * 2048 + h * 256 + 128, KR + krow * 64, (bf16_t*)(OB + qrow * 1024 + h * 128), KEYS, (char*)lds_raw))
                att::attn_body<64, ATT_B_QPARK, ATT_B_SDEPTH, 1536, 2048, 2048, 1024, true, false>(QB + qrow * 1536 + h * 192, KVB + krow * 2048 + h * 256, KVB + krow * 2048 + h * 256 + 128, KR + krow * 64, (bf16_t*)(OB + qrow * 1024 + h * 128), KEYS, (char*)lds_raw);
        }
#endif
        if (ucnt <= cslot) P6_COPIES();
#undef P6_COPIES
    } SEAM(PH_ATT);
    if (IN(PH_MERGE)) REP(PH_MERGE) { PDECL();
        pg8::Gemm g{(const bf16_t*)(ws + WS_R4), (const bf16_t*)(ws + WS_WBRA), DM, 1024, (long)NTOK * 1024 - 8 * 128}; pg8::TileOrder S{NTOK / 256, 8, G, blk};
        EpiMergeF E{(const signed char*)(ws + WS_R3), (bf16_t*)(ws + WS_R1), (const float*)(ws + WS_SAO)};
        pg8::gemm_phase<EpiMergeF, pg8::TileOrder, false, 2>(lds, g, S, E);
    } SEAM(PH_MERGE);
    if (IN(PH_OUT)) REP(PH_OUT) { PDECL();
        pg8::Gemm g{(const bf16_t*)(ws + WS_R1), (const bf16_t*)(ws + WS_WOUT), DM}; pg8::TileOrder S{NTOK / 256, 8, G, blk};
        EpiOut E{P.x, (const float*)(ws + WS_MOD), (float*)(ws + WS_R3), (const float*)(ws + WS_SAO) + 2048};
        pg8::gemm_phase<EpiOut, pg8::TileOrder, false, 2>(lds, g, S, E);
    } SEAM(PH_OUT);
    if (IN(PH_ROUTE)) REP(PH_ROUTE) { PDECL(); TIDS(); p9_route(P, lds, G, blk, tid, wave, lane, !(PROBE_DUP == PH_ROUTE && rep_ == 0)); } SEAM(PH_ROUTE);
    if (IN(PH_GU) || IN(PH_DOWN)) { PDECL();
        LAS int* tab = (LAS int*)(lds + MOETAB_OFF);
        if (my_tid() == 0) { int pre = 0;
            for (int e = 0; e < 16; ++e) { const int n = (int)__hip_atomic_load(ctl + CW_ECNT + 64 * e, RLX_AGENT); tab[e] = pre; tab[32 + e] = n; pre += (n + 255) >> 8; }
            tab[16] = pre; }
        __syncthreads();
    }
    if (IN(PH_GU)) REP(PH_GU) { PDECL();
        const LAS int* tab = (const LAS int*)(lds + MOETAB_OFF);
        pg8::Gemm g{(const bf16_t*)(ws + WS_R4), (const bf16_t*)(ws + WS_WG), DM}; MoeOrder S{tab, (const unsigned*)(ws + WS_LIST), G, blk, ctl + CW_QCNT};
        EpiGateUp E{(bf16_t*)(ws + WS_R1), (const unsigned*)(ws + WS_LIST), (const float*)(ws + WS_SAH2), (const unsigned*)(ws + WS_CTL) + CW_CMAX_WG};
        pg8::gemm_phase<EpiGateUp, MoeOrder, true, true>(lds, g, S, E);
    }
    if (IN(PH_DOWN)) REP(PH_DOWN) { PDECL();
        const LAS int* tab = (const LAS int*)(lds + MOETAB_OFF);
        pg8::Gemm g{(const bf16_t*)(ws + WS_R1), (const bf16_t*)(ws + WS_WD), DEXP}; MoeQueue S{tab, (volatile LAS int*)(lds + QSLOT_OFF), ctl + CW_QHEAD, ctl + CW_QCNT, (const unsigned*)(ws + WS_LIST), G, blk};
        EpiDown E{(bf16_t*)(ws + WS_R2), (const unsigned*)(ws + WS_LIST), (const float*)(ws + WS_WLIST), (const float*)(ws + WS_INVD)};
        pg8::gemm_phase<EpiDown, MoeQueue, false, 2>(lds, g, S, E);
    } SEAM(PH_DOWN);
    if (IN(PH_FINAL)) REP(PH_FINAL) { PDECL(); TIDS(); p12_final(P, gw, NGW, lane); }
#undef IN
#undef SEAM
}

extern "C" void kernel_launch(void* const* d_in, const int* in_sizes, int n_in, void* d_out, int out_size, void* d_ws, size_t ws_size, hipStream_t stream) {
    static int grid = 0;
    if (grid == 0) {
        if (n_in != 24 || in_sizes[0] != NTOK * DM || out_size != NTOK * DM || ws_size < WS_END) {
            fprintf(stderr, "kernel_launch: shape mismatch (n_in %d, in0 %d, out %d, ws %zu; need ws >= %zu); nothing launched\n", n_in, n_in > 0 ? in_sizes[0] : -1, out_size, ws_size, (size_t)WS_END); grid = -1; return; }
        int dev = 0, cus = 0, per_cu = 0;
        if (hipGetDevice(&dev) != hipSuccess || hipDeviceGetAttribute(&cus, hipDeviceAttributeMultiprocessorCount, dev) != hipSuccess) { fprintf(stderr, "kernel_launch: device query failed\n"); grid = -1; return; }
        if (hipFuncSetAttribute((const void*)fwd_kernel, hipFuncAttributeMaxDynamicSharedMemorySize, LDS_BYTES) != hipSuccess) { fprintf(stderr, "kernel_launch: hipFuncSetAttribute failed\n"); grid = -1; return; }
        if (hipOccupancyMaxActiveBlocksPerMultiprocessor(&per_cu, (const void*)fwd_kernel, NWAVES * 64, LDS_BYTES) != hipSuccess || per_cu < 1) {
            fprintf(stderr, "kernel_launch: occupancy query reports %d workgroups per CU\n", per_cu); }
        (void)hipGetLastError();
        grid = cus;
    }
    if (grid < 0) return;
    if (hipMemsetAsync((char*)d_ws + WS_CTL, 0, CTL_ZERO_BYTES, stream) != hipSuccess) { fprintf(stderr, "kernel_launch: memset failed\n"); return; }
    Args a{};
    const float** pp = (const float**)&a.p;
    for (int i = 0; i < 24; ++i) pp[i] = (const float*)d_in[i];
    a.p.out = (float*)d_out; a.p.ws = (unsigned char*)d_ws;
#if MK_ONE_LAUNCH
    a.ph_lo = 0; a.ph_hi = NPH; a.use_bar = 1; a.pad = 0;
    hipLaunchKernelGGL(fwd_kernel, dim3(grid), dim3(NWAVES * 64), LDS_BYTES, stream, a);
#else
    for (int k = 0; k < NPH; ++k) { a.ph_lo = k; a.ph_hi = k + 1; a.use_bar = 0; a.pad = 0;
        hipLaunchKernelGGL(fwd_kernel, dim3(grid), dim3(NWAVES * 64), LDS_BYTES, stream, a); }
#endif
    const hipError_t le = hipPeekAtLastError();
    if (le != hipSuccess) fprintf(stderr, "kernel_launch: launch failed: %s\n", hipGetErrorName(le));
}
```
